# Optimizing an MI355X kernel written in HIP

```python
import jax, jax.numpy as jnp
from jax import lax
import numpy as np

D_MODEL = 1024
BATCH = 4
SEQ = 4096
DEPTH = 1

RET_WIDTH = D_MODEL // 2
RET_HEADS = 4
RET_HEAD_DIM = RET_WIDTH // RET_HEADS
CONV_WIDTH = D_MODEL - RET_WIDTH
CONV_GROUPS = 8
CONV_K = 3
MIX_WIDTH = RET_WIDTH + CONV_WIDTH
IN_COLS = 4 * RET_WIDTH + 3 * CONV_WIDTH
CHUNK = 128
ROPE_BASE = 10000.0
N_GROUPS = 8
EXPERTS_PER_GROUP = 8
N_EXPERTS = N_GROUPS * EXPERTS_PER_GROUP
TOP_K = 2
EXPERT_FF = D_MODEL // 2
MOE_BLOCK = 128
EPS = 1e-6

kernel_name = "hybrid_retention_shortconv_hiermoe"


def rmsnorm(x, w):
    xf = x.astype(jnp.float32)
    y = xf * lax.rsqrt(jnp.mean(xf * xf, axis=-1, keepdims=True) + EPS)
    return (y * w.astype(jnp.float32)).astype(x.dtype)


def rotary(x, pos):
    half = x.shape[-1] // 2
    inv = ROPE_BASE ** (-jnp.arange(half, dtype=jnp.float32) / half)
    ang = pos.astype(jnp.float32)[:, None] * inv[None, :]
    cos = jnp.cos(ang)[None, :, None, :]
    sin = jnp.sin(ang)[None, :, None, :]
    xf = x.astype(jnp.float32)
    x1, x2 = xf[..., :half], xf[..., half:]
    return jnp.concatenate([x1 * cos - x2 * sin, x2 * cos + x1 * sin], axis=-1)


def retention_chunkwise(q, k, v):
    b, s, h, d = q.shape
    nc = s // CHUNK
    log_g = jnp.log1p(-(2.0 ** (-5.0 - jnp.arange(h, dtype=jnp.float32))))
    idx = jnp.arange(CHUNK, dtype=jnp.float32)
    rel = idx[:, None] - idx[None, :]
    causal = rel >= 0
    intra_decay = jnp.where(causal[None], jnp.exp(log_g[:, None, None] * jnp.where(causal, rel, 0.0)[None]), 0.0)
    k_decay = jnp.exp(log_g[:, None] * (CHUNK - 1 - idx)[None, :])
    q_decay = jnp.exp(log_g[:, None] * (idx + 1)[None, :])
    chunk_decay = jnp.exp(log_g * CHUNK)

    qc = q.reshape(b, nc, CHUNK, h, d)
    kc = k.reshape(b, nc, CHUNK, h, d)
    vc = v.reshape(b, nc, CHUNK, h, d)

    scores = jnp.einsum('bnihd,bnjhd->bnhij', qc, kc) * intra_decay[None, None]
    o_intra = jnp.einsum('bnhij,bnjhd->bnihd', scores, vc)

    kv = jnp.einsum('bnjhd,hj,bnjhe->bnhde', kc, k_decay, vc)

    def step(state, kv_n):
        return chunk_decay[None, :, None, None] * state + kv_n, state

    _, prev = lax.scan(step, jnp.zeros((b, h, d, d), jnp.float32), jnp.moveaxis(kv, 1, 0))
    prev = jnp.moveaxis(prev, 0, 1)
    o_inter = jnp.einsum('bnihd,bnhde->bnihe', qc, prev) * q_decay.T[None, None, :, :, None]
    return (o_intra + o_inter).reshape(b, s, h, d)


def head_groupnorm(o, w):
    b, s, h, d = o.shape
    mu = jnp.mean(o, axis=-1, keepdims=True)
    var = jnp.mean(jnp.square(o - mu), axis=-1, keepdims=True)
    y = (o - mu) * lax.rsqrt(var + EPS)
    return y.reshape(b, s, h * d) * w.astype(jnp.float32)


def causal_depthwise_conv(u, w):
    return lax.conv_general_dilated(
        u, w[:, None, :], window_strides=(1,), padding=[(CONV_K - 1, 0)],
        dimension_numbers=('NWC', 'WIO', 'NWC'), feature_group_count=u.shape[-1])


def mixer(h, w_in, ret_gn_w, conv_w, w_o):
    b, s, _ = h.shape
    proj = h @ w_in
    R, C = RET_WIDTH, CONV_WIDTH
    q, k, v, g, gb, gc, u = jnp.split(proj, [R, 2 * R, 3 * R, 4 * R, 4 * R + C, 4 * R + 2 * C], axis=-1)
    pos = jnp.arange(s)
    q = rotary(q.reshape(b, s, RET_HEADS, RET_HEAD_DIM), pos) * (RET_HEAD_DIM ** -0.5)
    k = rotary(k.reshape(b, s, RET_HEADS, RET_HEAD_DIM), pos)
    v = v.reshape(b, s, RET_HEADS, RET_HEAD_DIM).astype(jnp.float32)
    ret = retention_chunkwise(q, k, v)
    ret = (jax.nn.silu(g.astype(jnp.float32)) * head_groupnorm(ret, ret_gn_w)).astype(h.dtype)
    conv = gb * causal_depthwise_conv(gc * u, conv_w)
    return jnp.concatenate([ret, conv], axis=-1) @ w_o


def expert_dispatch(t, expert, gate, w_gate, w_up, w_down):
    n, d = t.shape
    e_total = w_gate.shape[0]
    n_slots = n * TOP_K
    flat_e = expert.reshape(-1)
    flat_tok = jnp.repeat(jnp.arange(n, dtype=jnp.int32), TOP_K)
    flat_w = gate.reshape(-1)
    order = jnp.argsort(flat_e)
    se, stok, sw = flat_e[order], flat_tok[order], flat_w[order]
    counts = jnp.bincount(flat_e, length=e_total)
    starts = jnp.cumsum(counts) - counts
    padded = ((counts + MOE_BLOCK - 1) // MOE_BLOCK) * MOE_BLOCK
    pad_ends = jnp.cumsum(padded)
    pad_starts = pad_ends - padded
    dest = pad_starts[se] + (jnp.arange(n_slots) - starts[se])
    n_blocks = -(-n_slots // MOE_BLOCK) + e_total
    cap = n_blocks * MOE_BLOCK
    buf_tok = jnp.full((cap,), n, jnp.int32).at[dest].set(stok)
    buf_w = jnp.zeros((cap,), t.dtype).at[dest].set(sw.astype(t.dtype))
    block_e = jnp.minimum(jnp.searchsorted(pad_ends, jnp.arange(n_blocks) * MOE_BLOCK, side='right'), e_total - 1)
    t_pad = jnp.concatenate([t, jnp.zeros((1, d), t.dtype)], axis=0)

    def run_block(args):
        tok, e = args
        xb = t_pad[tok]
        hb = jax.nn.silu(xb @ w_gate[e]) * (xb @ w_up[e])
        return hb @ w_down[e]

    yb = lax.map(run_block, (buf_tok.reshape(n_blocks, MOE_BLOCK), block_e))
    y = jax.ops.segment_sum(yb.reshape(cap, d) * buf_w[:, None], buf_tok, num_segments=n + 1)
    return y[:n]


def hier_moe(h, rg_w, rg_b, re_w, re_b, w_gate, w_up, w_down):
    b, s, d = h.shape
    t = h.reshape(b * s, d)
    g_prob = jax.nn.softmax((t @ rg_w).astype(jnp.float32) + rg_b.astype(jnp.float32), axis=-1)
    p_group, g_sel = lax.top_k(g_prob, 1)
    p_group, g_sel = p_group[:, 0], g_sel[:, 0]
    e_logits_all = jnp.einsum('nd,gde->nge', t, re_w).astype(jnp.float32) + re_b.astype(jnp.float32)[None]
    e_logits = jnp.take_along_axis(e_logits_all, g_sel[:, None, None], axis=1)[:, 0]
    e_prob = jax.nn.softmax(e_logits, axis=-1)
    top_p, top_i = lax.top_k(e_prob, TOP_K)
    top_p = top_p / jnp.sum(top_p, axis=-1, keepdims=True)
    gate = p_group[:, None] * top_p
    expert = g_sel[:, None] * EXPERTS_PER_GROUP + top_i
    return expert_dispatch(t, expert, gate, w_gate, w_up, w_down).reshape(b, s, d)


def setup_inputs(seed: int = 0) -> dict:
    key = jax.random.key(seed)
    ks = jax.random.split(key, 16)
    f32 = jnp.float32
    nrm = lambda k, shape, scale: jax.random.normal(k, shape, f32) * scale
    return {
        "x": nrm(ks[0], (BATCH, SEQ, D_MODEL), 1.0),
        "norm1_w": 1.0 + nrm(ks[1], (DEPTH, D_MODEL), 0.02),
        "w_in": nrm(ks[2], (DEPTH, D_MODEL, IN_COLS), D_MODEL ** -0.5),
        "ret_gn_w": 1.0 + nrm(ks[3], (DEPTH, RET_WIDTH), 0.02),
        "conv_w": nrm(ks[4], (DEPTH, CONV_K, CONV_WIDTH), CONV_K ** -0.5),
        "w_o": nrm(ks[5], (DEPTH, MIX_WIDTH, D_MODEL), MIX_WIDTH ** -0.5),
        "norm2_w": 1.0 + nrm(ks[6], (DEPTH, D_MODEL), 0.02),
        "router_g_w": nrm(ks[7], (DEPTH, D_MODEL, N_GROUPS), D_MODEL ** -0.5),
        "router_g_b": nrm(ks[8], (DEPTH, N_GROUPS), 0.01),
        "router_e_w": nrm(ks[9], (DEPTH, N_GROUPS, D_MODEL, EXPERTS_PER_GROUP), D_MODEL ** -0.5),
        "router_e_b": nrm(ks[10], (DEPTH, N_GROUPS, EXPERTS_PER_GROUP), 0.01),
        "w_gate": nrm(ks[11], (DEPTH, N_EXPERTS, D_MODEL, EXPERT_FF), D_MODEL ** -0.5),
        "w_up": nrm(ks[12], (DEPTH, N_EXPERTS, D_MODEL, EXPERT_FF), D_MODEL ** -0.5),
        "w_down": nrm(ks[13], (DEPTH, N_EXPERTS, EXPERT_FF, D_MODEL), EXPERT_FF ** -0.5),
        "final_norm_w": 1.0 + nrm(ks[14], (D_MODEL,), 0.02),
    }


def reference(x, norm1_w, w_in, ret_gn_w, conv_w, w_o, norm2_w, router_g_w, router_g_b,
              router_e_w, router_e_b, w_gate, w_up, w_down, final_norm_w):
    for l in range(DEPTH):
        h = rmsnorm(x, norm1_w[l])
        x = x + mixer(h, w_in[l], ret_gn_w[l], conv_w[l], w_o[l])
        h = rmsnorm(x, norm2_w[l])
        x = x + hier_moe(h, router_g_w[l], router_g_b[l], router_e_w[l], router_e_b[l],
                         w_gate[l], w_up[l], w_down[l])
    return rmsnorm(x, final_norm_w)
```

```cpp
#include <hip/hip_runtime.h>
#include <cstdio>
#include <cstdint>

constexpr int NB = 4, SEQ = 4096, D = 1024, M = NB * SEQ;
constexpr int RW = 512, NH = 4, HD = 128, CW = 512, INC = 3584, CH = 128, NCH = SEQ / CH;
constexpr int NG = 8, EPG = 8, NE = 64, FF = 512;
constexpr float EPS = 1e-6f;
constexpr int NWAVES = 8;

#define GAS __attribute__((address_space(1)))
#define LAS __attribute__((address_space(3)))
typedef unsigned short bf16;
typedef unsigned v4u __attribute__((ext_vector_type(4)));
typedef unsigned v2u __attribute__((ext_vector_type(2)));
typedef float f32x4 __attribute__((ext_vector_type(4)));
typedef short bf16x8 __attribute__((ext_vector_type(8)));
typedef GAS unsigned gu32;
#define RLX_AGENT __ATOMIC_RELAXED, __HIP_MEMORY_SCOPE_AGENT
#define LDS_WAIT() asm volatile("s_waitcnt lgkmcnt(0)" ::: "memory")
#define VM_WAIT() asm volatile("s_waitcnt vmcnt(0)" ::: "memory")

__device__ __forceinline__ unsigned f2bf(float f) { unsigned u = __builtin_bit_cast(unsigned, f); return (u + 0x7fffu + ((u >> 16) & 1u)) >> 16; }
__device__ __forceinline__ unsigned pk2(float lo, float hi) { return f2bf(lo) | (f2bf(hi) << 16); }
__device__ __forceinline__ float bf2f(unsigned short b) { return __builtin_bit_cast(float, (unsigned)b << 16); }
__device__ __forceinline__ float bflo(unsigned w) { return __builtin_bit_cast(float, w << 16); }
__device__ __forceinline__ float bfhi(unsigned w) { return __builtin_bit_cast(float, w & 0xffff0000u); }
__device__ __forceinline__ unsigned cvt_pk_bf16(float lo, float hi) { unsigned r; asm volatile("v_cvt_pk_bf16_f32 %0, %1, %2" : "=v"(r) : "v"(lo), "v"(hi)); return r; }

__device__ __forceinline__ int lane_now() { int l; asm volatile("v_mbcnt_lo_u32_b32 %0, -1, 0\n\tv_mbcnt_hi_u32_b32 %0, -1, %0" : "=v"(l)); return l; }
constexpr size_t MiB = 1u << 20;
constexpr size_t WS_CTL = 0, CTL_ZERO_BYTES = 512 * 1024;
constexpr size_t WS_WRT = 1 * MiB;
constexpr size_t WS_ROPE = 2 * MiB;
constexpr size_t WS_WOT = 4 * MiB;
constexpr size_t WS_WINT = 6 * MiB;
constexpr size_t WS_TOKL = 14 * MiB, WS_RSL = 18 * MiB, WS_GATEL = 22 * MiB;
constexpr size_t WS_SSQ = 13 * MiB;
constexpr size_t WS_QB = 224 * MiB, WS_KB = 240 * MiB, WS_VB = 256 * MiB, WS_GB = 272 * MiB, WS_GBB = 288 * MiB, WS_CUB = 304 * MiB, WS_PREVT = 320 * MiB;
constexpr size_t WS_YB = 224 * MiB;
constexpr size_t WS_HB = 288 * MiB;
constexpr size_t WS_XN = 336 * MiB;
constexpr size_t WS_KVT = 368 * MiB;
constexpr size_t WS_MIXB = 368 * MiB;
constexpr size_t WS_END = 400 * MiB;

constexpr int CW_TMO = 0, CW_CODE = 1;
constexpr int CW_E1 = 256, CW_E2 = 320, CW_ECNT = 1024, CW_X1 = 2048, CW_X2 = 3072;
constexpr int CW_BAR = 4096;
constexpr int CW_CNT = 49152, CNT_STRIDE = 1088;

constexpr int RING_OFF = 0, RING_BYTES = 131072;
constexpr int LDSCTL_OFF = RING_BYTES, MISC_OFF = LDSCTL_OFF + 320;
constexpr int LDS_BYTES = 147456;

namespace pg8 {
typedef short s16x4_t __attribute__((ext_vector_type(4)));
typedef short v4i16g_t __attribute__((ext_vector_type(4)));
constexpr int BM = 256, BK = 64, HALF = 128, HTB = HALF * BK * 2, STAGE_BYTES = 8 * HTB, NXCD = 8, WGM = 8;
__host__ __device__ __forceinline__ int lds_byte(int r, int c) { const int st = (r >> 4) * 2 + (c >> 5), rr = r & 15, cc = c & 31, ob = rr * 64 + cc * 2; return st * 1024 + (ob ^ (((ob >> 9) & 1) << 5)); }
__host__ __device__ __forceinline__ void stage_rc(int b, int& R, int& C) { const int st = b / 1024, sb = b % 1024, swz = sb ^ (((sb >> 9) & 1) << 5); R = (st >> 1) * 16 + swz / 64; C = (st & 1) * 32 + (swz % 64) / 2; }
__host__ __device__ __forceinline__ int perm32(int rho) { const int n = rho >> 4, i = rho & 15; return 8 * (i >> 2) + 4 * n + (i & 3); }

struct Unit { int arow0; int pm, pn; int e, rb, nvalid; unsigned B, B1; };

template <class Epi, class Sched, bool GATHER, bool ALIGN_EPI, bool BF32 = false>
__device__ __forceinline__ void gemm_phase(LAS unsigned char* lds, const void* Amat, const unsigned Abytes, const int K, const Sched& S, const Epi& E) {
    const __amdgpu_buffer_rsrc_t rA = __builtin_amdgcn_make_buffer_rsrc((void*)Amat, 0, Abytes, 0x00020000);
    const __amdgpu_buffer_rsrc_t rB0 = __builtin_amdgcn_make_buffer_rsrc((void*)S.Wb0, 0, S.Wbytes, 0x00020000), rB1 = __builtin_amdgcn_make_buffer_rsrc((void*)S.Wb1, 0, S.Wbytes, 0x00020000);
    const int tid = threadIdx.x, wid = __builtin_amdgcn_readfirstlane(tid >> 6), lane = tid & 63, wr = wid >> 2, wc = wid & 3, fr = lane & 15, fq = lane >> 4;
    const int nt = K / BK;
    int Rv[2], Cv[2]; unsigned voffB[2];
#pragma unroll
    for (int i = 0; i < 2; ++i) { stage_rc(tid * 16 + i * 8192, Rv[i], Cv[i]); const int Rb = Epi::PERM ? ((Rv[i] & ~31) + perm32(Rv[i] & 31)) : Rv[i]; voffB[i] = (unsigned)(Rb * K + Cv[i]) * 2u; }
    const unsigned kstep = (unsigned)(BK * 2);
    const unsigned hstepB = (unsigned)(HALF * K * 2);
    const unsigned ldsw = (unsigned)wid * 1024u;
    const int aoff = lds_byte(wr * 64 + fr, fq * 8), boff = lds_byte(wc * 32 + fr, fq * 8);
    size_t ldwb = 0; if constexpr (BF32) ldwb = (size_t)S.ldwb;
    const int bk0 = tid >> 5, bmm = tid & 31;
    const unsigned bwoff = (256u * bk0 + 16u * ((unsigned)(bmm >> 1) ^ ((((unsigned)bk0 & 3u) << 2) | (((unsigned)bk0 >> 2) & 3u)))) + 8u * (((unsigned)bmm & 1u) ^ (((unsigned)bk0 >> 3) & 1u));
    const unsigned bgoff = (unsigned)bk0 * (unsigned)ldwb + (unsigned)bmm * 16u;
    unsigned trb[2][2];
#pragma unroll
    for (int t = 0; t < 2; ++t)
#pragma unroll
        for (int nf = 0; nf < 2; ++nf) { const unsigned row = 8u * fq + 4u * t + ((unsigned)fr >> 2), ch = 4u * wc + ((unsigned)fr & 3u);
            trb[t][nf] = 256u * row + 16u * (ch ^ (((row & 3u) << 2) | ((row >> 2) & 3u))) + 8u * ((unsigned)nf ^ ((unsigned)fq & 1u)); }
    unsigned bgo[4];
#pragma unroll
    for (int i = 0; i < 4; ++i) bgo[i] = bgoff + (unsigned)(16 * i) * (unsigned)ldwb;
    f32x4 R[4];
#define PG8_SA(b, h) (((BF32 ? 4 : 0) + (b) * 2 + (h)) * HTB)
#define PG8_SB(b, h) (((BF32 ? 0 : 4) + (b) * 2 + (h)) * HTB)
#define PG8_STAGE_B(bufoff, so) do { _Pragma("unroll") for (int _i = 0; _i < 2; ++_i) \
        __builtin_amdgcn_raw_ptr_buffer_load_lds(rB0, (LAS void*)(lds + (bufoff) + ldsw + _i * 8192), 16, (int)voffB[_i], (int)(so), 0, 0); } while (0)
#define PG8_STAGE_A(bufoff, vo, kb) do { _Pragma("unroll") for (int _i = 0; _i < 2; ++_i) \
        __builtin_amdgcn_raw_ptr_buffer_load_lds(rA, (LAS void*)(lds + (bufoff) + ldsw + _i * 8192), 16, (int)(vo)[_i], (int)(kb), 0, 0); } while (0)
#define PG8_LDA(dst, b, h) do { _Pragma("unroll") for (int m = 0; m < 4; ++m) _Pragma("unroll") for (int k = 0; k < 2; ++k) dst[m][k] = *(const LAS bf16x8*)(lds + PG8_SA(b, h) + aoff + m * 2048 + k * 1024); } while (0)
#define PG8_LDB(dst, b, h) do { _Pragma("unroll") for (int n = 0; n < 2; ++n) _Pragma("unroll") for (int k = 0; k < 2; ++k) dst[n][k] = *(const LAS bf16x8*)(lds + PG8_SB(b, h) + boff + n * 2048 + k * 1024); } while (0)
#define PG8_BLOAD(h, so, kt) do { const int _so = (int)((so) + (unsigned)(kt) * 64u * (unsigned)ldwb); _Pragma("unroll") for (int _i = 0; _i < 4; ++_i) \
        R[_i] = __builtin_bit_cast(f32x4, __builtin_amdgcn_raw_buffer_load_b128((h) ? rB1 : rB0, (int)bgo[_i], _so, 0)); } while (0)
#define PG8_BWRITE(bufoff) do { _Pragma("unroll") for (int _i = 0; _i < 4; ++_i) { v2u _w; _w.x = cvt_pk_bf16(R[_i].x, R[_i].y); _w.y = cvt_pk_bf16(R[_i].z, R[_i].w); *(LAS v2u*)(lds + (bufoff) + bwoff + 4096 * _i) = _w; } } while (0)
#define PG8_TR(addr) __builtin_bit_cast(s16x4_t, __builtin_amdgcn_ds_read_tr16_b64_v4i16((LAS v4i16g_t*)(addr)))
#define PG8_LDBT(dst, b, h) do { _Pragma("unroll") for (int n = 0; n < 2; ++n) _Pragma("unroll") for (int k = 0; k < 2; ++k) { \
        const s16x4_t _lo = PG8_TR(lds + PG8_SB(b, h) + trb[0][n] + 8192 * k), _hi = PG8_TR(lds + PG8_SB(b, h) + trb[1][n] + 8192 * k); \
        dst[n][k] = (bf16x8){_lo[0], _lo[1], _lo[2], _lo[3], _hi[0], _hi[1], _hi[2], _hi[3]}; } } while (0)
#define PG8_LDBX(dst, b, h) do { if constexpr (BF32) { PG8_LDBT(dst, b, h); } else { PG8_LDB(dst, b, h); } } while (0)
#define PG8_MMA(ai, bj, At, Bt) do { __builtin_amdgcn_s_setprio(1); _Pragma("unroll") for (int m = 0; m < 4; ++m) _Pragma("unroll") for (int n = 0; n < 2; ++n) _Pragma("unroll") for (int k = 0; k < 2; ++k) \
        acc[ai][bj][m][n] = __builtin_amdgcn_mfma_f32_16x16x32_bf16(Bt[n][k], At[m][k], acc[ai][bj][m][n], 0, 0, 0); __builtin_amdgcn_s_setprio(0); } while (0)
#define PG8_WAIT_V(n) asm volatile("s_waitcnt vmcnt(" #n ")" ::: "memory")
#define PG8_WAIT_L(n) asm volatile("s_waitcnt lgkmcnt(" #n ")" ::: "memory")
#define PG8_BAR __builtin_amdgcn_s_barrier()
#define PG8_SCHED __builtin_amdgcn_sched_barrier(0)
#define PG8_SETVO(vo, u) do { _Pragma("unroll") for (int _h = 0; _h < 2; ++_h) _Pragma("unroll") for (int _i = 0; _i < 2; ++_i) { \
        const int _row = GATHER ? S.arow(u, _h * HALF + Rv[_i]) : (u).arow0 + _h * HALF + Rv[_i]; (vo)[_h][_i] = (unsigned)(_row * K + Cv[_i]) * 2u; } } while (0)
    Unit cur, nxt; int ui = 0;
    if (!S.next(0, cur)) return;
    unsigned voC[2][2], voN[2][2];
    PG8_SETVO(voC, cur);
    f32x4 acc[2][2][4][2];
#pragma unroll
    for (int a = 0; a < 2; ++a)
#pragma unroll
        for (int b = 0; b < 2; ++b)
#pragma unroll
            for (int m = 0; m < 4; ++m)
#pragma unroll
                for (int n = 0; n < 2; ++n) acc[a][b][m][n] = (f32x4){0.f, 0.f, 0.f, 0.f};
    bf16x8 At[4][2], B0[2][2], B1[2][2];
    unsigned cB = cur.B, cB1 = cur.B1;
    if constexpr (BF32) {
        PG8_STAGE_A(PG8_SA(0, 0), voC[0], 0); PG8_STAGE_A(PG8_SA(0, 1), voC[1], 0);
        PG8_BLOAD(0, cB, 0); PG8_BWRITE(PG8_SB(0, 0)); PG8_BLOAD(1, cB1, 0); PG8_BWRITE(PG8_SB(0, 1));
        PG8_WAIT_V(0); PG8_WAIT_L(0);
        if (wr == 1) PG8_BAR;
        PG8_BAR;
        PG8_STAGE_A(PG8_SA(1, 0), voC[0], kstep); PG8_BLOAD(0, cB, 1);
        PG8_BAR;
    } else {
    PG8_STAGE_B(PG8_SB(0, 0), cB); PG8_STAGE_B(PG8_SB(0, 1), cB + hstepB); PG8_STAGE_A(PG8_SA(0, 0), voC[0], 0); PG8_STAGE_A(PG8_SA(0, 1), voC[1], 0);
    if (wr == 1) PG8_BAR;
    PG8_WAIT_V(2); PG8_BAR;
    PG8_STAGE_B(PG8_SB(1, 0), cB + kstep); PG8_STAGE_A(PG8_SA(1, 0), voC[0], kstep); PG8_STAGE_B(PG8_SB(1, 1), cB + hstepB + kstep);
    PG8_WAIT_V(6); PG8_BAR;
    }
    for (;;) {
        const bool has_next = S.next(ui + 1, nxt);
        const unsigned nB = has_next ? nxt.B : cB, nB1 = has_next ? nxt.B1 : cB1;
        if (has_next) { PG8_SETVO(voN, nxt); } else {
#pragma unroll
            for (int h = 0; h < 2; ++h)
#pragma unroll
                for (int i = 0; i < 2; ++i) voN[h][i] = voC[h][i]; }
        for (int t = 0; t < nt; t += 2) {
            const bool last = (t == nt - 2);
            const unsigned kb1 = (unsigned)(t + 1) * kstep;
            const unsigned kb2 = last ? 0u : (unsigned)(t + 2) * kstep, kb3 = kb2 + kstep;
            const unsigned b2 = last ? nB : cB + (unsigned)(t + 2) * kstep, b3 = b2 + kstep;
            unsigned vo2[2][2];
#pragma unroll
            for (int h = 0; h < 2; ++h)
#pragma unroll
                for (int i = 0; i < 2; ++i) vo2[h][i] = last ? voN[h][i] : voC[h][i];
            if constexpr (BF32) {
            const unsigned h20 = last ? nB : cB; const int kt2 = last ? 0 : t + 2;
            PG8_LDBT(B0, 0, 0); PG8_SCHED; PG8_LDA(At, 0, 0); PG8_BWRITE(PG8_SB(1, 0)); PG8_STAGE_A(PG8_SA(1, 1), voC[1], kb1); PG8_BLOAD(1, cB1, t + 1);
            PG8_WAIT_L(0); PG8_BAR; PG8_MMA(0, 0, At, B0); PG8_SCHED; PG8_LDBT(B0, 0, 1); PG8_WAIT_L(0); PG8_SCHED; PG8_MMA(0, 1, At, B0); PG8_BAR; PG8_SCHED;
            PG8_LDBT(B0, 0, 0); PG8_SCHED; PG8_LDA(At, 0, 1); PG8_BWRITE(PG8_SB(1, 1)); PG8_STAGE_A(PG8_SA(0, 0), vo2[0], kb2); PG8_BLOAD(0, h20, kt2);
            PG8_WAIT_L(0); PG8_BAR; PG8_MMA(1, 0, At, B0); PG8_SCHED; PG8_LDBT(B0, 0, 1); PG8_WAIT_L(0); PG8_SCHED; PG8_MMA(1, 1, At, B0); PG8_BAR; PG8_SCHED;
            const unsigned h21 = last ? nB1 : cB1;
            PG8_LDBT(B0, 1, 0); PG8_SCHED; PG8_LDA(At, 1, 0); PG8_BWRITE(PG8_SB(0, 0)); PG8_STAGE_A(PG8_SA(0, 1), vo2[1], kb2); PG8_BLOAD(1, h21, kt2);
            PG8_WAIT_L(0); PG8_BAR; PG8_MMA(0, 0, At, B0); PG8_SCHED; PG8_LDBT(B0, 1, 1); PG8_WAIT_L(0); PG8_SCHED; PG8_MMA(0, 1, At, B0); PG8_BAR; PG8_SCHED;
            PG8_LDA(At, 1, 1); PG8_LDBT(B0, 1, 0); PG8_SCHED; PG8_BWRITE(PG8_SB(0, 1)); PG8_STAGE_A(PG8_SA(1, 0), vo2[0], kb3); PG8_BLOAD(0, h20, kt2 + 1);
            PG8_WAIT_L(0); PG8_BAR; PG8_MMA(1, 0, At, B0); PG8_SCHED; PG8_LDBT(B0, 1, 1); PG8_WAIT_L(0); PG8_SCHED; PG8_MMA(1, 1, At, B0); PG8_BAR; PG8_SCHED;
            } else {
            PG8_LDB(B0, 0, 0); PG8_LDB(B1, 0, 1); PG8_SCHED; PG8_LDA(At, 0, 0); PG8_STAGE_A(PG8_SA(1, 1), voC[1], kb1);
            PG8_WAIT_V(8); PG8_WAIT_L(0); PG8_BAR; PG8_MMA(0, 0, At, B0); PG8_MMA(0, 1, At, B1); PG8_BAR; PG8_SCHED;
            PG8_LDA(At, 0, 1); PG8_STAGE_B(PG8_SB(0, 0), b2); PG8_STAGE_B(PG8_SB(0, 1), b2 + hstepB); PG8_STAGE_A(PG8_SA(0, 0), vo2[0], kb2);
            PG8_WAIT_V(8); PG8_WAIT_L(0); PG8_BAR; PG8_MMA(1, 0, At, B0); PG8_MMA(1, 1, At, B1); PG8_BAR; PG8_SCHED;
            PG8_LDB(B0, 1, 0); PG8_LDB(B1, 1, 1); PG8_SCHED; PG8_LDA(At, 1, 0); PG8_STAGE_A(PG8_SA(0, 1), vo2[1], kb2);
            PG8_WAIT_V(8); PG8_WAIT_L(0); PG8_BAR; PG8_MMA(0, 0, At, B0); PG8_MMA(0, 1, At, B1); PG8_BAR; PG8_SCHED;
            PG8_LDA(At, 1, 1); PG8_STAGE_B(PG8_SB(1, 0), b3); PG8_STAGE_B(PG8_SB(1, 1), b3 + hstepB); PG8_STAGE_A(PG8_SA(1, 0), vo2[0], kb3);
            PG8_WAIT_V(8); PG8_WAIT_L(0); PG8_BAR; PG8_MMA(1, 0, At, B0); PG8_MMA(1, 1, At, B1); PG8_BAR; PG8_SCHED;
            }
        }
        if constexpr (ALIGN_EPI) { if (wr == 0) PG8_BAR; }
        E(acc, cur, wr, wc, fr, fq);
        if (!has_next) break;
#pragma unroll
        for (int a = 0; a < 2; ++a)
#pragma unroll
            for (int b = 0; b < 2; ++b)
#pragma unroll
                for (int m = 0; m < 4; ++m)
#pragma unroll
                    for (int n = 0; n < 2; ++n) acc[a][b][m][n] = (f32x4){0.f, 0.f, 0.f, 0.f};
        cur = nxt; cB = nB; cB1 = nB1; ++ui;
#pragma unroll
        for (int h = 0; h < 2; ++h)
#pragma unroll
            for (int i = 0; i < 2; ++i) voC[h][i] = voN[h][i];
        if constexpr (ALIGN_EPI) { if (wr == 1) PG8_BAR; }
    }
    PG8_WAIT_V(0);
    if constexpr (!ALIGN_EPI) { if (wr == 0) PG8_BAR; }
    PG8_BAR;
#undef PG8_SA
#undef PG8_SB
#undef PG8_STAGE_A
#undef PG8_STAGE_B
#undef PG8_LDA
#undef PG8_LDB
#undef PG8_LDBT
#undef PG8_LDBX
#undef PG8_TR
#undef PG8_BLOAD
#undef PG8_BWRITE
#undef PG8_MMA
#undef PG8_WAIT_V
#undef PG8_WAIT_L
#undef PG8_BAR
#undef PG8_SCHED
#undef PG8_SETVO
}
}


namespace mz {
using pg8::lds_byte; using pg8::stage_rc; using pg8::Unit; using pg8::s16x4_t; using pg8::v4i16g_t;
template <class Epi, class Sched, bool GATHER>
__device__ __forceinline__ void gemm_z(LAS unsigned char* lds, const void* Amat, const unsigned Abytes, const int K, const Sched& S, const Epi& E) {
    const __amdgpu_buffer_rsrc_t rA = __builtin_amdgcn_make_buffer_rsrc((void*)Amat, 0, Abytes, 0x00020000);
    const __amdgpu_buffer_rsrc_t rB0 = __builtin_amdgcn_make_buffer_rsrc((void*)S.Wb0, 0, S.Wbytes, 0x00020000), rB1 = __builtin_amdgcn_make_buffer_rsrc((void*)S.Wb1, 0, S.Wbytes, 0x00020000);
    const int tid = threadIdx.x, wid = __builtin_amdgcn_readfirstlane(tid >> 6), lane = tid & 63, wr = wid >> 2, wc = wid & 3, fr = lane & 15, fq = lane >> 4;
    const int nt = K / 64;
    const unsigned ldwb = (unsigned)S.ldwb, ktb = 64u * ldwb;
    int Rv[2], Cv[2];
#pragma unroll
    for (int i = 0; i < 2; ++i) stage_rc(tid * 16 + i * 8192, Rv[i], Cv[i]);
    const unsigned ldsw = (unsigned)wid * 1024u;
    const int aoff = lds_byte(wr * 64 + fr, fq * 8);
    const int bk0 = tid >> 5, bmm = tid & 31;
    const unsigned bwoff = (256u * bk0 + 16u * ((unsigned)(bmm >> 1) ^ ((((unsigned)bk0 & 3u) << 2) | (((unsigned)bk0 >> 2) & 3u)))) + 8u * (((unsigned)bmm & 1u) ^ (((unsigned)bk0 >> 3) & 1u));
    unsigned bgo[4];
#pragma unroll
    for (int i = 0; i < 4; ++i) bgo[i] = (unsigned)(bk0 + 16 * i) * ldwb + (unsigned)bmm * 16u;
    unsigned trb[2][2];
#pragma unroll
    for (int t = 0; t < 2; ++t)
#pragma unroll
        for (int nf = 0; nf < 2; ++nf) { const unsigned row = 8u * fq + 4u * t + ((unsigned)fr >> 2), ch = 4u * wc + ((unsigned)fr & 3u);
            trb[t][nf] = 256u * row + 16u * (ch ^ (((row & 3u) << 2) | ((row >> 2) & 3u))) + 8u * ((unsigned)nf ^ ((unsigned)fq & 1u)); }
#define MZ_SB(p, h) (((p) * 2 + (h)) * 16384)
#define MZ_SA(q) (65536 + (q) * 16384)
#define MZ_STAGE_A(q, vo, kb) do { _Pragma("unroll") for (int _i = 0; _i < 2; ++_i) \
        __builtin_amdgcn_raw_ptr_buffer_load_lds(rA, (LAS void*)(lds + MZ_SA(q) + ldsw + _i * 8192), 16, (int)(vo)[_i], (int)(kb), 0, 0); } while (0)
#define MZ_BLOAD(X, so0, so1, kt) do { const int _s0 = (int)((so0) + (unsigned)(kt) * ktb), _s1 = (int)((so1) + (unsigned)(kt) * ktb); _Pragma("unroll") for (int _i = 0; _i < 4; ++_i) { \
        X[0][_i] = __builtin_bit_cast(f32x4, __builtin_amdgcn_raw_buffer_load_b128(rB0, (int)bgo[_i], _s0, 0)); X[1][_i] = __builtin_bit_cast(f32x4, __builtin_amdgcn_raw_buffer_load_b128(rB1, (int)bgo[_i], _s1, 0)); } } while (0)
#define MZ_BWRITE(X, p) do { _Pragma("unroll") for (int _h = 0; _h < 2; ++_h) _Pragma("unroll") for (int _i = 0; _i < 4; ++_i) { v2u _w; _w.x = cvt_pk_bf16(X[_h][_i].x, X[_h][_i].y); _w.y = cvt_pk_bf16(X[_h][_i].z, X[_h][_i].w); \
        *(LAS v2u*)(lds + MZ_SB(p, _h) + bwoff + 4096 * _i) = _w; } } while (0)
#define MZ_TR(addr) __builtin_bit_cast(s16x4_t, __builtin_amdgcn_ds_read_tr16_b64_v4i16((LAS v4i16g_t*)(addr)))
#define MZ_LDB(dst, p, h) do { _Pragma("unroll") for (int n = 0; n < 2; ++n) _Pragma("unroll") for (int k = 0; k < 2; ++k) { \
        const s16x4_t _lo = MZ_TR(lds + MZ_SB(p, h) + trb[0][n] + 8192 * k), _hi = MZ_TR(lds + MZ_SB(p, h) + trb[1][n] + 8192 * k); \
        dst[n][k] = (bf16x8){_lo[0], _lo[1], _lo[2], _lo[3], _hi[0], _hi[1], _hi[2], _hi[3]}; } } while (0)
#define MZ_LDA(q) do { _Pragma("unroll") for (int m = 0; m < 4; ++m) _Pragma("unroll") for (int k = 0; k < 2; ++k) At[m][k] = *(const LAS bf16x8*)(lds + MZ_SA(q) + aoff + m * 2048 + k * 1024); } while (0)
#define MZ_MMA() do { __builtin_amdgcn_s_setprio(1); _Pragma("unroll") for (int m = 0; m < 4; ++m) _Pragma("unroll") for (int n = 0; n < 2; ++n) _Pragma("unroll") for (int k = 0; k < 2; ++k) { \
        acc[0][m][n] = __builtin_amdgcn_mfma_f32_16x16x32_bf16(B0[n][k], At[m][k], acc[0][m][n], 0, 0, 0); acc[1][m][n] = __builtin_amdgcn_mfma_f32_16x16x32_bf16(B1[n][k], At[m][k], acc[1][m][n], 0, 0, 0); } \
        __builtin_amdgcn_s_setprio(0); } while (0)
#define MZ_WAIT_V(n) asm volatile("s_waitcnt vmcnt(" #n ")" ::: "memory")
#define MZ_WAIT_L(n) asm volatile("s_waitcnt lgkmcnt(" #n ")" ::: "memory")
#define MZ_BAR __builtin_amdgcn_s_barrier()
#define MZ_SCHED __builtin_amdgcn_sched_barrier(0)
#define MZ_SETVO(vo, u) do { _Pragma("unroll") for (int _i = 0; _i < 2; ++_i) { const int _row = GATHER ? S.arow(u, Rv[_i]) : (u).arow0 + Rv[_i]; (vo)[_i] = (unsigned)(_row * K + Cv[_i]) * 2u; } } while (0)
#define MZ_SP(q, p, X, avo, akb, b0, b1, bkt) do { \
        MZ_LDA(q); MZ_LDB(B0, p, 0); MZ_LDB(B1, p, 1); MZ_SCHED; MZ_BWRITE(X, (p) ^ 1); MZ_STAGE_A(((q) + 2) & 3, avo, akb); MZ_BLOAD(X, b0, b1, bkt); \
        MZ_WAIT_V(18); MZ_WAIT_L(0); MZ_BAR; MZ_MMA(); MZ_BAR; MZ_SCHED; } while (0)
    Unit cur, nxt; int ui = 0;
    if (!S.next(0, cur)) return;
    unsigned voC[2], voN[2];
    MZ_SETVO(voC, cur);
    f32x4 acc[2][4][2];
#pragma unroll
    for (int b = 0; b < 2; ++b)
#pragma unroll
        for (int m = 0; m < 4; ++m)
#pragma unroll
            for (int n = 0; n < 2; ++n) acc[b][m][n] = (f32x4){0.f, 0.f, 0.f, 0.f};
    bf16x8 At[4][2], B0[2][2], B1[2][2];
    f32x4 P[2][4], Q[2][4];
    MZ_STAGE_A(0, voC, 0); MZ_STAGE_A(1, voC, 128);
    MZ_BLOAD(P, cur.B, cur.B1, 0); MZ_BWRITE(P, 0);
    MZ_WAIT_V(0); MZ_WAIT_L(0);
    if (wr == 1) MZ_BAR;
    MZ_BAR;
    MZ_BLOAD(P, cur.B, cur.B1, 1); MZ_BLOAD(Q, cur.B, cur.B1, 2);
    for (;;) {
        const bool has_next = S.next(ui + 1, nxt);
        const unsigned nB = has_next ? nxt.B : cur.B, nB1 = has_next ? nxt.B1 : cur.B1;
        if (has_next) { MZ_SETVO(voN, nxt); } else { voN[0] = voC[0]; voN[1] = voC[1]; }
        for (int t = 0; t < nt; t += 4) {
            const bool last = (t == nt - 4);
            MZ_SP(0, 0, P, voC, (unsigned)(t + 2) * 128u, cur.B, cur.B1, t + 3);
            { const unsigned b0 = last ? nB : cur.B, b1 = last ? nB1 : cur.B1; const int bkt = last ? 0 : t + 4;
              MZ_SP(1, 1, Q, voC, (unsigned)(t + 3) * 128u, b0, b1, bkt); }
            { const unsigned b0 = last ? nB : cur.B, b1 = last ? nB1 : cur.B1; const int bkt = last ? 1 : t + 5;
              unsigned av[2]; av[0] = last ? voN[0] : voC[0]; av[1] = last ? voN[1] : voC[1]; const unsigned akb = last ? 0u : (unsigned)(t + 4) * 128u;
              MZ_SP(2, 0, P, av, akb, b0, b1, bkt); }
            { const unsigned b0 = last ? nB : cur.B, b1 = last ? nB1 : cur.B1; const int bkt = last ? 2 : t + 6;
              unsigned av[2]; av[0] = last ? voN[0] : voC[0]; av[1] = last ? voN[1] : voC[1]; const unsigned akb = last ? 128u : (unsigned)(t + 5) * 128u;
              MZ_SP(3, 1, Q, av, akb, b0, b1, bkt); }
        }
        if (wr == 0) MZ_BAR;
        E(acc, cur, wr, wc, fr, fq);
        if (!has_next) break;
#pragma unroll
        for (int b = 0; b < 2; ++b)
#pragma unroll
            for (int m = 0; m < 4; ++m)
#pragma unroll
                for (int n = 0; n < 2; ++n) acc[b][m][n] = (f32x4){0.f, 0.f, 0.f, 0.f};
        cur = nxt; ++ui; voC[0] = voN[0]; voC[1] = voN[1];
        if (wr == 1) MZ_BAR;
    }
    MZ_WAIT_V(0);
    MZ_BAR;
#undef MZ_SB
#undef MZ_SA
#undef MZ_STAGE_A
#undef MZ_BLOAD
#undef MZ_BWRITE
#undef MZ_TR
#undef MZ_LDB
#undef MZ_LDA
#undef MZ_MMA
#undef MZ_WAIT_V
#undef MZ_WAIT_L
#undef MZ_BAR
#undef MZ_SCHED
#undef MZ_SETVO
#undef MZ_SP
}
}


namespace mw {
using pg8::lds_byte; using pg8::stage_rc; using pg8::Unit; using pg8::s16x4_t; using pg8::v4i16g_t;
template <class Epi, class Sched, bool GATHER>
__device__ __forceinline__ void gemm_w(LAS unsigned char* lds, const void* Amat, const unsigned Abytes, const int K, const Sched& S, const Epi& E) {
    const __amdgpu_buffer_rsrc_t rA = __builtin_amdgcn_make_buffer_rsrc((void*)Amat, 0, Abytes, 0x00020000);
    const __amdgpu_buffer_rsrc_t rB0 = __builtin_amdgcn_make_buffer_rsrc((void*)S.Wb0, 0, S.Wbytes, 0x00020000), rB1 = __builtin_amdgcn_make_buffer_rsrc((void*)S.Wb1, 0, S.Wbytes, 0x00020000);
    const int wid = S.wave, lane = lane_now(), tid = wid * 64 + lane, wr = wid >> 2, wc = wid & 3, fr = lane & 15, fq = lane >> 4;
    const int nt = K / 64;
    const unsigned ldwb = (unsigned)S.ldwb, ktb = 64u * ldwb, pstep = 16u * ldwb, hA = (unsigned)(128 * K * 2);
    int Rv[2], Cv[2]; unsigned al[2];
#pragma unroll
    for (int i = 0; i < 2; ++i) { stage_rc(tid * 16 + i * 8192, Rv[i], Cv[i]); al[i] = (unsigned)(Rv[i] * K + Cv[i]) * 2u; }
    const unsigned ldsw = (unsigned)wid * 1024u;
    const int aoff = lds_byte(wr * 64 + fr, fq * 8);
    const int bk0 = tid >> 5, bmm = tid & 31;
    const unsigned bwoff = (256u * bk0 + 16u * ((unsigned)(bmm >> 1) ^ ((((unsigned)bk0 & 3u) << 2) | (((unsigned)bk0 >> 2) & 3u)))) + 8u * (((unsigned)bmm & 1u) ^ (((unsigned)bk0 >> 3) & 1u));
    const unsigned bgoff = (unsigned)bk0 * ldwb + (unsigned)bmm * 16u;
    unsigned trb[2];
#pragma unroll
    for (int t = 0; t < 2; ++t) { const unsigned row = 8u * fq + 4u * t + ((unsigned)fr >> 2), ch = 4u * wc + ((unsigned)fr & 3u);
        trb[t] = 256u * row + 16u * (ch ^ (((row & 3u) << 2) | ((row >> 2) & 3u))) + 8u * ((unsigned)fq & 1u); }
#define MW_SB(b, h) (((b) * 2 + (h)) * 16384)
#define MW_SA(b, h) ((4 + (b) * 2 + (h)) * 16384)
#define MW_VO_voC(h, i) voC[h][i]
#define MW_VO_voN(h, i) voNt[(2 * (h) + (i)) * 512]
#define MW_STAGE_A(b, h, vo, uo, kb) do { _Pragma("unroll") for (int _i = 0; _i < 2; ++_i) { \
        if constexpr (GATHER) __builtin_amdgcn_raw_ptr_buffer_load_lds(rA, (LAS void*)(lds + MW_SA(b, h) + ldsw + _i * 8192), 16, (int)MW_VO_##vo(h, _i), (int)(kb), 0, 0); \
        else __builtin_amdgcn_raw_ptr_buffer_load_lds(rA, (LAS void*)(lds + MW_SA(b, h) + ldsw + _i * 8192), 16, (int)al[_i], (int)((uo) + (h) * hA + (kb)), 0, 0); } } while (0)
#define MW_BLOAD(X, h, so, kt) do { const unsigned _s = (so) + (unsigned)(kt) * ktb; _Pragma("unroll") for (int _i = 0; _i < 4; ++_i) \
        X[_i] = __builtin_bit_cast(f32x4, __builtin_amdgcn_raw_buffer_load_b128((h) ? rB1 : rB0, (int)bgoff, (int)(_s + (unsigned)_i * pstep), 0)); } while (0)
#define MW_BWRITE(X, b, h) do { _Pragma("unroll") for (int _i = 0; _i < 4; ++_i) { v2u _w; _w.x = cvt_pk_bf16(X[_i].x, X[_i].y); _w.y = cvt_pk_bf16(X[_i].z, X[_i].w); *(LAS v2u*)(lds + MW_SB(b, h) + bwoff + 4096 * _i) = _w; } } while (0)
#define MW_TR(addr) __builtin_bit_cast(s16x4_t, __builtin_amdgcn_ds_read_tr16_b64_v4i16((LAS v4i16g_t*)(addr)))
#define MW_LDB(b, h) do { _Pragma("unroll") for (int n = 0; n < 2; ++n) _Pragma("unroll") for (int k = 0; k < 2; ++k) { \
        const s16x4_t _lo = MW_TR(lds + MW_SB(b, h) + (trb[0] ^ (8u * n)) + 8192 * k), _hi = MW_TR(lds + MW_SB(b, h) + (trb[1] ^ (8u * n)) + 8192 * k); \
        B0[n][k] = (bf16x8){_lo[0], _lo[1], _lo[2], _lo[3], _hi[0], _hi[1], _hi[2], _hi[3]}; } } while (0)
#define MW_LDA(b, h) do { _Pragma("unroll") for (int m = 0; m < 4; ++m) _Pragma("unroll") for (int k = 0; k < 2; ++k) At[m][k] = *(const LAS bf16x8*)(lds + MW_SA(b, h) + aoff + m * 2048 + k * 1024); } while (0)
#define MW_MMA(ai, bj) do { __builtin_amdgcn_s_setprio(1); _Pragma("unroll") for (int m = 0; m < 4; ++m) _Pragma("unroll") for (int n = 0; n < 2; ++n) _Pragma("unroll") for (int k = 0; k < 2; ++k) \
        asm volatile("v_mfma_f32_16x16x32_bf16 %0, %1, %2, %0" : "+v"(acc[ai][bj][m][n]) : "v"(B0[n][k]), "v"(At[m][k]));   \
        __builtin_amdgcn_s_setprio(0); } while (0)
#define MW_WAIT_V(n) asm volatile("s_waitcnt vmcnt(" #n ")" ::: "memory")
#define MW_WAIT_L(n) asm volatile("s_waitcnt lgkmcnt(" #n ")" ::: "memory")
#define MW_BAR __builtin_amdgcn_s_barrier()
#define MW_SCHED __builtin_amdgcn_sched_barrier(0)
#define MW_SETVO(vo, u) do { if constexpr (GATHER) { const int _t = wid * 64 + lane_now();   \
        _Pragma("unroll") for (int _i = 0; _i < 2; ++_i) { int _R, _C; stage_rc(_t * 16 + _i * 8192, _R, _C); _Pragma("unroll") for (int _h = 0; _h < 2; ++_h) { \
        const int _row = S.arow(u, _h * 128 + _R); MW_VO_##vo(_h, _i) = (unsigned)(_row * K + _C) * 2u; } } } } while (0)
#define MW_SP(rb, ai, X, wb, wh, sb, sh, svo, suo, skb, lh, lso, lkt) do { \
        MW_LDB(rb, 0); MW_SCHED; MW_LDA(rb, ai); MW_BWRITE(X, wb, wh); MW_STAGE_A(sb, sh, svo, suo, skb); MW_BLOAD(X, lh, lso, lkt); \
        MW_WAIT_L(0); MW_BAR; MW_MMA(ai, 0); MW_SCHED; MW_LDB(rb, 1); MW_WAIT_L(0); MW_SCHED; MW_MMA(ai, 1); MW_BAR; MW_SCHED; } while (0)
    Unit cur, nxt; int ui = 0;
    if (!S.next(0, cur)) return;
    unsigned voC[2][2];
    LAS unsigned* const voNt = (LAS unsigned*)(lds + 131072 + 2048) + tid;
    MW_SETVO(voC, cur);
    f32x4 acc[2][2][4][2];
#pragma unroll
    for (int a = 0; a < 2; ++a)
#pragma unroll
        for (int b = 0; b < 2; ++b)
#pragma unroll
            for (int m = 0; m < 4; ++m)
#pragma unroll
                for (int n = 0; n < 2; ++n) acc[a][b][m][n] = (f32x4){0.f, 0.f, 0.f, 0.f};
    bf16x8 At[4][2], B0[2][2];
    f32x4 X[4], Y[4];
    unsigned cU = (unsigned)cur.arow0 * (unsigned)(K * 2);
    MW_STAGE_A(0, 0, voC, cU, 0u); MW_STAGE_A(0, 1, voC, cU, 0u);
    MW_BLOAD(X, 0, cur.B, 0); MW_BWRITE(X, 0, 0); MW_BLOAD(Y, 1, cur.B1, 0); MW_BWRITE(Y, 0, 1);
    MW_WAIT_V(0); MW_WAIT_L(0);
    if (wr == 1) MW_BAR;
    MW_BAR;
    MW_STAGE_A(1, 0, voC, cU, 128u); MW_BLOAD(X, 0, cur.B, 1); MW_BLOAD(Y, 1, cur.B1, 1);
    MW_BAR;
    for (;;) {
        const bool has_next = S.next(ui + 1, nxt);
        const unsigned nB = has_next ? nxt.B : cur.B, nB1 = has_next ? nxt.B1 : cur.B1, nU = has_next ? (unsigned)nxt.arow0 * (unsigned)(K * 2) : cU;
        if constexpr (GATHER) { if (has_next) { MW_SETVO(voN, nxt); } else {
#pragma unroll
            for (int h = 0; h < 2; ++h)
#pragma unroll
                for (int i = 0; i < 2; ++i) MW_VO_voN(h, i) = voC[h][i]; } }
        for (int t = 0; t < nt - 2; t += 2) {
            MW_SP(0, 0, X, 1, 0, 1, 1, voC, cU, (unsigned)(t + 1) * 128u, 0, cur.B, t + 2);
            MW_SP(0, 1, Y, 1, 1, 0, 0, voC, cU, (unsigned)(t + 2) * 128u, 1, cur.B1, t + 2);
            MW_SP(1, 0, X, 0, 0, 0, 1, voC, cU, (unsigned)(t + 2) * 128u, 0, cur.B, t + 3);
            MW_SP(1, 1, Y, 0, 1, 1, 0, voC, cU, (unsigned)(t + 3) * 128u, 1, cur.B1, t + 3);
        }
        {
            const int t = nt - 2;
            MW_SP(0, 0, X, 1, 0, 1, 1, voC, cU, (unsigned)(t + 1) * 128u, 0, nB, 0);
            MW_SP(0, 1, Y, 1, 1, 0, 0, voN, nU, 0u, 1, nB1, 0);
            MW_SP(1, 0, X, 0, 0, 0, 1, voN, nU, 0u, 0, nB, 1);
            MW_SP(1, 1, Y, 0, 1, 1, 0, voN, nU, 128u, 1, nB1, 1);
        }
        asm volatile("s_nop 15\n\ts_nop 7" ::: "memory");
        if (wr == 0) MW_BAR;
        E(acc, cur, wr, wc, fr, fq);
        if (!has_next) break;
#pragma unroll
        for (int a = 0; a < 2; ++a)
#pragma unroll
            for (int b = 0; b < 2; ++b)
#pragma unroll
                for (int m = 0; m < 4; ++m)
#pragma unroll
                    for (int n = 0; n < 2; ++n) acc[a][b][m][n] = (f32x4){0.f, 0.f, 0.f, 0.f};
        cur = nxt; cU = nU; ++ui;
        if constexpr (GATHER) {
#pragma unroll
            for (int h = 0; h < 2; ++h)
#pragma unroll
                for (int i = 0; i < 2; ++i) voC[h][i] = MW_VO_voN(h, i); }
        if (wr == 1) MW_BAR;
    }
    MW_WAIT_V(0);
    MW_BAR;
#undef MW_SB
#undef MW_SA
#undef MW_STAGE_A
#undef MW_BLOAD
#undef MW_BWRITE
#undef MW_TR
#undef MW_LDB
#undef MW_LDA
#undef MW_MMA
#undef MW_WAIT_V
#undef MW_WAIT_L
#undef MW_BAR
#undef MW_SCHED
#undef MW_SETVO
#undef MW_VO_voC
#undef MW_VO_voN
#undef MW_SP
}
}

#define XB_TMO      128
#define XB_XCNT(j)  (256  + 64 * (j))
#define XB_XSUB(j)  (1280 + 64 * (j))
#define XB_XGEN(j)  (2304 + 64 * (j))
#define XB_TOP      3328
#define XB_TOPGEN   3392
#define XCD_BAR_WORDS 3456
#define XB_SPIN_CAP (1u << 18)
__device__ __forceinline__ unsigned xb_ld(unsigned* p)              { return __hip_atomic_load(p, __ATOMIC_RELAXED, __HIP_MEMORY_SCOPE_AGENT); }
__device__ __forceinline__ unsigned xb_add(unsigned* p, unsigned v) { return __hip_atomic_fetch_add(p, v, __ATOMIC_RELAXED, __HIP_MEMORY_SCOPE_AGENT); }
__device__ __forceinline__ unsigned xb_xcc_id() { return (unsigned)__builtin_amdgcn_s_getreg((3 << 11) | 20) & 0xFu; }
#define XB_SPIN(cond, bar) do { unsigned _sp = 0; while (cond) { __builtin_amdgcn_s_sleep(1); \
    if ((++_sp & 255u) == 0u) { if (xb_ld(&(bar)[XB_TMO])) break; if (_sp > XB_SPIN_CAP) { atomicAdd(&(bar)[XB_TMO], 1u); break; } } } } while (0)
struct XcdBarrier { unsigned* bar; unsigned x; volatile LAS unsigned* st; };
__device__ __forceinline__ XcdBarrier xcd_barrier_post(unsigned* bar, volatile LAS unsigned* st) {
    XcdBarrier b; b.bar = bar; b.x = xb_xcc_id(); b.st = st;
    if (threadIdx.x == 0) (void)xb_add(&bar[XB_XCNT(b.x)], 1u);
    return b;
}
__device__ __forceinline__ void xcd_barrier_complete(unsigned* bar, unsigned x, unsigned& nloc, unsigned& nx) {
    const unsigned G = gridDim.x * gridDim.y * gridDim.z;
    unsigned sum, cnt, mine, sp = 0u;
    for (;;) {
        sum = 0u; cnt = 0u; mine = 0u;
#pragma unroll
        for (unsigned j = 0; j < 16; ++j) { const unsigned c = xb_ld(&bar[XB_XCNT(j)]); sum += c; cnt += (c > 0u) ? 1u : 0u; mine = (j == x) ? c : mine; }
        if (sum == G) break;
        __builtin_amdgcn_s_sleep(1);
        if ((++sp & 255u) == 0u) { if (xb_ld(&bar[XB_TMO])) break; if (sp > XB_SPIN_CAP) { atomicAdd(&bar[XB_TMO], 1u); break; } }
    }
    nloc = mine > 0u ? mine : 1u; nx = cnt > 0u ? cnt : 1u;
}
__device__ __forceinline__ void xcd_barrier(const XcdBarrier& b) {
    asm volatile("s_waitcnt vmcnt(0)" ::: "memory");
    __syncthreads();
    if (threadIdx.x == 0) {
        unsigned* bar = b.bar;
        __builtin_amdgcn_s_waitcnt(0);
        unsigned nloc = b.st[0], nx = b.st[1];
        if (nloc == 0u) { xcd_barrier_complete(bar, b.x, nloc, nx); b.st[0] = nloc; b.st[1] = nx; }
        const unsigned old = xb_add(&bar[XB_XSUB(b.x)], 1u);
        const unsigned gen = old / nloc;
        if (old + 1u == (gen + 1u) * nloc) {
            __builtin_amdgcn_fence(__ATOMIC_RELEASE, "agent");
            asm volatile("s_waitcnt vmcnt(0)" ::: "memory");
            const unsigned og = xb_add(&bar[XB_TOP], 1u);
            const unsigned tg = og / nx;
            if (og + 1u == (tg + 1u) * nx) xb_add(&bar[XB_TOPGEN], 1u);
            else XB_SPIN(xb_ld(&bar[XB_TOPGEN]) == tg, bar);
            __builtin_amdgcn_fence(__ATOMIC_ACQUIRE, "agent");
            xb_add(&bar[XB_XGEN(b.x)], 1u);
            asm volatile("s_waitcnt vmcnt(0)" ::: "memory");
        } else {
            XB_SPIN(xb_ld(&bar[XB_XGEN(b.x)]) == gen, bar);
            __builtin_amdgcn_fence(__ATOMIC_ACQUIRE, "agent");
            asm volatile("s_waitcnt vmcnt(0)" ::: "memory");
        }
    }
    __syncthreads();
}

__device__ __forceinline__ void wave_arrive(volatile LAS unsigned* wcnt, unsigned* xcnt, unsigned nloc, unsigned* top) {
    asm volatile("s_waitcnt vmcnt(0)" ::: "memory");
    if (lane_now() == 0) {
        const unsigned o = __hip_atomic_fetch_add((LAS unsigned*)wcnt, 1u, __ATOMIC_RELAXED, __HIP_MEMORY_SCOPE_WORKGROUP);
        if (o == (unsigned)NWAVES - 1u) {
            *wcnt = 0u;
            const unsigned old = xb_add(xcnt, 1u);
            if (old + 1u == nloc) {
                __builtin_amdgcn_fence(__ATOMIC_RELEASE, "agent");
                asm volatile("s_waitcnt vmcnt(0)" ::: "memory");
                (void)xb_add(top, nloc);
            }
        }
    }
}
__device__ __forceinline__ void wg_wait_count(unsigned* ctr, unsigned target, unsigned* bar) {
    if (threadIdx.x == 0) {
        XB_SPIN(xb_ld(ctr) < target, bar);
        __builtin_amdgcn_fence(__ATOMIC_ACQUIRE, "agent");
        asm volatile("s_waitcnt vmcnt(0)" ::: "memory");
    }
    __syncthreads();
}

struct Frame {
    LAS unsigned char* lds; volatile LAS unsigned* MISC; gu32* ctl;
    int tid, lane, wave, vcu, G;
    const float *x, *norm1_w, *w_in, *gn_w, *conv_w, *w_o, *norm2_w, *rg_w, *rg_b, *re_w, *re_b, *w_gate, *w_up, *w_down, *fin_w;
    float* out; unsigned char* ws;
};
__device__ __forceinline__ float wave_sum(float v) {
#pragma unroll
    for (int o = 1; o < 64; o <<= 1) v += __shfl_xor(v, o);
    return v;
}

__device__ __forceinline__ int win_srccol(int c) {
    const int tile = c >> 8, bj = (c >> 7) & 1, p = c & 127;
    if (tile < 4) { const int head = (tile & 1) * 2 + bj; const int orig = 4 * (p >> 3) + (p & 3) + 64 * ((p >> 2) & 1); return (tile >> 1) * RW + head * HD + orig; }
    if (tile < 10) return 1024 + (c - 1024);
    const int t = tile - 10; return (bj ? 3072 : 2560) + 128 * t + p;
}
__device__ __forceinline__ void p0_transpose_item(const float* W, int ldw, int srccol, bf16* WT0, int Kd, int k0, const float* scale, LAS float* scr, int lane) {
    const int dn = 4 * (lane & 7), kr = lane >> 3;
    f32x4 v[8];
#pragma unroll
    for (int i = 0; i < 8; ++i) v[i] = *(const GAS f32x4*)(W + (size_t)(k0 + 8 * i + kr) * ldw + srccol);
#pragma unroll
    for (int i = 0; i < 8; ++i) { LAS float* s = scr + (8 * i + kr) * 33 + dn; s[0] = v[i].x; s[1] = v[i].y; s[2] = v[i].z; s[3] = v[i].w; }
    LDS_WAIT(); asm volatile("" ::: "memory");
    const int c = lane & 7;
    f32x4 s0 = (f32x4){1.f, 1.f, 1.f, 1.f}, s1 = s0;
    if (scale) { s0 = *(const GAS f32x4*)(scale + k0 + 8 * c); s1 = *(const GAS f32x4*)(scale + k0 + 8 * c + 4); }
#pragma unroll
    for (int j = 0; j < 4; ++j) { const int n = (lane >> 3) + 8 * j; const LAS float* s = scr + (8 * c) * 33 + n;
        v4u o; o.x = pk2(s[0 * 33] * s0.x, s[1 * 33] * s0.y); o.y = pk2(s[2 * 33] * s0.z, s[3 * 33] * s0.w); o.z = pk2(s[4 * 33] * s1.x, s[5 * 33] * s1.y); o.w = pk2(s[6 * 33] * s1.z, s[7 * 33] * s1.w);
        *(GAS v4u*)(WT0 + (size_t)n * Kd + k0 + 8 * c) = o; }
    LDS_WAIT(); asm volatile("" ::: "memory");
}
__device__ __forceinline__ void rms_row_to_bf16(const float* xrow, const float* w, bf16* orow, int lane) {
    const GAS f32x4* xr = (const GAS f32x4*)xrow + lane;
    f32x4 v[4]; float s = 0.f;
#pragma unroll
    for (int j = 0; j < 4; ++j) { v[j] = xr[64 * j]; s += (v[j].x * v[j].x + v[j].y * v[j].y) + (v[j].z * v[j].z + v[j].w * v[j].w); }
    const float rs = 1.f / sqrtf(wave_sum(s) * (1.f / D) + EPS);
    GAS unsigned long long* o8 = (GAS unsigned long long*)orow + lane;
#pragma unroll
    for (int j = 0; j < 4; ++j) { const f32x4 ww = ((const GAS f32x4*)w)[lane + 64 * j];
        o8[64 * j] = (unsigned long long)pk2(v[j].x * rs * ww.x, v[j].y * rs * ww.y) | ((unsigned long long)pk2(v[j].z * rs * ww.z, v[j].w * rs * ww.w) << 32); }
}
__device__ __forceinline__ void p0_prologue(Frame& F) {
    LAS float* scr = (LAS float*)(F.lds + RING_OFF + F.wave * 16384);
    const int gw = F.vcu * NWAVES + F.wave, NGW = F.G * NWAVES, lane = F.lane;
    bf16* WinT = (bf16*)(F.ws + WS_WINT); bf16* WoT = (bf16*)(F.ws + WS_WOT);
    constexpr int I_IN = (D / 64) * (INC / 32), I_O = (D / 64) * (D / 32);
    constexpr int NITEMS = I_IN + I_O;
    for (int it = gw; it < NITEMS; it += NGW) {
        int r = it;
        if (r < I_IN) { const int nb = r % (INC / 32), kb = r / (INC / 32); const int n0 = 32 * nb;
            p0_transpose_item(F.w_in, INC, win_srccol(n0 + 4 * (lane & 7)), WinT + (size_t)n0 * D, D, 64 * kb, nullptr, scr, lane); continue; }
        r -= I_IN;
        { const int nb = r % (D / 32), kb = r / (D / 32); const int n0 = 32 * nb;
            p0_transpose_item(F.w_o, D, n0 + 4 * (lane & 7), WoT + (size_t)n0 * D, D, 64 * kb, nullptr, scr, lane); }
    }
    for (int idx = F.vcu * 512 + F.tid; idx < M; idx += F.G * 512) ((float*)(F.ws + WS_SSQ))[idx] = 0.f;
    { bf16* WrT = (bf16*)(F.ws + WS_WRT);
      for (int idx = F.vcu * 512 + F.tid; idx < 128 * D; idx += F.G * 512) {
          const int n = idx >> 10, k = idx & 1023; float v = 0.f;
          if (n < 8) v = F.rg_w[k * NG + n];
          else if (n < 72) { const int gg = (n - 8) >> 3, ee = (n - 8) & 7; v = F.re_w[((size_t)gg * D + k) * EPG + ee]; }
          WrT[idx] = (bf16)f2bf(v); } }
    bf16* XN = (bf16*)(F.ws + WS_XN);
    for (int m = gw; m < M; m += NGW) rms_row_to_bf16(F.x + (size_t)m * D, F.norm1_w, XN + (size_t)m * D, lane);
    float* rc = (float*)(F.ws + WS_ROPE); float* rsn = rc + SEQ * 64;
    for (int idx = F.vcu * 512 + F.tid; idx < SEQ * 64; idx += F.G * 512) {
        const int i = idx & 63, pos = idx >> 6;
        const float inv = (float)exp2(-(double)i * (13.287712379549449 / 64.0));
        const float ang = (float)pos * inv;
        const double rev = (double)ang * 0.15915494309189535;
        const float fr = (float)(rev - floor(rev));
        rc[idx] = __builtin_amdgcn_cosf(fr); rsn[idx] = __builtin_amdgcn_sinf(fr);
    }
}

struct InProjSched {
    int c, G; const void* Wb0; const void* Wb1; unsigned Wbytes;
    __device__ __forceinline__ bool next(int i, pg8::Unit& u) const {
        constexpr int nM = M / 256, nN = INC / 256, nwg = nM * nN;
        const int L = i * G + c; if (L >= nwg) return false;
        int wgid = L; { const int q = nwg / 8, r = nwg % 8, xcd = wgid % 8, off = wgid / 8; wgid = (xcd < r ? xcd * (q + 1) : r * (q + 1) + (xcd - r) * q) + off; }
        const int nig = 8 * nN, gid = wgid / nig, fm = gid * 8;
        u.pm = fm + ((wgid % nig) % 8); u.pn = (wgid % nig) / 8; u.arow0 = u.pm * 256; u.e = i; u.rb = 0; u.nvalid = 256;
        u.B = (unsigned)u.pn * (256u * D * 2u); u.B1 = u.B; return true;
    }
    __device__ __forceinline__ int arow(const pg8::Unit&, int) const { return 0; }
};
struct EpiInProj {
    static constexpr bool PERM = true;
    bf16* base; const float *rc, *rs; unsigned *xc1, *top1; volatile LAS unsigned* misc;
    __device__ __forceinline__ void operator()(const f32x4 (&acc)[2][2][4][2], const pg8::Unit& u, int wr, int wc, int fr, int fq) const {
        const int row0 = u.pm * 256 + wr * 64 + fr; const int pn = u.pn;
        if (pn < 4) {
            bf16* dst = base + (size_t)(pn >> 1) * (8u << 20); const float sc = (pn < 2) ? 0.08838834764831845f : 1.0f;
            const int i0 = 4 * (4 * wc + fq);
#pragma unroll
            for (int ai = 0; ai < 2; ++ai)
#pragma unroll
                for (int m = 0; m < 4; ++m) { const int r = row0 + ai * 128 + m * 16; const int pos = r & (SEQ - 1);
                    const f32x4 cs = *(const f32x4*)(rc + pos * 64 + i0), sn = *(const f32x4*)(rs + pos * 64 + i0);
#pragma unroll
                    for (int bj = 0; bj < 2; ++bj) { const f32x4 x1 = acc[ai][bj][m][0], x2 = acc[ai][bj][m][1];
                        const f32x4 o1 = (x1 * cs - x2 * sn) * sc, o2 = (x2 * cs + x1 * sn) * sc;
                        v4u w; w.x = cvt_pk_bf16(o1[0], o1[1]); w.y = cvt_pk_bf16(o1[2], o1[3]); w.z = cvt_pk_bf16(o2[0], o2[1]); w.w = cvt_pk_bf16(o2[2], o2[3]);
                        *(v4u*)(dst + (size_t)r * RW + ((pn & 1) * 2 + bj) * HD + wc * 32 + 8 * fq) = w; } }
        } else if (pn < 10) {
            bf16* dst = base + (size_t)(pn >> 1) * (8u << 20);
#pragma unroll
            for (int ai = 0; ai < 2; ++ai)
#pragma unroll
                for (int m = 0; m < 4; ++m) { const int r = row0 + ai * 128 + m * 16;
#pragma unroll
                    for (int bj = 0; bj < 2; ++bj) { const f32x4 v0 = acc[ai][bj][m][0], v1 = acc[ai][bj][m][1];
                        v4u w; w.x = cvt_pk_bf16(v0[0], v0[1]); w.y = cvt_pk_bf16(v0[2], v0[3]); w.z = cvt_pk_bf16(v1[0], v1[1]); w.w = cvt_pk_bf16(v1[2], v1[3]);
                        *(v4u*)(dst + (size_t)r * RW + (pn & 1) * 256 + bj * 128 + wc * 32 + 8 * fq) = w; } }
        } else {
            const int t = pn - 10; bf16* cub = base + (size_t)5 * (8u << 20);
#pragma unroll
            for (int ai = 0; ai < 2; ++ai)
#pragma unroll
                for (int m = 0; m < 4; ++m) { const int r = row0 + ai * 128 + m * 16;
                    const f32x4 v0 = acc[ai][0][m][0] * acc[ai][1][m][0], v1 = acc[ai][0][m][1] * acc[ai][1][m][1];
                    v4u w; w.x = cvt_pk_bf16(v0[0], v0[1]); w.y = cvt_pk_bf16(v0[2], v0[3]); w.z = cvt_pk_bf16(v1[0], v1[1]); w.w = cvt_pk_bf16(v1[2], v1[3]);
                    *(v4u*)(cub + (size_t)r * RW + t * 128 + wc * 32 + 8 * fq) = w; }
        }
        if (u.e == 1) wave_arrive(misc + 12, xc1, misc[8], top1);
    }
};


typedef short s16x4 __attribute__((ext_vector_type(4)));
typedef short v4i16_t __attribute__((ext_vector_type(4)));
__device__ __forceinline__ unsigned offb(unsigned row, unsigned ch) { return 256u * row + 16u * (ch ^ (((row & 3u) << 2) | ((row >> 2) & 3u))); }
__device__ __forceinline__ bf16x8 tr_frag(const LAS unsigned char* img, int lane, int c, int ks) {
    const unsigned g = lane >> 4, q = (lane & 15) >> 2, p = lane & 3;
    const unsigned a0 = offb(32 * ks + 8 * g + q, 2 * c + (p >> 1)) + 8 * (p & 1), a1 = offb(32 * ks + 8 * g + 4 + q, 2 * c + (p >> 1)) + 8 * (p & 1);
    const s16x4 lo = __builtin_bit_cast(s16x4, __builtin_amdgcn_ds_read_tr16_b64_v4i16((LAS v4i16_t*)(img + a0)));
    const s16x4 hi = __builtin_bit_cast(s16x4, __builtin_amdgcn_ds_read_tr16_b64_v4i16((LAS v4i16_t*)(img + a1)));
    return (bf16x8){lo[0], lo[1], lo[2], lo[3], hi[0], hi[1], hi[2], hi[3]};
}
__device__ __forceinline__ bf16x8 row_frag(const LAS unsigned char* img, int lane, int rb, int s) { return *(const LAS bf16x8*)(img + offb((lane & 15) + 16 * rb, 4 * s + (lane >> 4))); }
__device__ __forceinline__ float lg2_gamma(int h) { return log2f(1.0f - exp2f(-5.0f - (float)h)); }
__device__ __forceinline__ float silu_f(float g) { return g * __builtin_amdgcn_rcpf(1.0f + __expf(-g)); }

__device__ __forceinline__ void tile_load(v4u (&r)[4], const bf16* base, size_t row_stride, int tid) {
#pragma unroll
    for (int i = 0; i < 4; ++i) { const int id = tid + 512 * i, row = id >> 4, ch = id & 15; r[i] = *(const GAS v4u*)(base + (size_t)row * row_stride + 8 * ch); }
}
template <bool KSCALE>
__device__ __forceinline__ void tile_write(const v4u (&r)[4], LAS unsigned char* img, int tid, float lg2) {
#pragma unroll
    for (int i = 0; i < 4; ++i) { const int id = tid + 512 * i, row = id >> 4, ch = id & 15; v4u kv = r[i];
        if (KSCALE) { const float kd = exp2f((float)(CH - 1 - row) * lg2);
            kv.x = pk2(bflo(kv.x) * kd, bfhi(kv.x) * kd); kv.y = pk2(bflo(kv.y) * kd, bfhi(kv.y) * kd); kv.z = pk2(bflo(kv.z) * kd, bfhi(kv.z) * kd); kv.w = pk2(bflo(kv.w) * kd, bfhi(kv.w) * kd); }
        *(LAS v4u*)(img + offb(row, ch)) = kv; }
}
__device__ __forceinline__ void p2_kv_phase(Frame& F, const int u0, const int ustride) {
    bf16* KVT = (bf16*)(F.ws + WS_KVT);
    const bf16* kb = (const bf16*)(F.ws + WS_KB); const bf16* vb = (const bf16*)(F.ws + WS_VB);
    LAS unsigned char* Kimg = F.lds; LAS unsigned char* Vimg = F.lds + 32768;
    const int lane = F.lane, w = F.wave, g = lane >> 4, fr = lane & 15, tid = F.tid;
    LAS unsigned char* stg = F.lds + 65536 + 4096 * w;
    v4u rk[4], rv[4];
    int u = u0;
    if (u < NB * NCH * NH) { const int h = u & 3, n = (u >> 2) & 31, b = u >> 7; const size_t row0 = (size_t)b * SEQ + (size_t)n * CH;
        tile_load(rk, kb + row0 * RW + h * HD, RW, tid); tile_load(rv, vb + row0 * RW + h * HD, RW, tid); }
    for (; u < NB * NCH * NH; u += ustride) {
        const int h = u & 3;
        tile_write<true>(rk, Kimg, tid, lg2_gamma(h)); tile_write<false>(rv, Vimg, tid, 0.f);
        __syncthreads();
        { const int u2 = u + ustride; if (u2 < NB * NCH * NH) { const int h2 = u2 & 3, n2 = (u2 >> 2) & 31, b2 = u2 >> 7; const size_t r2 = (size_t)b2 * SEQ + (size_t)n2 * CH;
            tile_load(rk, kb + r2 * RW + h2 * HD, RW, tid); tile_load(rv, vb + r2 * RW + h2 * HD, RW, tid); } }
        bf16x8 af[4];
#pragma unroll
        for (int ks = 0; ks < 4; ++ks) af[ks] = tr_frag(Vimg, lane, w, ks);
#pragma unroll
        for (int cd = 0; cd < 8; ++cd) {
            f32x4 acc = (f32x4){0.f, 0.f, 0.f, 0.f};
#pragma unroll
            for (int ks = 0; ks < 4; ++ks) acc = __builtin_amdgcn_mfma_f32_16x16x32_bf16(af[ks], tr_frag(Kimg, lane, cd, ks), acc, 0, 0, 0);
#pragma unroll
            for (int r = 0; r < 4; ++r) ((LAS bf16*)stg)[(4 * g + r) * HD + 16 * cd + fr] = (bf16)f2bf(acc[r]);
        }
        LDS_WAIT();
#pragma unroll
        for (int k = 0; k < 4; ++k) { const int id = lane + 64 * k, row = id >> 4, ch = id & 15;
            *(GAS v4u*)(KVT + (size_t)u * (HD * HD) + (size_t)(16 * w + row) * HD + 8 * ch) = *(const LAS v4u*)(stg + row * 256 + ch * 16); }
        __syncthreads();
    }
}
__device__ __forceinline__ void p3_scan_phase(Frame& F, const int u0, const int ustride) {
    const bf16* KVT = (const bf16*)(F.ws + WS_KVT); bf16* prevT = (bf16*)(F.ws + WS_PREVT);
    for (int idx = u0 * 512 + F.tid; idx < NB * NH * HD * HD / 4; idx += ustride * 512) {
        const int de4 = idx & 4095, h = (idx >> 12) & 3, b = idx >> 14;
        const float cd = exp2f((float)CH * lg2_gamma(h));
        float s0 = 0.f, s1 = 0.f, s2 = 0.f, s3 = 0.f;
#pragma unroll 8
        for (int n = 0; n < NCH; ++n) {
            const size_t o = (size_t)((b * NCH + n) * NH + h) * (HD * HD) + 4 * de4;
            const v2u kvv = *(const GAS v2u*)(KVT + o);
            v2u pw; pw.x = pk2(s0, s1); pw.y = pk2(s2, s3);
            *(GAS v2u*)(prevT + o) = pw;
            s0 = cd * s0 + bflo(kvv.x); s1 = cd * s1 + bfhi(kvv.x); s2 = cd * s2 + bflo(kvv.y); s3 = cd * s3 + bfhi(kvv.y);
        }
    }
}
__device__ __forceinline__ void p4_retout_phase(Frame& F) {
    const bf16* qb = (const bf16*)(F.ws + WS_QB); const bf16* gbuf = (const bf16*)(F.ws + WS_GB); const bf16* prevT = (const bf16*)(F.ws + WS_PREVT);
    const bf16* kb = (const bf16*)(F.ws + WS_KB); const bf16* vb = (const bf16*)(F.ws + WS_VB);
    bf16* mixb = (bf16*)(F.ws + WS_MIXB);
    LAS unsigned char* Kimg = F.lds; LAS unsigned char* Vimg = F.lds + 32768; LAS unsigned char* Simg = F.lds + 65536;
    const int lane = F.lane, w = F.wave, g = lane >> 4, fr = lane & 15, tid = F.tid;
    LAS unsigned char* Pimg = F.lds + 98304 + 4096 * w;
    v4u rk[4], rv[4], rp[4];
    int u = blockIdx.x;
    if (u < NB * NCH * NH) { const int h = u & 3, n = (u >> 2) & 31, b = u >> 7; const size_t row0 = (size_t)b * SEQ + (size_t)n * CH;
        tile_load(rk, kb + row0 * RW + h * HD, RW, tid); tile_load(rv, vb + row0 * RW + h * HD, RW, tid); tile_load(rp, prevT + (size_t)u * (HD * HD), HD, tid); }
    for (; u < NB * NCH * NH; u += F.G) {
        const int h = u & 3, n = (u >> 2) & 31, b = u >> 7; const size_t row0 = (size_t)b * SEQ + (size_t)n * CH;
        const float lg2 = lg2_gamma(h);
        tile_write<false>(rk, Kimg, tid, 0.f); tile_write<false>(rv, Vimg, tid, 0.f); tile_write<false>(rp, Simg, tid, 0.f);
        const int i0 = 16 * w;
        bf16x8 qf[4];
#pragma unroll
        for (int s = 0; s < 4; ++s) qf[s] = *(const GAS bf16x8*)(qb + (row0 + i0 + fr) * RW + h * HD + 32 * s + 8 * g);
        __syncthreads();
        { const int u2 = u + F.G; if (u2 < NB * NCH * NH) { const int h2 = u2 & 3, n2 = (u2 >> 2) & 31, b2 = u2 >> 7; const size_t r2 = (size_t)b2 * SEQ + (size_t)n2 * CH;
            tile_load(rk, kb + r2 * RW + h2 * HD, RW, tid); tile_load(rv, vb + r2 * RW + h2 * HD, RW, tid); tile_load(rp, prevT + (size_t)u2 * (HD * HD), HD, tid); } }
        const int njt = (w | 1) + 1;
        for (int jt = 0; jt < njt; ++jt) {
            f32x4 acc = (f32x4){0.f, 0.f, 0.f, 0.f};
#pragma unroll
            for (int s = 0; s < 4; ++s) acc = __builtin_amdgcn_mfma_f32_16x16x32_bf16(row_frag(Kimg, lane, jt, s), qf[s], acc, 0, 0, 0);
            const int i = i0 + fr, jb = 16 * jt + 4 * g;
            float pv[4];
#pragma unroll
            for (int r = 0; r < 4; ++r) { const int j = jb + r; const float v = acc[r] * exp2f((float)(i - j) * lg2); pv[r] = (i >= j) ? v : 0.f; }
            v2u w2; w2.x = pk2(pv[0], pv[1]); w2.y = pk2(pv[2], pv[3]);
            *(LAS v2u*)(Pimg + offb(fr, 2 * jt + (g >> 1)) + 8 * (g & 1)) = w2;
        }
        LDS_WAIT();
        float qd[4];
#pragma unroll
        for (int r = 0; r < 4; ++r) qd[r] = exp2f((float)(i0 + 4 * g + r + 1) * lg2);
        const int ksmax = w >> 1;
        f32x4 o[8];
#pragma unroll
        for (int et = 0; et < 8; ++et) {
            f32x4 acc = (f32x4){0.f, 0.f, 0.f, 0.f};
#pragma unroll
            for (int s = 0; s < 4; ++s) acc = __builtin_amdgcn_mfma_f32_16x16x32_bf16(qf[s], row_frag(Simg, lane, et, s), acc, 0, 0, 0);
#pragma unroll
            for (int r = 0; r < 4; ++r) acc[r] *= qd[r];
            for (int ks = 0; ks <= ksmax; ++ks) acc = __builtin_amdgcn_mfma_f32_16x16x32_bf16(row_frag(Pimg, lane, 0, ks), tr_frag(Vimg, lane, et, ks), acc, 0, 0, 0);
            o[et] = acc;
        }
        float mu[4], rstd[4];
#pragma unroll
        for (int r = 0; r < 4; ++r) { float sm = 0.f;
#pragma unroll
            for (int et = 0; et < 8; ++et) sm += o[et][r];
            sm += __shfl_xor(sm, 1); sm += __shfl_xor(sm, 2); sm += __shfl_xor(sm, 4); sm += __shfl_xor(sm, 8);
            mu[r] = sm * (1.0f / HD); float q2 = 0.f;
#pragma unroll
            for (int et = 0; et < 8; ++et) { const float d = o[et][r] - mu[r]; q2 += d * d; }
            q2 += __shfl_xor(q2, 1); q2 += __shfl_xor(q2, 2); q2 += __shfl_xor(q2, 4); q2 += __shfl_xor(q2, 8);
            rstd[r] = 1.0f / sqrtf(q2 * (1.0f / HD) + EPS); }
        LDS_WAIT();
        LAS bf16* stg = (LAS bf16*)Pimg;
#pragma unroll
        for (int et = 0; et < 8; ++et) { const float gw = F.gn_w[h * HD + 16 * et + fr];
#pragma unroll
            for (int r = 0; r < 4; ++r) stg[(4 * g + r) * HD + 16 * et + fr] = (bf16)f2bf((o[et][r] - mu[r]) * rstd[r] * gw); }
        LDS_WAIT();
#pragma unroll
        for (int k = 0; k < 4; ++k) {
            const int id = lane + 64 * k, row = id >> 4, ch = id & 15;
            const v4u yv = *(const LAS v4u*)(Pimg + row * 256 + ch * 16);
            const size_t grow = row0 + i0 + row;
            const v4u gv = *(const GAS v4u*)(gbuf + grow * RW + h * HD + 8 * ch);
            v4u ov;
            ov.x = pk2(silu_f(bflo(gv.x)) * bflo(yv.x), silu_f(bfhi(gv.x)) * bfhi(yv.x)); ov.y = pk2(silu_f(bflo(gv.y)) * bflo(yv.y), silu_f(bfhi(gv.y)) * bfhi(yv.y));
            ov.z = pk2(silu_f(bflo(gv.z)) * bflo(yv.z), silu_f(bfhi(gv.z)) * bfhi(yv.z)); ov.w = pk2(silu_f(bflo(gv.w)) * bflo(yv.w), silu_f(bfhi(gv.w)) * bfhi(yv.w));
            *(GAS v4u*)(mixb + grow * D + h * HD + 8 * ch) = ov;
        }
        __syncthreads();
    }
    const bf16* gbb = (const bf16*)(F.ws + WS_GBB); const bf16* cub = (const bf16*)(F.ws + WS_CUB);
    for (int id = blockIdx.x * 512 + F.tid; id < M * 64; id += F.G * 512) {
        const int row = id >> 6, ch = id & 63, t = row & (SEQ - 1);
        const v4u c2 = *(const GAS v4u*)(cub + (size_t)row * CW + 8 * ch);
        v4u c1 = (v4u){0u, 0u, 0u, 0u}, c0 = c1;
        if (t >= 1) c1 = *(const GAS v4u*)(cub + (size_t)(row - 1) * CW + 8 * ch);
        if (t >= 2) c0 = *(const GAS v4u*)(cub + (size_t)(row - 2) * CW + 8 * ch);
        const v4u gv = *(const GAS v4u*)(gbb + (size_t)row * CW + 8 * ch);
        float wk[3][8];
#pragma unroll
        for (int k = 0; k < 3; ++k) { const f32x4 a = *(const GAS f32x4*)(F.conv_w + k * CW + 8 * ch), bq = *(const GAS f32x4*)(F.conv_w + k * CW + 8 * ch + 4);
            wk[k][0] = a.x; wk[k][1] = a.y; wk[k][2] = a.z; wk[k][3] = a.w; wk[k][4] = bq.x; wk[k][5] = bq.y; wk[k][6] = bq.z; wk[k][7] = bq.w; }
        const unsigned c0a[4] = {c0.x, c0.y, c0.z, c0.w}, c1a[4] = {c1.x, c1.y, c1.z, c1.w}, c2a[4] = {c2.x, c2.y, c2.z, c2.w}, ga[4] = {gv.x, gv.y, gv.z, gv.w};
        unsigned oa[4];
#pragma unroll
        for (int x = 0; x < 4; ++x) {
            const float lo = bflo(ga[x]) * (wk[0][2 * x] * bflo(c0a[x]) + wk[1][2 * x] * bflo(c1a[x]) + wk[2][2 * x] * bflo(c2a[x]));
            const float hi = bfhi(ga[x]) * (wk[0][2 * x + 1] * bfhi(c0a[x]) + wk[1][2 * x + 1] * bfhi(c1a[x]) + wk[2][2 * x + 1] * bfhi(c2a[x]));
            oa[x] = pk2(lo, hi); }
        *(GAS v4u*)(mixb + (size_t)row * D + RW + 8 * ch) = (v4u){oa[0], oa[1], oa[2], oa[3]};
    }
}

struct OutProjSched {
    int c, G; const void* Wb0; const void* Wb1; unsigned Wbytes;
    __device__ __forceinline__ bool next(int i, pg8::Unit& u) const {
        constexpr int nN = D / 256, nwg = (M / 256) * nN;
        const int L = i * G + c; if (L >= nwg) return false;
        const int wgid = (L % 8) * (nwg / 8) + L / 8;
        const int nig = 8 * nN, gid = wgid / nig, fm = gid * 8;
        u.pm = fm + ((wgid % nig) % 8); u.pn = (wgid % nig) / 8; u.arow0 = u.pm * 256; u.e = 0; u.rb = 0; u.nvalid = 256;
        u.B = (unsigned)u.pn * (256u * D * 2u); u.B1 = u.B; return true;
    }
    __device__ __forceinline__ int arow(const pg8::Unit&, int) const { return 0; }
};
struct EpiOutProj {
    static constexpr bool PERM = true;
    const float* x; const float* nw2; bf16* xn2; float* ssq;
    __device__ __forceinline__ void operator()(const f32x4 (&acc)[2][2][4][2], const pg8::Unit& u, int wr, int wc, int fr, int fq) const {
        const int row0 = u.pm * 256 + wr * 64 + fr, col0 = u.pn * 256 + wc * 32 + 8 * fq;
        f32x4 nwv[2][2];
#pragma unroll
        for (int bj = 0; bj < 2; ++bj) { nwv[bj][0] = *(const f32x4*)(nw2 + col0 + bj * 128); nwv[bj][1] = *(const f32x4*)(nw2 + col0 + bj * 128 + 4); }
#pragma unroll
        for (int ai = 0; ai < 2; ++ai)
#pragma unroll
            for (int m = 0; m < 4; ++m) { const size_t r = (size_t)(row0 + ai * 128 + m * 16); float ss = 0.f;
#pragma unroll
                for (int bj = 0; bj < 2; ++bj) { const size_t o = r * D + col0 + bj * 128;
                    const f32x4 v0 = acc[ai][bj][m][0] + *(const f32x4*)(x + o), v1 = acc[ai][bj][m][1] + *(const f32x4*)(x + o + 4);
                    ss += (v0[0] * v0[0] + v0[1] * v0[1]) + (v0[2] * v0[2] + v0[3] * v0[3]) + (v1[0] * v1[0] + v1[1] * v1[1]) + (v1[2] * v1[2] + v1[3] * v1[3]);
                    const f32x4 s0 = v0 * nwv[bj][0], s1 = v1 * nwv[bj][1];
                    v4u w; w.x = cvt_pk_bf16(s0[0], s0[1]); w.y = cvt_pk_bf16(s0[2], s0[3]); w.z = cvt_pk_bf16(s1[0], s1[1]); w.w = cvt_pk_bf16(s1[2], s1[3]);
                    *(v4u*)(xn2 + o) = w; }
                ss += __shfl_xor(ss, 16); ss += __shfl_xor(ss, 32);
                if (fq == 0) atomicAdd(ssq + r, ss); }
    }
};

__device__ __forceinline__ void p6_router_phase(Frame& F) {
    const bf16* xn2 = (const bf16*)(F.ws + WS_XN); const bf16* WrT = (const bf16*)(F.ws + WS_WRT);
    int* cnt = (int*)(F.ws + WS_CTL) + CW_CNT; int* tokl = (int*)(F.ws + WS_TOKL); float* rsl = (float*)(F.ws + WS_RSL); float* gatel = (float*)(F.ws + WS_GATEL);
    const float* ssq = (const float*)(F.ws + WS_SSQ);
    const int lane = F.lane, w = F.wave, g = lane >> 4, fr = lane & 15;
    constexpr int LS = 84;
    LAS float* slab = (LAS float*)F.lds + (w & 3) * (64 * LS);
    if (w == 0) { ((LAS int*)(F.lds + 4 * 64 * LS * 4))[lane] = 0; LDS_WAIT(); }
    for (int cb = (int)blockIdx.x; cb < M / 64; cb += F.G) {
        f32x4 acc[4][5];
#pragma unroll
        for (int rb = 0; rb < 4; ++rb)
#pragma unroll
            for (int t = 0; t < 5; ++t) acc[rb][t] = (f32x4){0.f, 0.f, 0.f, 0.f};
        const bf16* arow = xn2 + (size_t)(64 * cb + fr) * D + 128 * w + 8 * g;
        const bf16* brow = WrT + (size_t)fr * D + 128 * w + 8 * g;
#pragma unroll
        for (int s4 = 0; s4 < 4; ++s4) {
            bf16x8 bfr[5];
#pragma unroll
            for (int t = 0; t < 5; ++t) bfr[t] = *(const GAS bf16x8*)(brow + (size_t)(16 * t) * D + 32 * s4);
#pragma unroll
            for (int rb = 0; rb < 4; ++rb) { const bf16x8 a = *(const GAS bf16x8*)(arow + (size_t)(16 * rb) * D + 32 * s4);
#pragma unroll
                for (int t = 0; t < 5; ++t) acc[rb][t] = __builtin_amdgcn_mfma_f32_16x16x32_bf16(a, bfr[t], acc[rb][t], 0, 0, 0); }
        }
        if (w < 4) {
#pragma unroll
            for (int rb = 0; rb < 4; ++rb)
#pragma unroll
                for (int t = 0; t < 5; ++t)
#pragma unroll
                    for (int r = 0; r < 4; ++r) slab[(16 * rb + 4 * g + r) * LS + 16 * t + fr] = acc[rb][t][r];
        }
        __syncthreads();
        if (w >= 4) {
#pragma unroll
            for (int rb = 0; rb < 4; ++rb)
#pragma unroll
                for (int t = 0; t < 5; ++t)
#pragma unroll
                    for (int r = 0; r < 4; ++r) { LAS float* p = slab + (16 * rb + 4 * g + r) * LS + 16 * t + fr; *p = *p + acc[rb][t][r]; }
        }
        __syncthreads();
        if (w == 0) {
            const int tok = 64 * cb + lane;
            const LAS float* L0 = (const LAS float*)F.lds + lane * LS;
            const float rs = 1.0f / sqrtf(ssq[tok] * (1.0f / D) + EPS);
            float gl[8];
#pragma unroll
            for (int n = 0; n < 8; ++n) gl[n] = (((L0[n] + L0[64 * LS + n]) + L0[2 * 64 * LS + n]) + L0[3 * 64 * LS + n]) * rs + F.rg_b[n];
            int gs = 0; float gm = gl[0];
#pragma unroll
            for (int n = 1; n < 8; ++n) if (gl[n] > gm) { gm = gl[n]; gs = n; }
            float den = 0.f;
#pragma unroll
            for (int n = 0; n < 8; ++n) den += __expf(gl[n] - gm);
            const float pg = 1.0f / den;
            float el[8];
#pragma unroll
            for (int e = 0; e < 8; ++e) { const int n = 8 + gs * 8 + e; el[e] = (((L0[n] + L0[64 * LS + n]) + L0[2 * 64 * LS + n]) + L0[3 * 64 * LS + n]) * rs + F.re_b[gs * EPG + e]; }
            int i1 = 0; float m1 = el[0];
#pragma unroll
            for (int e = 1; e < 8; ++e) if (el[e] > m1) { m1 = el[e]; i1 = e; }
            int i2 = 0; float m2 = -3.0e38f;
#pragma unroll
            for (int e = 0; e < 8; ++e) if (e != i1 && el[e] > m2) { m2 = el[e]; i2 = e; }
            const float rr = __expf(m2 - m1); const float w1 = 1.0f / (1.0f + rr), w2 = rr / (1.0f + rr);
            const int e1 = gs * EPG + i1, e2 = gs * EPG + i2;
            LAS int* hist = (LAS int*)(F.lds + 4 * 64 * LS * 4);
            const int l1 = __hip_atomic_fetch_add(hist + e1, 1, __ATOMIC_RELAXED, __HIP_MEMORY_SCOPE_WORKGROUP), l2 = __hip_atomic_fetch_add(hist + e2, 1, __ATOMIC_RELAXED, __HIP_MEMORY_SCOPE_WORKGROUP);
            LDS_WAIT(); asm volatile("" ::: "memory");
            { const int c = hist[lane]; int base = 0; if (c > 0) base = atomicAdd(cnt + lane * CNT_STRIDE, c); hist[64 + lane] = base; hist[lane] = 0; }
            LDS_WAIT(); asm volatile("" ::: "memory");
            const int r1 = hist[64 + e1] + l1, r2 = hist[64 + e2] + l2;
            tokl[e1 * M + r1] = tok * 2;     rsl[e1 * M + r1] = rs; gatel[e1 * M + r1] = pg * w1;
            tokl[e2 * M + r2] = tok * 2 + 1; rsl[e2 * M + r2] = rs; gatel[e2 * M + r2] = pg * w2;
        }
        __syncthreads();
    }
}

__device__ __forceinline__ const char* uniform_ptr(const char* p) {
    const unsigned long long v = (unsigned long long)p;
    const unsigned lo = __builtin_amdgcn_readfirstlane((unsigned)v), hi = __builtin_amdgcn_readfirstlane((unsigned)(v >> 32));
    return (const char*)(((unsigned long long)hi << 32) | lo);
}
struct MoeSched {
    int half;
    int wave; int c, G; int total, limit; const LAS int* tab;
    const void* Wb0; const void* Wb1; unsigned Wbytes; unsigned off1; unsigned estride; int colstep; int ldwb; const int* tokl;
    __device__ __forceinline__ void init(const int* cnt, int lane, LAS int* table) {
        const int my_cnt = __hip_atomic_load(cnt + lane * CNT_STRIDE, __ATOMIC_RELAXED, __HIP_MEMORY_SCOPE_AGENT), my_nb = (my_cnt + 255) >> 8;
        int v = my_nb;
#pragma unroll
        for (int o = 1; o < 64; o <<= 1) { const int t = __shfl_up(v, o); if (lane >= o) v += t; }
        table[lane] = 4 * (v - my_nb); table[64 + lane] = my_nb; table[128 + lane] = my_cnt; total = 4 * __builtin_amdgcn_readlane(v, 63); limit = (total / G) * G; tab = table;
    }
    __device__ __forceinline__ bool next(int i, pg8::Unit& u) const {
        const int j = i * G + c; int L, hf = 0;
        if (half) { if (j >= 2 * (total - limit)) return false; L = limit + (j >> 1); hf = j & 1; } else { if (j >= limit) return false; L = j; }
        int wgid = L; { const int q = total / 8, r = total % 8, xcd = wgid % 8, off = wgid / 8; wgid = (xcd < r ? xcd * (q + 1) : r * (q + 1) + (xcd - r) * q) + off; }
        const int ln = (int)__builtin_amdgcn_mbcnt_hi(~0u, __builtin_amdgcn_mbcnt_lo(~0u, 0u));
        const int my_b4 = tab[ln], my_nb = tab[64 + ln];
        const bool hit = (wgid >= my_b4) && (wgid < my_b4 + 4 * my_nb);
        const unsigned long long mk = __ballot(hit);
        const int e = __builtin_amdgcn_readfirstlane((int)__builtin_ctzll(mk));
        const int b4 = __builtin_amdgcn_readfirstlane(tab[e]), nb = __builtin_amdgcn_readfirstlane(tab[64 + e]), ce = __builtin_amdgcn_readfirstlane(tab[128 + e]);
        const int within = wgid - b4; u.pn = __builtin_amdgcn_readfirstlane(within / nb); const int blk = within - u.pn * nb;
        const int rows = half ? 128 : 256;
        u.e = e; u.rb = (blk << 8) + 128 * hf; u.pm = (b4 >> 2) + blk; u.arow0 = (u.pm << 8) + 128 * hf;
        int nv = ce - u.rb; nv = nv < 0 ? 0 : nv; u.nvalid = nv < rows ? nv : rows;
        u.B = (unsigned)e * estride + (unsigned)u.pn * (unsigned)colstep; u.B1 = u.B + off1; return true;
    }
    __device__ __forceinline__ int arow(const pg8::Unit& u, int rl) const { return rl < u.nvalid ? (tokl[u.e * M + u.rb + rl] >> 1) : 0; }
};
struct EpiMoe1 {
    bf16* hb; const float* rsl;
    __device__ __forceinline__ void operator()(const f32x4 (&acc)[2][4][2], const pg8::Unit& u, int wr, int wc, int fr, int fq) const {
#pragma unroll
        for (int m = 0; m < 4; ++m) { const int rl = wr * 64 + m * 16 + fr;
            const float rs = rsl[u.e * M + u.rb + rl];
            f32x4 v0, v1;
#pragma unroll
            for (int j = 0; j < 4; ++j) { v0[j] = silu_f(acc[0][m][0][j] * rs) * (acc[1][m][0][j] * rs); v1[j] = silu_f(acc[0][m][1][j] * rs) * (acc[1][m][1][j] * rs); }
            v4u w; w.x = cvt_pk_bf16(v0[0], v0[1]); w.y = cvt_pk_bf16(v0[2], v0[3]); w.z = cvt_pk_bf16(v1[0], v1[1]); w.w = cvt_pk_bf16(v1[2], v1[3]);
            *(v4u*)(hb + (size_t)(u.arow0 + rl) * FF + u.pn * 128 + wc * 32 + 8 * fq) = w; }
    }
};
struct EpiMoe2 {
    bf16* yb; const int* tokl; const float* gatel;
    __device__ __forceinline__ void operator()(const f32x4 (&acc)[2][4][2], const pg8::Unit& u, int wr, int wc, int fr, int fq) const {
#pragma unroll
        for (int m = 0; m < 4; ++m) { const int rl = wr * 64 + m * 16 + fr;
            if (rl < u.nvalid) {
                const int dst = tokl[u.e * M + u.rb + rl]; const float gt = gatel[u.e * M + u.rb + rl];
#pragma unroll
                for (int bj = 0; bj < 2; ++bj) { const f32x4 v0 = acc[bj][m][0] * gt, v1 = acc[bj][m][1] * gt;
                    v4u w; w.x = cvt_pk_bf16(v0[0], v0[1]); w.y = cvt_pk_bf16(v0[2], v0[3]); w.z = cvt_pk_bf16(v1[0], v1[1]); w.w = cvt_pk_bf16(v1[2], v1[3]);
                    *(v4u*)(yb + (size_t)dst * D + u.pn * 256 + bj * 128 + wc * 32 + 8 * fq) = w; } } }
    }
};

struct EpiMoe1W {
    bf16* hb; const float* rsl;
    __device__ __forceinline__ void operator()(const f32x4 (&acc)[2][2][4][2], const pg8::Unit& u, int wr, int wc, int fr, int fq) const {
#pragma unroll
        for (int ai = 0; ai < 2; ++ai)
#pragma unroll
            for (int m = 0; m < 4; ++m) { const int rl = ai * 128 + wr * 64 + m * 16 + fr;
                const float rs = rsl[u.e * M + u.rb + rl];
                f32x4 v0, v1;
#pragma unroll
                for (int j = 0; j < 4; ++j) { v0[j] = silu_f(acc[ai][0][m][0][j] * rs) * (acc[ai][1][m][0][j] * rs); v1[j] = silu_f(acc[ai][0][m][1][j] * rs) * (acc[ai][1][m][1][j] * rs); }
                v4u w; w.x = cvt_pk_bf16(v0[0], v0[1]); w.y = cvt_pk_bf16(v0[2], v0[3]); w.z = cvt_pk_bf16(v1[0], v1[1]); w.w = cvt_pk_bf16(v1[2], v1[3]);
                *(v4u*)(hb + (size_t)(u.arow0 + rl) * FF + u.pn * 128 + wc * 32 + 8 * fq) = w; }
    }
};
struct EpiMoe2W {
    bf16* yb; const int* tokl; const float* gatel;
    __device__ __forceinline__ void operator()(const f32x4 (&acc)[2][2][4][2], const pg8::Unit& u, int wr, int wc, int fr, int fq) const {
#pragma unroll
        for (int ai = 0; ai < 2; ++ai)
#pragma unroll
            for (int m = 0; m < 4; ++m) { const int rl = ai * 128 + wr * 64 + m * 16 + fr;
                if (rl < u.nvalid) {
                    const int dst = tokl[u.e * M + u.rb + rl]; const float gt = gatel[u.e * M + u.rb + rl];
#pragma unroll
                    for (int bj = 0; bj < 2; ++bj) { const f32x4 v0 = acc[ai][bj][m][0] * gt, v1 = acc[ai][bj][m][1] * gt;
                        v4u w; w.x = cvt_pk_bf16(v0[0], v0[1]); w.y = cvt_pk_bf16(v0[2], v0[3]); w.z = cvt_pk_bf16(v1[0], v1[1]); w.w = cvt_pk_bf16(v1[2], v1[3]);
                        *(v4u*)(yb + (size_t)dst * D + u.pn * 256 + bj * 128 + wc * 32 + 8 * fq) = w; } } }
    }
};

__device__ __forceinline__ void p9_final_phase(Frame& F) {
    const bf16* xb2 = (const bf16*)(F.ws + WS_XN); const bf16* yb = (const bf16*)(F.ws + WS_YB);
    const int gw = F.vcu * NWAVES + F.wave, NGW = F.G * NWAVES, lane = lane_now();
    for (int row = gw; row < M; row += NGW) {
        float v[16]; float ss = 0.f;
#pragma unroll
        for (int c = 0; c < 2; ++c) {
            const int ch = lane + 64 * c;
            const v4u a = *(const GAS v4u*)(xb2 + (size_t)row * D + 8 * ch), b1 = *(const GAS v4u*)(yb + (size_t)(2 * row) * D + 8 * ch), b2 = *(const GAS v4u*)(yb + (size_t)(2 * row + 1) * D + 8 * ch);
            const unsigned aa[4] = {a.x, a.y, a.z, a.w}, bb[4] = {b1.x, b1.y, b1.z, b1.w}, cc[4] = {b2.x, b2.y, b2.z, b2.w};
            const f32x4 n0 = *(const GAS f32x4*)(F.norm2_w + 8 * ch), n1 = *(const GAS f32x4*)(F.norm2_w + 8 * ch + 4);
            const float inw[8] = {1.0f / n0[0], 1.0f / n0[1], 1.0f / n0[2], 1.0f / n0[3], 1.0f / n1[0], 1.0f / n1[1], 1.0f / n1[2], 1.0f / n1[3]};
#pragma unroll
            for (int x = 0; x < 4; ++x) { const float lo = bflo(aa[x]) * inw[2 * x] + (bflo(bb[x]) + bflo(cc[x])), hi = bfhi(aa[x]) * inw[2 * x + 1] + (bfhi(bb[x]) + bfhi(cc[x])); v[8 * c + 2 * x] = lo; v[8 * c + 2 * x + 1] = hi; ss += lo * lo + hi * hi; }
        }
        const float rs = 1.0f / sqrtf(wave_sum(ss) * (1.0f / D) + EPS);
#pragma unroll
        for (int c = 0; c < 2; ++c) {
            const int ch = lane + 64 * c;
            const f32x4 w0 = *(const GAS f32x4*)(F.fin_w + 8 * ch), w1 = *(const GAS f32x4*)(F.fin_w + 8 * ch + 4);
            f32x4 o0, o1;
#pragma unroll
            for (int x = 0; x < 4; ++x) { o0[x] = v[8 * c + x] * rs * w0[x]; o1[x] = v[8 * c + 4 + x] * rs * w1[x]; }
            *(GAS f32x4*)(F.out + (size_t)row * D + 8 * ch) = o0; *(GAS f32x4*)(F.out + (size_t)row * D + 8 * ch + 4) = o1;
        }
    }
}

struct Args { const float* in[15]; float* out; unsigned char* ws; int ph_lo, ph_hi, li, pad; };
__global__ void __launch_bounds__(NWAVES * 64, 2) mega_fwd(Args args) {
    extern __shared__ __attribute__((aligned(16))) unsigned char lds[];
    Frame F;
    F.lds = (LAS unsigned char*)lds; F.MISC = (volatile LAS unsigned*)(F.lds + MISC_OFF);
    F.tid = threadIdx.x; F.lane = F.tid & 63; F.wave = __builtin_amdgcn_readfirstlane(F.tid >> 6);
    F.G = gridDim.x; { const int bx = blockIdx.x; F.vcu = (F.G % 8 == 0) ? (bx % 8) * (F.G / 8) + bx / 8 : bx; }
    F.ws = args.ws; F.ctl = (gu32*)(args.ws + WS_CTL); F.out = args.out;
    F.x = args.in[0]; F.norm1_w = args.in[1]; F.w_in = args.in[2]; F.gn_w = args.in[3]; F.conv_w = args.in[4]; F.w_o = args.in[5]; F.norm2_w = args.in[6];
    F.rg_w = args.in[7]; F.rg_b = args.in[8]; F.re_w = args.in[9]; F.re_b = args.in[10]; F.w_gate = args.in[11]; F.w_up = args.in[12]; F.w_down = args.in[13]; F.fin_w = args.in[14];
    for (int u = F.tid; u < (LDS_BYTES - LDSCTL_OFF) / 4; u += NWAVES * 64) ((LAS unsigned*)(F.lds + LDSCTL_OFF))[u] = 0u;
    __syncthreads();
    XcdBarrier bar = xcd_barrier_post((unsigned*)(F.ctl + CW_BAR) + args.li * XCD_BAR_WORDS, F.MISC + 8);
    const int lo = args.ph_lo, hi = args.ph_hi;
    const bool early = (F.G == 256);
    if (early && blockIdx.x >= 128 && threadIdx.x == 0) (void)xb_add((unsigned*)(F.ctl + CW_ECNT) + 64 * bar.x, 1u);
#define IN(k) (lo <= (k) && (k) < hi)
#define BOTH(k) (IN(k) && IN((k) + 1))
    if (IN(0)) { p0_prologue(F); if (BOTH(0)) xcd_barrier(bar); }
    if (IN(1)) {
        InProjSched S{(int)blockIdx.x, F.G, (const void*)(F.ws + WS_WINT), (const void*)(F.ws + WS_WINT), (unsigned)(INC * D * 2)};
        static_assert(WS_KB - WS_QB == 16 * MiB && WS_VB - WS_KB == 16 * MiB && WS_GB - WS_VB == 16 * MiB && WS_GBB - WS_GB == 16 * MiB && WS_CUB - WS_GBB == 16 * MiB, "EpiInProj strides");
        EpiInProj E{(bf16*)(F.ws + WS_QB), (const float*)(F.ws + WS_ROPE), (const float*)(F.ws + WS_ROPE) + SEQ * 64, (unsigned*)(F.ctl + CW_X1) + 64 * bar.x, (unsigned*)(F.ctl + CW_E1), F.MISC};
        pg8::gemm_phase<EpiInProj, InProjSched, false, true>(F.lds + RING_OFF, (const void*)(F.ws + WS_XN), (unsigned)(M * D * 2), D, S, E);
        if (BOTH(1) && !early) xcd_barrier(bar);
    }
    {
        const int bx = (int)blockIdx.x; const bool mine = !early || bx >= 128; const int pi = early ? bx - 128 : bx, pstr = early ? 128 : F.G;
        if (IN(2)) {
            if (mine) {
                if (early) wg_wait_count((unsigned*)(F.ctl + CW_E1), 256u, bar.bar);
                p2_kv_phase(F, pi, pstr);
                if (early) { wave_arrive(F.MISC + 12, (unsigned*)(F.ctl + CW_X2) + 64 * bar.x, xb_ld((unsigned*)(F.ctl + CW_ECNT) + 64 * bar.x), (unsigned*)(F.ctl + CW_E2)); wg_wait_count((unsigned*)(F.ctl + CW_E2), 128u, bar.bar); }
            }
            if (BOTH(2) && !early) xcd_barrier(bar);
        }
        if (IN(3)) { if (mine) p3_scan_phase(F, pi, pstr); if (BOTH(3)) xcd_barrier(bar); }
    }
    if (IN(4)) { p4_retout_phase(F); if (BOTH(4)) xcd_barrier(bar); }
    if (IN(5)) {
        OutProjSched S{(int)blockIdx.x, F.G, (const void*)(F.ws + WS_WOT), (const void*)(F.ws + WS_WOT), (unsigned)(D * D * 2)};
        EpiOutProj E{F.x, F.norm2_w, (bf16*)(F.ws + WS_XN), (float*)(F.ws + WS_SSQ)};
        pg8::gemm_phase<EpiOutProj, OutProjSched, false, false>(F.lds + RING_OFF, (const void*)(F.ws + WS_MIXB), (unsigned)(M * D * 2), D, S, E);
        if (BOTH(5)) xcd_barrier(bar);
    }
    if (IN(6)) { p6_router_phase(F); if (BOTH(6)) xcd_barrier(bar); }
    if (IN(7)) {
        MoeSched S; S.half = 0; S.wave = F.wave; S.c = (int)blockIdx.x; S.G = F.G; S.Wb0 = (const void*)F.w_gate; S.Wb1 = (const void*)F.w_up; S.Wbytes = (unsigned)(NE * D * FF * 4); S.off1 = 0; S.estride = (unsigned)(D * FF * 4); S.colstep = 128 * 4; S.ldwb = FF * 4; S.tokl = (const int*)(F.ws + WS_TOKL);
        S.init((const int*)(F.ws + WS_CTL) + CW_CNT, lane_now(), (LAS int*)(F.lds + LDSCTL_OFF + 1024)); __syncthreads();
        { EpiMoe1W E{(bf16*)(F.ws + WS_HB), (const float*)(F.ws + WS_RSL)};
          mw::gemm_w<EpiMoe1W, MoeSched, true>(F.lds + RING_OFF, (const void*)(F.ws + WS_XN), (unsigned)(M * D * 2), D, S, E); }
        S.half = 1;
        { EpiMoe1 E{(bf16*)(F.ws + WS_HB), (const float*)(F.ws + WS_RSL)};
          mz::gemm_z<EpiMoe1, MoeSched, true>(F.lds + RING_OFF, (const void*)(F.ws + WS_XN), (unsigned)(M * D * 2), D, S, E); }
        if (BOTH(7)) xcd_barrier(bar);
    }
    if (IN(8)) {
        MoeSched S; S.half = 0; S.wave = F.wave; S.c = (int)blockIdx.x; S.G = F.G; S.Wb0 = (const void*)F.w_down; S.Wb1 = (const void*)F.w_down; S.Wbytes = (unsigned)(NE * FF * D * 4); S.off1 = 128 * 4; S.estride = (unsigned)(FF * D * 4); S.colstep = 256 * 4; S.ldwb = D * 4; S.tokl = (const int*)(F.ws + WS_TOKL);
        S.init((const int*)(F.ws + WS_CTL) + CW_CNT, lane_now(), (LAS int*)(F.lds + LDSCTL_OFF + 1024)); __syncthreads();
        { EpiMoe2W E{(bf16*)(F.ws + WS_YB), (const int*)(F.ws + WS_TOKL), (const float*)(F.ws + WS_GATEL)};
          mw::gemm_w<EpiMoe2W, MoeSched, false>(F.lds + RING_OFF, (const void*)(F.ws + WS_HB), (unsigned)(49152u * FF * 2u), FF, S, E); }
        S.half = 1;
        { EpiMoe2 E{(bf16*)(F.ws + WS_YB), (const int*)(F.ws + WS_TOKL), (const float*)(F.ws + WS_GATEL)};
          mz::gemm_z<EpiMoe2, MoeSched, false>(F.lds + RING_OFF, (const void*)(F.ws + WS_HB), (unsigned)(49152u * FF * 2u), FF, S, E); }
        if (BOTH(8)) xcd_barrier(bar);
    }
    if (IN(9)) { p9_final_phase(F); }
#undef IN
#undef BOTH
}

extern "C" void kernel_launch(void* const* d_in, const int* in_sizes, int n_in, void* d_out, int out_size, void* d_ws, size_t ws_size, hipStream_t stream) {
    static int grid = 0;
    if (grid == 0) {
        int dev = 0, cus = 0, per_cu = 0;
        if (hipGetDevice(&dev) != hipSuccess || hipDeviceGetAttribute(&cus, hipDeviceAttributeMultiprocessorCount, dev) != hipSuccess) { fprintf(stderr, "kernel_launch: device query failed\n"); grid = -1; return; }
        if (hipFuncSetAttribute((const void*)mega_fwd, hipFuncAttributeMaxDynamicSharedMemorySize, LDS_BYTES) != hipSuccess) { fprintf(stderr, "kernel_launch: hipFuncSetAttribute failed\n"); grid = -1; return; }
        if (hipOccupancyMaxActiveBlocksPerMultiprocessor(&per_cu, (const void*)mega_fwd, NWAVES * 64, LDS_BYTES) != hipSuccess || per_cu < 1) fprintf(stderr, "kernel_launch: occupancy query reports %d blocks per CU\n", per_cu);
        (void)hipGetLastError();
        grid = cus;
    }
    if (grid < 0) return;
    char* ws = (char*)d_ws; float* out = (float*)d_out;
    (void)hipMemsetAsync(ws + WS_CTL, 0, CTL_ZERO_BYTES, stream);
    Args a{};
    for (int i = 0; i < 15; ++i) a.in[i] = (const float*)d_in[i];
    a.out = out; a.ws = (unsigned char*)d_ws;
    a.ph_lo = 0; a.ph_hi = 10; a.li = 0; hipLaunchKernelGGL(mega_fwd, dim3(grid), dim3(NWAVES * 64), LDS_BYTES, stream, a);
}
```

```cpp
#include <hip/hip_runtime.h>
#include <cstdio>
#include <cstdint>

constexpr int NB = 4, SEQ = 4096, D = 1024, M = NB * SEQ;
constexpr int RW = 512, NH = 4, HD = 128, CW = 512, INC = 3584, CH = 128, NCH = SEQ / CH;
constexpr int NG = 8, EPG = 8, NE = 64, FF = 512;
constexpr float EPS = 1e-6f;
constexpr int NWAVES = 8;

#define GAS __attribute__((address_space(1)))
#define LAS __attribute__((address_space(3)))
typedef unsigned short bf16;
typedef unsigned v4u __attribute__((ext_vector_type(4)));
typedef unsigned v2u __attribute__((ext_vector_type(2)));
typedef float f32x4 __attribute__((ext_vector_type(4)));
typedef short bf16x8 __attribute__((ext_vector_type(8)));
typedef GAS unsigned gu32;
#define RLX_AGENT __ATOMIC_RELAXED, __HIP_MEMORY_SCOPE_AGENT
#define LDS_WAIT() asm volatile("s_waitcnt lgkmcnt(0)" ::: "memory")
#define VM_WAIT() asm volatile("s_waitcnt vmcnt(0)" ::: "memory")

__device__ __forceinline__ unsigned f2bf(float f) { unsigned u = __builtin_bit_cast(unsigned, f); return (u + 0x7fffu + ((u >> 16) & 1u)) >> 16; }
__device__ __forceinline__ unsigned pk2(float lo, float hi) { return f2bf(lo) | (f2bf(hi) << 16); }
__device__ __forceinline__ float bf2f(unsigned short b) { return __builtin_bit_cast(float, (unsigned)b << 16); }
__device__ __forceinline__ float bflo(unsigned w) { return __builtin_bit_cast(float, w << 16); }
__device__ __forceinline__ float bfhi(unsigned w) { return __builtin_bit_cast(float, w & 0xffff0000u); }
__device__ __forceinline__ unsigned cvt_pk_bf16(float lo, float hi) { unsigned r; asm volatile("v_cvt_pk_bf16_f32 %0, %1, %2" : "=v"(r) : "v"(lo), "v"(hi)); return r; }

__device__ __forceinline__ int lane_now() { int l; asm volatile("v_mbcnt_lo_u32_b32 %0, -1, 0\n\tv_mbcnt_hi_u32_b32 %0, -1, %0" : "=v"(l)); return l; }
constexpr size_t MiB = 1u << 20;
constexpr size_t WS_CTL = 0, CTL_ZERO_BYTES = 512 * 1024;
constexpr size_t WS_WRT = 1 * MiB;
constexpr size_t WS_ROPE = 2 * MiB;
constexpr size_t WS_WOT = 4 * MiB;
constexpr size_t WS_WINT = 6 * MiB;
constexpr size_t WS_TOKL = 14 * MiB, WS_RSL = 18 * MiB, WS_GATEL = 22 * MiB;
constexpr size_t WS_SSQ = 13 * MiB;
constexpr size_t WS_QB = 224 * MiB, WS_KB = 240 * MiB, WS_VB = 256 * MiB, WS_GB = 272 * MiB, WS_GBB = 288 * MiB, WS_CUB = 304 * MiB, WS_PREVT = 320 * MiB;
constexpr size_t WS_YB = 224 * MiB;
constexpr size_t WS_HB = 288 * MiB;
constexpr size_t WS_XN = 336 * MiB;
constexpr size_t WS_KVT = 368 * MiB;
constexpr size_t WS_MIXB = 368 * MiB;
constexpr size_t WS_END = 400 * MiB;

constexpr int CW_TMO = 0, CW_CODE = 1;
constexpr int CW_E1 = 256, CW_E2 = 320, CW_ECNT = 1024, CW_X1 = 2048, CW_X2 = 3072;
constexpr int CW_BAR = 4096;
constexpr int CW_CNT = 49152, CNT_STRIDE = 1088;

constexpr int RING_OFF = 0, RING_BYTES = 131072;
constexpr int LDSCTL_OFF = RING_BYTES, MISC_OFF = LDSCTL_OFF + 320;
constexpr int LDS_BYTES = 147456;

namespace pg8 {
typedef short s16x4_t __attribute__((ext_vector_type(4)));
typedef short v4i16g_t __attribute__((ext_vector_type(4)));
constexpr int BM = 256, BK = 64, HALF = 128, HTB = HALF * BK * 2, STAGE_BYTES = 8 * HTB, NXCD = 8, WGM = 8;
__host__ __device__ __forceinline__ int lds_byte(int r, int c) { const int st = (r >> 4) * 2 + (c >> 5), rr = r & 15, cc = c & 31, ob = rr * 64 + cc * 2; return st * 1024 + (ob ^ (((ob >> 9) & 1) << 5)); }
__host__ __device__ __forceinline__ void stage_rc(int b, int& R, int& C) { const int st = b / 1024, sb = b % 1024, swz = sb ^ (((sb >> 9) & 1) << 5); R = (st >> 1) * 16 + swz / 64; C = (st & 1) * 32 + (swz % 64) / 2; }
__host__ __device__ __forceinline__ int perm32(int rho) { const int n = rho >> 4, i = rho & 15; return 8 * (i >> 2) + 4 * n + (i & 3); }

struct Unit { int arow0; int pm, pn; int e, rb, nvalid; unsigned B, B1; };

template <class Epi, class Sched, bool GATHER, bool ALIGN_EPI, bool BF32 = false>
__device__ __forceinline__ void gemm_phase(LAS unsigned char* lds, const void* Amat, const unsigned Abytes, const int K, const Sched& S, const Epi& E) {
    const __amdgpu_buffer_rsrc_t rA = __builtin_amdgcn_make_buffer_rsrc((void*)Amat, 0, Abytes, 0x00020000);
    const __amdgpu_buffer_rsrc_t rB0 = __builtin_amdgcn_make_buffer_rsrc((void*)S.Wb0, 0, S.Wbytes, 0x00020000), rB1 = __builtin_amdgcn_make_buffer_rsrc((void*)S.Wb1, 0, S.Wbytes, 0x00020000);
    const int tid = threadIdx.x, wid = __builtin_amdgcn_readfirstlane(tid >> 6), lane = tid & 63, wr = wid >> 2, wc = wid & 3, fr = lane & 15, fq = lane >> 4;
    const int nt = K / BK;
    int Rv[2], Cv[2]; unsigned voffB[2];
#pragma unroll
    for (int i = 0; i < 2; ++i) { stage_rc(tid * 16 + i * 8192, Rv[i], Cv[i]); const int Rb = Epi::PERM ? ((Rv[i] & ~31) + perm32(Rv[i] & 31)) : Rv[i]; voffB[i] = (unsigned)(Rb * K + Cv[i]) * 2u; }
    const unsigned kstep = (unsigned)(BK * 2);
    const unsigned hstepB = (unsigned)(HALF * K * 2);
    const unsigned ldsw = (unsigned)wid * 1024u;
    const int aoff = lds_byte(wr * 64 + fr, fq * 8), boff = lds_byte(wc * 32 + fr, fq * 8);
    size_t ldwb = 0; if constexpr (BF32) ldwb = (size_t)S.ldwb;
    const int bk0 = tid >> 5, bmm = tid & 31;
    const unsigned bwoff = (256u * bk0 + 16u * ((unsigned)(bmm >> 1) ^ ((((unsigned)bk0 & 3u) << 2) | (((unsigned)bk0 >> 2) & 3u)))) + 8u * (((unsigned)bmm & 1u) ^ (((unsigned)bk0 >> 3) & 1u));
    const unsigned bgoff = (unsigned)bk0 * (unsigned)ldwb + (unsigned)bmm * 16u;
    unsigned trb[2][2];
#pragma unroll
    for (int t = 0; t < 2; ++t)
#pragma unroll
        for (int nf = 0; nf < 2; ++nf) { const unsigned row = 8u * fq + 4u * t + ((unsigned)fr >> 2), ch = 4u * wc + ((unsigned)fr & 3u);
            trb[t][nf] = 256u * row + 16u * (ch ^ (((row & 3u) << 2) | ((row >> 2) & 3u))) + 8u * ((unsigned)nf ^ ((unsigned)fq & 1u)); }
    unsigned bgo[4];
#pragma unroll
    for (int i = 0; i < 4; ++i) bgo[i] = bgoff + (unsigned)(16 * i) * (unsigned)ldwb;
    f32x4 R[4];
#define PG8_SA(b, h) (((BF32 ? 4 : 0) + (b) * 2 + (h)) * HTB)
#define PG8_SB(b, h) (((BF32 ? 0 : 4) + (b) * 2 + (h)) * HTB)
#define PG8_STAGE_B(bufoff, so) do { _Pragma("unroll") for (int _i = 0; _i < 2; ++_i) \
        __builtin_amdgcn_raw_ptr_buffer_load_lds(rB0, (LAS void*)(lds + (bufoff) + ldsw + _i * 8192), 16, (int)voffB[_i], (int)(so), 0, 0); } while (0)
#define PG8_STAGE_A(bufoff, vo, kb) do { _Pragma("unroll") for (int _i = 0; _i < 2; ++_i) \
        __builtin_amdgcn_raw_ptr_buffer_load_lds(rA, (LAS void*)(lds + (bufoff) + ldsw + _i * 8192), 16, (int)(vo)[_i], (int)(kb), 0, 0); } while (0)
#define PG8_LDA(dst, b, h) do { _Pragma("unroll") for (int m = 0; m < 4; ++m) _Pragma("unroll") for (int k = 0; k < 2; ++k) dst[m][k] = *(const LAS bf16x8*)(lds + PG8_SA(b, h) + aoff + m * 2048 + k * 1024); } while (0)
#define PG8_LDB(dst, b, h) do { _Pragma("unroll") for (int n = 0; n < 2; ++n) _Pragma("unroll") for (int k = 0; k < 2; ++k) dst[n][k] = *(const LAS bf16x8*)(lds + PG8_SB(b, h) + boff + n * 2048 + k * 1024); } while (0)
#define PG8_BLOAD(h, so, kt) do { const int _so = (int)((so) + (unsigned)(kt) * 64u * (unsigned)ldwb); _Pragma("unroll") for (int _i = 0; _i < 4; ++_i) \
        R[_i] = __builtin_bit_cast(f32x4, __builtin_amdgcn_raw_buffer_load_b128((h) ? rB1 : rB0, (int)bgo[_i], _so, 0)); } while (0)
#define PG8_BWRITE(bufoff) do { _Pragma("unroll") for (int _i = 0; _i < 4; ++_i) { v2u _w; _w.x = cvt_pk_bf16(R[_i].x, R[_i].y); _w.y = cvt_pk_bf16(R[_i].z, R[_i].w); *(LAS v2u*)(lds + (bufoff) + bwoff + 4096 * _i) = _w; } } while (0)
#define PG8_TR(addr) __builtin_bit_cast(s16x4_t, __builtin_amdgcn_ds_read_tr16_b64_v4i16((LAS v4i16g_t*)(addr)))
#define PG8_LDBT(dst, b, h) do { _Pragma("unroll") for (int n = 0; n < 2; ++n) _Pragma("unroll") for (int k = 0; k < 2; ++k) { \
        const s16x4_t _lo = PG8_TR(lds + PG8_SB(b, h) + trb[0][n] + 8192 * k), _hi = PG8_TR(lds + PG8_SB(b, h) + trb[1][n] + 8192 * k); \
        dst[n][k] = (bf16x8){_lo[0], _lo[1], _lo[2], _lo[3], _hi[0], _hi[1], _hi[2], _hi[3]}; } } while (0)
#define PG8_LDBX(dst, b, h) do { if constexpr (BF32) { PG8_LDBT(dst, b, h); } else { PG8_LDB(dst, b, h); } } while (0)
#define PG8_MMA(ai, bj, At, Bt) do { __builtin_amdgcn_s_setprio(1); _Pragma("unroll") for (int m = 0; m < 4; ++m) _Pragma("unroll") for (int n = 0; n < 2; ++n) _Pragma("unroll") for (int k = 0; k < 2; ++k) \
        acc[ai][bj][m][n] = __builtin_amdgcn_mfma_f32_16x16x32_bf16(Bt[n][k], At[m][k], acc[ai][bj][m][n], 0, 0, 0); __builtin_amdgcn_s_setprio(0); } while (0)
#define PG8_WAIT_V(n) asm volatile("s_waitcnt vmcnt(" #n ")" ::: "memory")
#define PG8_WAIT_L(n) asm volatile("s_waitcnt lgkmcnt(" #n ")" ::: "memory")
#define PG8_BAR __builtin_amdgcn_s_barrier()
#define PG8_SCHED __builtin_amdgcn_sched_barrier(0)
#define PG8_SETVO(vo, u) do { _Pragma("unroll") for (int _h = 0; _h < 2; ++_h) _Pragma("unroll") for (int _i = 0; _i < 2; ++_i) { \
        const int _row = GATHER ? S.arow(u, _h * HALF + Rv[_i]) : (u).arow0 + _h * HALF + Rv[_i]; (vo)[_h][_i] = (unsigned)(_row * K + Cv[_i]) * 2u; } } while (0)
    Unit cur, nxt; int ui = 0;
    if (!S.next(0, cur)) return;
    unsigned voC[2][2], voN[2][2];
    PG8_SETVO(voC, cur);
    f32x4 acc[2][2][4][2];
#pragma unroll
    for (int a = 0; a < 2; ++a)
#pragma unroll
        for (int b = 0; b < 2; ++b)
#pragma unroll
            for (int m = 0; m < 4; ++m)
#pragma unroll
                for (int n = 0; n < 2; ++n) acc[a][b][m][n] = (f32x4){0.f, 0.f, 0.f, 0.f};
    bf16x8 At[4][2], B0[2][2], B1[2][2];
    unsigned cB = cur.B, cB1 = cur.B1;
    if constexpr (BF32) {
        PG8_STAGE_A(PG8_SA(0, 0), voC[0], 0); PG8_STAGE_A(PG8_SA(0, 1), voC[1], 0);
        PG8_BLOAD(0, cB, 0); PG8_BWRITE(PG8_SB(0, 0)); PG8_BLOAD(1, cB1, 0); PG8_BWRITE(PG8_SB(0, 1));
        PG8_WAIT_V(0); PG8_WAIT_L(0);
        if (wr == 1) PG8_BAR;
        PG8_BAR;
        PG8_STAGE_A(PG8_SA(1, 0), voC[0], kstep); PG8_BLOAD(0, cB, 1);
        PG8_BAR;
    } else {
    PG8_STAGE_B(PG8_SB(0, 0), cB); PG8_STAGE_B(PG8_SB(0, 1), cB + hstepB); PG8_STAGE_A(PG8_SA(0, 0), voC[0], 0); PG8_STAGE_A(PG8_SA(0, 1), voC[1], 0);
    if (wr == 1) PG8_BAR;
    PG8_WAIT_V(2); PG8_BAR;
    PG8_STAGE_B(PG8_SB(1, 0), cB + kstep); PG8_STAGE_A(PG8_SA(1, 0), voC[0], kstep); PG8_STAGE_B(PG8_SB(1, 1), cB + hstepB + kstep);
    PG8_WAIT_V(6); PG8_BAR;
    }
    for (;;) {
        const bool has_next = S.next(ui + 1, nxt);
        const unsigned nB = has_next ? nxt.B : cB, nB1 = has_next ? nxt.B1 : cB1;
        if (has_next) { PG8_SETVO(voN, nxt); } else {
#pragma unroll
            for (int h = 0; h < 2; ++h)
#pragma unroll
                for (int i = 0; i < 2; ++i) voN[h][i] = voC[h][i]; }
        for (int t = 0; t < nt; t += 2) {
            const bool last = (t == nt - 2);
            const unsigned kb1 = (unsigned)(t + 1) * kstep;
            const unsigned kb2 = last ? 0u : (unsigned)(t + 2) * kstep, kb3 = kb2 + kstep;
            const unsigned b2 = last ? nB : cB + (unsigned)(t + 2) * kstep, b3 = b2 + kstep;
            unsigned vo2[2][2];
#pragma unroll
            for (int h = 0; h < 2; ++h)
#pragma unroll
                for (int i = 0; i < 2; ++i) vo2[h][i] = last ? voN[h][i] : voC[h][i];
            if constexpr (BF32) {
            const unsigned h20 = last ? nB : cB; const int kt2 = last ? 0 : t + 2;
            PG8_LDBT(B0, 0, 0); PG8_SCHED; PG8_LDA(At, 0, 0); PG8_BWRITE(PG8_SB(1, 0)); PG8_STAGE_A(PG8_SA(1, 1), voC[1], kb1); PG8_BLOAD(1, cB1, t + 1);
            PG8_WAIT_L(0); PG8_BAR; PG8_MMA(0, 0, At, B0); PG8_SCHED; PG8_LDBT(B0, 0, 1); PG8_WAIT_L(0); PG8_SCHED; PG8_MMA(0, 1, At, B0); PG8_BAR; PG8_SCHED;
            PG8_LDBT(B0, 0, 0); PG8_SCHED; PG8_LDA(At, 0, 1); PG8_BWRITE(PG8_SB(1, 1)); PG8_STAGE_A(PG8_SA(0, 0), vo2[0], kb2); PG8_BLOAD(0, h20, kt2);
            PG8_WAIT_L(0); PG8_BAR; PG8_MMA(1, 0, At, B0); PG8_SCHED; PG8_LDBT(B0, 0, 1); PG8_WAIT_L(0); PG8_SCHED; PG8_MMA(1, 1, At, B0); PG8_BAR; PG8_SCHED;
            const unsigned h21 = last ? nB1 : cB1;
            PG8_LDBT(B0, 1, 0); PG8_SCHED; PG8_LDA(At, 1, 0); PG8_BWRITE(PG8_SB(0, 0)); PG8_STAGE_A(PG8_SA(0, 1), vo2[1], kb2); PG8_BLOAD(1, h21, kt2);
            PG8_WAIT_L(0); PG8_BAR; PG8_MMA(0, 0, At, B0); PG8_SCHED; PG8_LDBT(B0, 1, 1); PG8_WAIT_L(0); PG8_SCHED; PG8_MMA(0, 1, At, B0); PG8_BAR; PG8_SCHED;
            PG8_LDA(At, 1, 1); PG8_LDBT(B0, 1, 0); PG8_SCHED; PG8_BWRITE(PG8_SB(0, 1)); PG8_STAGE_A(PG8_SA(1, 0), vo2[0], kb3); PG8_BLOAD(0, h20, kt2 + 1);
            PG8_WAIT_L(0); PG8_BAR; PG8_MMA(1, 0, At, B0); PG8_SCHED; PG8_LDBT(B0, 1, 1); PG8_WAIT_L(0); PG8_SCHED; PG8_MMA(1, 1, At, B0); PG8_BAR; PG8_SCHED;
            } else {
            PG8_LDB(B0, 0, 0); PG8_LDB(B1, 0, 1); PG8_SCHED; PG8_LDA(At, 0, 0); PG8_STAGE_A(PG8_SA(1, 1), voC[1], kb1);
            PG8_WAIT_V(8); PG8_WAIT_L(0); PG8_BAR; PG8_MMA(0, 0, At, B0); PG8_MMA(0, 1, At, B1); PG8_BAR; PG8_SCHED;
            PG8_LDA(At, 0, 1); PG8_STAGE_B(PG8_SB(0, 0), b2); PG8_STAGE_B(PG8_SB(0, 1), b2 + hstepB); PG8_STAGE_A(PG8_SA(0, 0), vo2[0], kb2);
            PG8_WAIT_V(8); PG8_WAIT_L(0); PG8_BAR; PG8_MMA(1, 0, At, B0); PG8_MMA(1, 1, At, B1); PG8_BAR; PG8_SCHED;
            PG8_LDB(B0, 1, 0); PG8_LDB(B1, 1, 1); PG8_SCHED; PG8_LDA(At, 1, 0); PG8_STAGE_A(PG8_SA(0, 1), vo2[1], kb2);
            PG8_WAIT_V(8); PG8_WAIT_L(0); PG8_BAR; PG8_MMA(0, 0, At, B0); PG8_MMA(0, 1, At, B1); PG8_BAR; PG8_SCHED;
            PG8_LDA(At, 1, 1); PG8_STAGE_B(PG8_SB(1, 0), b3); PG8_STAGE_B(PG8_SB(1, 1), b3 + hstepB); PG8_STAGE_A(PG8_SA(1, 0), vo2[0], kb3);
            PG8_WAIT_V(8); PG8_WAIT_L(0); PG8_BAR; PG8_MMA(1, 0, At, B0); PG8_MMA(1, 1, At, B1); PG8_BAR; PG8_SCHED;
            }
        }
        if constexpr (ALIGN_EPI) { if (wr == 0) PG8_BAR; }
        E(acc, cur, wr, wc, fr, fq);
        if (!has_next) break;
#pragma unroll
        for (int a = 0; a < 2; ++a)
#pragma unroll
            for (int b = 0; b < 2; ++b)
#pragma unroll
                for (int m = 0; m < 4; ++m)
#pragma unroll
                    for (int n = 0; n < 2; ++n) acc[a][b][m][n] = (f32x4){0.f, 0.f, 0.f, 0.f};
        cur = nxt; cB = nB; cB1 = nB1; ++ui;
#pragma unroll
        for (int h = 0; h < 2; ++h)
#pragma unroll
            for (int i = 0; i < 2; ++i) voC[h][i] = voN[h][i];
        if constexpr (ALIGN_EPI) { if (wr == 1) PG8_BAR; }
    }
    PG8_WAIT_V(0);
    if constexpr (!ALIGN_EPI) { if (wr == 0) PG8_BAR; }
    PG8_BAR;
#undef PG8_SA
#undef PG8_SB
#undef PG8_STAGE_A
#undef PG8_STAGE_B
#undef PG8_LDA
#undef PG8_LDB
#undef PG8_LDBT
#undef PG8_LDBX
#undef PG8_TR
#undef PG8_BLOAD
#undef PG8_BWRITE
#undef PG8_MMA
#undef PG8_WAIT_V
#undef PG8_WAIT_L
#undef PG8_BAR
#undef PG8_SCHED
#undef PG8_SETVO
}
}


namespace mz {
using pg8::lds_byte; using pg8::stage_rc; using pg8::Unit; using pg8::s16x4_t; using pg8::v4i16g_t;
template <class Epi, class Sched, bool GATHER>
__device__ __forceinline__ void gemm_z(LAS unsigned char* lds, const void* Amat, const unsigned Abytes, const int K, const Sched& S, const Epi& E) {
    const __amdgpu_buffer_rsrc_t rA = __builtin_amdgcn_make_buffer_rsrc((void*)Amat, 0, Abytes, 0x00020000);
    const __amdgpu_buffer_rsrc_t rB0 = __builtin_amdgcn_make_buffer_rsrc((void*)S.Wb0, 0, S.Wbytes, 0x00020000), rB1 = __builtin_amdgcn_make_buffer_rsrc((void*)S.Wb1, 0, S.Wbytes, 0x00020000);
    const int tid = threadIdx.x, wid = __builtin_amdgcn_readfirstlane(tid >> 6), lane = tid & 63, wr = wid >> 2, wc = wid & 3, fr = lane & 15, fq = lane >> 4;
    const int nt = K / 64;
    const unsigned ldwb = (unsigned)S.ldwb, ktb = 64u * ldwb;
    int Rv[2], Cv[2];
#pragma unroll
    for (int i = 0; i < 2; ++i) stage_rc(tid * 16 + i * 8192, Rv[i], Cv[i]);
    const unsigned ldsw = (unsigned)wid * 1024u;
    const int aoff = lds_byte(wr * 64 + fr, fq * 8);
    const int bk0 = tid >> 5, bmm = tid & 31;
    const unsigned bwoff = (256u * bk0 + 16u * ((unsigned)(bmm >> 1) ^ ((((unsigned)bk0 & 3u) << 2) | (((unsigned)bk0 >> 2) & 3u)))) + 8u * (((unsigned)bmm & 1u) ^ (((unsigned)bk0 >> 3) & 1u));
    unsigned bgo[4];
#pragma unroll
    for (int i = 0; i < 4; ++i) bgo[i] = (unsigned)(bk0 + 16 * i) * ldwb + (unsigned)bmm * 16u;
    unsigned trb[2][2];
#pragma unroll
    for (int t = 0; t < 2; ++t)
#pragma unroll
        for (int nf = 0; nf < 2; ++nf) { const unsigned row = 8u * fq + 4u * t + ((unsigned)fr >> 2), ch = 4u * wc + ((unsigned)fr & 3u);
            trb[t][nf] = 256u * row + 16u * (ch ^ (((row & 3u) << 2) | ((row >> 2) & 3u))) + 8u * ((unsigned)nf ^ ((unsigned)fq & 1u)); }
#define MZ_SB(p, h) (((p) * 2 + (h)) * 16384)
#define MZ_SA(q) (65536 + (q) * 16384)
#define MZ_STAGE_A(q, vo, kb) do { _Pragma("unroll") for (int _i = 0; _i < 2; ++_i) \
        __builtin_amdgcn_raw_ptr_buffer_load_lds(rA, (LAS void*)(lds + MZ_SA(q) + ldsw + _i * 8192), 16, (int)(vo)[_i], (int)(kb), 0, 0); } while (0)
#define MZ_BLOAD(X, so0, so1, kt) do { const int _s0 = (int)((so0) + (unsigned)(kt) * ktb), _s1 = (int)((so1) + (unsigned)(kt) * ktb); _Pragma("unroll") for (int _i = 0; _i < 4; ++_i) { \
        X[0][_i] = __builtin_bit_cast(f32x4, __builtin_amdgcn_raw_buffer_load_b128(rB0, (int)bgo[_i], _s0, 0)); X[1][_i] = __builtin_bit_cast(f32x4, __builtin_amdgcn_raw_buffer_load_b128(rB1, (int)bgo[_i], _s1, 0)); } } while (0)
#define MZ_BWRITE(X, p) do { _Pragma("unroll") for (int _h = 0; _h < 2; ++_h) _Pragma("unroll") for (int _i = 0; _i < 4; ++_i) { v2u _w; _w.x = cvt_pk_bf16(X[_h][_i].x, X[_h][_i].y); _w.y = cvt_pk_bf16(X[_h][_i].z, X[_h][_i].w); \
        *(LAS v2u*)(lds + MZ_SB(p, _h) + bwoff + 4096 * _i) = _w; } } while (0)
#define MZ_TR(addr) __builtin_bit_cast(s16x4_t, __builtin_amdgcn_ds_read_tr16_b64_v4i16((LAS v4i16g_t*)(addr)))
#define MZ_LDB(dst, p, h) do { _Pragma("unroll") for (int n = 0; n < 2; ++n) _Pragma("unroll") for (int k = 0; k < 2; ++k) { \
        const s16x4_t _lo = MZ_TR(lds + MZ_SB(p, h) + trb[0][n] + 8192 * k), _hi = MZ_TR(lds + MZ_SB(p, h) + trb[1][n] + 8192 * k); \
        dst[n][k] = (bf16x8){_lo[0], _lo[1], _lo[2], _lo[3], _hi[0], _hi[1], _hi[2], _hi[3]}; } } while (0)
#define MZ_LDA(q) do { _Pragma("unroll") for (int m = 0; m < 4; ++m) _Pragma("unroll") for (int k = 0; k < 2; ++k) At[m][k] = *(const LAS bf16x8*)(lds + MZ_SA(q) + aoff + m * 2048 + k * 1024); } while (0)
#define MZ_MMA() do { __builtin_amdgcn_s_setprio(1); _Pragma("unroll") for (int m = 0; m < 4; ++m) _Pragma("unroll") for (int n = 0; n < 2; ++n) _Pragma("unroll") for (int k = 0; k < 2; ++k) { \
        acc[0][m][n] = __builtin_amdgcn_mfma_f32_16x16x32_bf16(B0[n][k], At[m][k], acc[0][m][n], 0, 0, 0); acc[1][m][n] = __builtin_amdgcn_mfma_f32_16x16x32_bf16(B1[n][k], At[m][k], acc[1][m][n], 0, 0, 0); } \
        __builtin_amdgcn_s_setprio(0); } while (0)
#define MZ_WAIT_V(n) asm volatile("s_waitcnt vmcnt(" #n ")" ::: "memory")
#define MZ_WAIT_L(n) asm volatile("s_waitcnt lgkmcnt(" #n ")" ::: "memory")
#define MZ_BAR __builtin_amdgcn_s_barrier()
#define MZ_SCHED __builtin_amdgcn_sched_barrier(0)
#define MZ_SETVO(vo, u) do { _Pragma("unroll") for (int _i = 0; _i < 2; ++_i) { const int _row = GATHER ? S.arow(u, Rv[_i]) : (u).arow0 + Rv[_i]; (vo)[_i] = (unsigned)(_row * K + Cv[_i]) * 2u; } } while (0)
#define MZ_SP(q, p, X, avo, akb, b0, b1, bkt) do { \
        MZ_LDA(q); MZ_LDB(B0, p, 0); MZ_LDB(B1, p, 1); MZ_SCHED; MZ_BWRITE(X, (p) ^ 1); MZ_STAGE_A(((q) + 2) & 3, avo, akb); MZ_BLOAD(X, b0, b1, bkt); \
        MZ_WAIT_V(18); MZ_WAIT_L(0); MZ_BAR; MZ_MMA(); MZ_BAR; MZ_SCHED; } while (0)
    Unit cur, nxt; int ui = 0;
    if (!S.next(0, cur)) return;
    unsigned voC[2], voN[2];
    MZ_SETVO(voC, cur);
    f32x4 acc[2][4][2];
#pragma unroll
    for (int b = 0; b < 2; ++b)
#pragma unroll
        for (int m = 0; m < 4; ++m)
#pragma unroll
            for (int n = 0; n < 2; ++n) acc[b][m][n] = (f32x4){0.f, 0.f, 0.f, 0.f};
    bf16x8 At[4][2], B0[2][2], B1[2][2];
    f32x4 P[2][4], Q[2][4];
    MZ_STAGE_A(0, voC, 0); MZ_STAGE_A(1, voC, 128);
    MZ_BLOAD(P, cur.B, cur.B1, 0); MZ_BWRITE(P, 0);
    MZ_WAIT_V(0); MZ_WAIT_L(0);
    if (wr == 1) MZ_BAR;
    MZ_BAR;
    MZ_BLOAD(P, cur.B, cur.B1, 1); MZ_BLOAD(Q, cur.B, cur.B1, 2);
    for (;;) {
        const bool has_next = S.next(ui + 1, nxt);
        const unsigned nB = has_next ? nxt.B : cur.B, nB1 = has_next ? nxt.B1 : cur.B1;
        if (has_next) { MZ_SETVO(voN, nxt); } else { voN[0] = voC[0]; voN[1] = voC[1]; }
        for (int t = 0; t < nt; t += 4) {
            const bool last = (t == nt - 4);
            MZ_SP(0, 0, P, voC, (unsigned)(t + 2) * 128u, cur.B, cur.B1, t + 3);
            { const unsigned b0 = last ? nB : cur.B, b1 = last ? nB1 : cur.B1; const int bkt = last ? 0 : t + 4;
              MZ_SP(1, 1, Q, voC, (unsigned)(t + 3) * 128u, b0, b1, bkt); }
            { const unsigned b0 = last ? nB : cur.B, b1 = last ? nB1 : cur.B1; const int bkt = last ? 1 : t + 5;
              unsigned av[2]; av[0] = last ? voN[0] : voC[0]; av[1] = last ? voN[1] : voC[1]; const unsigned akb = last ? 0u : (unsigned)(t + 4) * 128u;
              MZ_SP(2, 0, P, av, akb, b0, b1, bkt); }
            { const unsigned b0 = last ? nB : cur.B, b1 = last ? nB1 : cur.B1; const int bkt = last ? 2 : t + 6;
              unsigned av[2]; av[0] = last ? voN[0] : voC[0]; av[1] = last ? voN[1] : voC[1]; const unsigned akb = last ? 128u : (unsigned)(t + 5) * 128u;
              MZ_SP(3, 1, Q, av, akb, b0, b1, bkt); }
        }
        if (wr == 0) MZ_BAR;
        E(acc, cur, wr, wc, fr, fq);
        if (!has_next) break;
#pragma unroll
        for (int b = 0; b < 2; ++b)
#pragma unroll
            for (int m = 0; m < 4; ++m)
#pragma unroll
                for (int n = 0; n < 2; ++n) acc[b][m][n] = (f32x4){0.f, 0.f, 0.f, 0.f};
        cur = nxt; ++ui; voC[0] = voN[0]; voC[1] = voN[1];
        if (wr == 1) MZ_BAR;
    }
    MZ_WAIT_V(0);
    MZ_BAR;
#undef MZ_SB
#undef MZ_SA
#undef MZ_STAGE_A
#undef MZ_BLOAD
#undef MZ_BWRITE
#undef MZ_TR
#undef MZ_LDB
#undef MZ_LDA
#undef MZ_MMA
#undef MZ_WAIT_V
#undef MZ_WAIT_L
#undef MZ_BAR
#undef MZ_SCHED
#undef MZ_SETVO
#undef MZ_SP
}
}


namespace mw {
using pg8::lds_byte; using pg8::stage_rc; using pg8::Unit; using pg8::s16x4_t; using pg8::v4i16g_t;
template <class Epi, class Sched, bool GATHER>
__device__ __forceinline__ void gemm_w(LAS unsigned char* lds, const void* Amat, const unsigned Abytes, const int K, const Sched& S, const Epi& E) {
    const __amdgpu_buffer_rsrc_t rA = __builtin_amdgcn_make_buffer_rsrc((void*)Amat, 0, Abytes, 0x00020000);
    const __amdgpu_buffer_rsrc_t rB0 = __builtin_amdgcn_make_buffer_rsrc((void*)S.Wb0, 0, S.Wbytes, 0x00020000), rB1 = __builtin_amdgcn_make_buffer_rsrc((void*)S.Wb1, 0, S.Wbytes, 0x00020000);
    const int wid = S.wave, lane = lane_now(), tid = wid * 64 + lane, wr = wid >> 2, wc = wid & 3, fr = lane & 15, fq = lane >> 4;
    const int nt = K / 64;
    const unsigned ldwb = (unsigned)S.ldwb, ktb = 64u * ldwb, pstep = 16u * ldwb, hA = (unsigned)(128 * K * 2);
    int Rv[2], Cv[2]; unsigned al[2];
#pragma unroll
    for (int i = 0; i < 2; ++i) { stage_rc(tid * 16 + i * 8192, Rv[i], Cv[i]); al[i] = (unsigned)(Rv[i] * K + Cv[i]) * 2u; }
    const unsigned ldsw = (unsigned)wid * 1024u;
    const int aoff = lds_byte(wr * 64 + fr, fq * 8);
    const int bk0 = tid >> 5, bmm = tid & 31;
    const unsigned bwoff = (256u * bk0 + 16u * ((unsigned)(bmm >> 1) ^ ((((unsigned)bk0 & 3u) << 2) | (((unsigned)bk0 >> 2) & 3u)))) + 8u * (((unsigned)bmm & 1u) ^ (((unsigned)bk0 >> 3) & 1u));
    const unsigned bgoff = (unsigned)bk0 * ldwb + (unsigned)bmm * 16u;
    unsigned trb[2];
#pragma unroll
    for (int t = 0; t < 2; ++t) { const unsigned row = 8u * fq + 4u * t + ((unsigned)fr >> 2), ch = 4u * wc + ((unsigned)fr & 3u);
        trb[t] = 256u * row + 16u * (ch ^ (((row & 3u) << 2) | ((row >> 2) & 3u))) + 8u * ((unsigned)fq & 1u); }
    unsigned tra[2][2];
#pragma unroll
    for (int t = 0; t < 2; ++t)
#pragma unroll
        for (int n = 0; n < 2; ++n) tra[t][n] = (unsigned)(__SIZE_TYPE__)lds + (trb[t] ^ (8u * n));
#define MW_SB(b, h) (((b) * 2 + (h)) * 16384)
#define MW_SA(b, h) ((4 + (b) * 2 + (h)) * 16384)
#define MW_TRA(dst, a, off) asm volatile("ds_read_b64_tr_b16 %0, %1 offset:%2" : "=v"(dst) : "v"(a), "n"(off))
#define MW_LDB_A1(b, h, n, k) do { v2u _lo, _hi; MW_TRA(_lo, tra[0][n], MW_SB(b, h) + 8192 * (k)); MW_TRA(_hi, tra[1][n], MW_SB(b, h) + 8192 * (k)); \
        B0[n][k] = __builtin_bit_cast(bf16x8, (v4u){_lo.x, _lo.y, _hi.x, _hi.y}); } while (0)
#define MW_LDB_A(b, h) do { MW_LDB_A1(b, h, 0, 0); MW_LDB_A1(b, h, 0, 1); MW_LDB_A1(b, h, 1, 0); MW_LDB_A1(b, h, 1, 1); } while (0)
    const unsigned aad = (unsigned)(__SIZE_TYPE__)lds + 65536u + (unsigned)aoff;
#define MW_LDA_A1(b, h, m, k) asm volatile("ds_read_b128 %0, %1 offset:%2" : "=v"(At[m][k]) : "v"(aad), "n"(((b) * 2 + (h)) * 16384 + (m) * 2048 + (k) * 1024))
#define MW_LDA_A(b, h) do { MW_LDA_A1(b, h, 0, 0); MW_LDA_A1(b, h, 0, 1); MW_LDA_A1(b, h, 1, 0); MW_LDA_A1(b, h, 1, 1); MW_LDA_A1(b, h, 2, 0); MW_LDA_A1(b, h, 2, 1); MW_LDA_A1(b, h, 3, 0); MW_LDA_A1(b, h, 3, 1); } while (0)
#define MW_VO_voC(h, i) voC[h][i]
#define MW_VO_voN(h, i) voNt[(2 * (h) + (i)) * 512]
#define MW_STAGE_A(b, h, vo, uo, kb) do { _Pragma("unroll") for (int _i = 0; _i < 2; ++_i) { \
        if constexpr (GATHER) __builtin_amdgcn_raw_ptr_buffer_load_lds(rA, (LAS void*)(lds + MW_SA(b, h) + ldsw + _i * 8192), 16, (int)MW_VO_##vo(h, _i), (int)(kb), 0, 0); \
        else __builtin_amdgcn_raw_ptr_buffer_load_lds(rA, (LAS void*)(lds + MW_SA(b, h) + ldsw + _i * 8192), 16, (int)al[_i], (int)((uo) + (h) * hA + (kb)), 0, 0); } } while (0)
#define MW_BLOAD(X, h, so, kt) do { const unsigned _s = (so) + (unsigned)(kt) * ktb; _Pragma("unroll") for (int _i = 0; _i < 4; ++_i) \
        X[_i] = __builtin_bit_cast(f32x4, __builtin_amdgcn_raw_buffer_load_b128((h) ? rB1 : rB0, (int)bgoff, (int)(_s + (unsigned)_i * pstep), 0)); } while (0)
#define MW_BWRITE(X, b, h) do { _Pragma("unroll") for (int _i = 0; _i < 4; ++_i) { v2u _w; _w.x = cvt_pk_bf16(X[_i].x, X[_i].y); _w.y = cvt_pk_bf16(X[_i].z, X[_i].w); *(LAS v2u*)(lds + MW_SB(b, h) + bwoff + 4096 * _i) = _w; } } while (0)
#define MW_TR(addr) __builtin_bit_cast(s16x4_t, __builtin_amdgcn_ds_read_tr16_b64_v4i16((LAS v4i16g_t*)(addr)))
#define MW_LDB(b, h) do { _Pragma("unroll") for (int n = 0; n < 2; ++n) _Pragma("unroll") for (int k = 0; k < 2; ++k) { \
        const s16x4_t _lo = MW_TR(lds + MW_SB(b, h) + (trb[0] ^ (8u * n)) + 8192 * k), _hi = MW_TR(lds + MW_SB(b, h) + (trb[1] ^ (8u * n)) + 8192 * k); \
        B0[n][k] = (bf16x8){_lo[0], _lo[1], _lo[2], _lo[3], _hi[0], _hi[1], _hi[2], _hi[3]}; } } while (0)
#define MW_LDA(b, h) do { _Pragma("unroll") for (int m = 0; m < 4; ++m) _Pragma("unroll") for (int k = 0; k < 2; ++k) At[m][k] = *(const LAS bf16x8*)(lds + MW_SA(b, h) + aoff + m * 2048 + k * 1024); } while (0)
#define MW_MMA(ai, bj) do { __builtin_amdgcn_s_setprio(1); _Pragma("unroll") for (int m = 0; m < 4; ++m) _Pragma("unroll") for (int n = 0; n < 2; ++n) _Pragma("unroll") for (int k = 0; k < 2; ++k) \
        asm volatile("v_mfma_f32_16x16x32_bf16 %0, %1, %2, %0" : "+v"(acc[ai][bj][m][n]) : "v"(B0[n][k]), "v"(At[m][k]));   \
        __builtin_amdgcn_s_setprio(0); } while (0)
#define MW_WAIT_V(n) asm volatile("s_waitcnt vmcnt(" #n ")" ::: "memory")
#define MW_WAIT_L(n) asm volatile("s_waitcnt lgkmcnt(" #n ")" ::: "memory")
#define MW_BAR __builtin_amdgcn_s_barrier()
#define MW_SCHED __builtin_amdgcn_sched_barrier(0)
#define MW_SETVO(vo, u) do { if constexpr (GATHER) { const int _t = wid * 64 + lane_now();   \
        _Pragma("unroll") for (int _i = 0; _i < 2; ++_i) { int _R, _C; stage_rc(_t * 16 + _i * 8192, _R, _C); _Pragma("unroll") for (int _h = 0; _h < 2; ++_h) { \
        const int _row = S.arow(u, _h * 128 + _R); MW_VO_##vo(_h, _i) = (unsigned)(_row * K + _C) * 2u; } } } } while (0)
#define MW_SP(rb, ai, X, wb, wh, sb, sh, svo, suo, skb, lh, lso, lkt) do { \
        MW_LDB_A(rb, 0); MW_SCHED; MW_LDA_A(rb, ai); MW_BWRITE(X, wb, wh); MW_STAGE_A(sb, sh, svo, suo, skb); MW_BLOAD(X, lh, lso, lkt); \
        MW_WAIT_L(0); MW_BAR; MW_MMA(ai, 0); MW_SCHED; MW_LDB_A(rb, 1); MW_WAIT_L(0); MW_SCHED; MW_MMA(ai, 1); MW_BAR; MW_SCHED; } while (0)
    Unit cur, nxt; int ui = 0;
    if (!S.next(0, cur)) return;
    unsigned voC[2][2];
    LAS unsigned* const voNt = (LAS unsigned*)(lds + 131072 + 2048) + tid;
    MW_SETVO(voC, cur);
    f32x4 acc[2][2][4][2];
#pragma unroll
    for (int a = 0; a < 2; ++a)
#pragma unroll
        for (int b = 0; b < 2; ++b)
#pragma unroll
            for (int m = 0; m < 4; ++m)
#pragma unroll
                for (int n = 0; n < 2; ++n) acc[a][b][m][n] = (f32x4){0.f, 0.f, 0.f, 0.f};
    bf16x8 At[4][2], B0[2][2];
    f32x4 X[4], Y[4];
    unsigned cU = (unsigned)cur.arow0 * (unsigned)(K * 2);
    MW_STAGE_A(0, 0, voC, cU, 0u); MW_STAGE_A(0, 1, voC, cU, 0u);
    MW_BLOAD(X, 0, cur.B, 0); MW_BWRITE(X, 0, 0); MW_BLOAD(Y, 1, cur.B1, 0); MW_BWRITE(Y, 0, 1);
    MW_WAIT_V(0); MW_WAIT_L(0);
    if (wr == 1) MW_BAR;
    MW_BAR;
    MW_STAGE_A(1, 0, voC, cU, 128u); MW_BLOAD(X, 0, cur.B, 1); MW_BLOAD(Y, 1, cur.B1, 1);
    MW_BAR;
    for (;;) {
        const bool has_next = S.next(ui + 1, nxt);
        const unsigned nB = has_next ? nxt.B : cur.B, nB1 = has_next ? nxt.B1 : cur.B1, nU = has_next ? (unsigned)nxt.arow0 * (unsigned)(K * 2) : cU;
        if constexpr (GATHER) { if (has_next) { MW_SETVO(voN, nxt); } else {
#pragma unroll
            for (int h = 0; h < 2; ++h)
#pragma unroll
                for (int i = 0; i < 2; ++i) MW_VO_voN(h, i) = voC[h][i]; } }
        for (int t = 0; t < nt - 2; t += 2) {
            MW_SP(0, 0, X, 1, 0, 1, 1, voC, cU, (unsigned)(t + 1) * 128u, 0, cur.B, t + 2);
            MW_SP(0, 1, Y, 1, 1, 0, 0, voC, cU, (unsigned)(t + 2) * 128u, 1, cur.B1, t + 2);
            MW_SP(1, 0, X, 0, 0, 0, 1, voC, cU, (unsigned)(t + 2) * 128u, 0, cur.B, t + 3);
            MW_SP(1, 1, Y, 0, 1, 1, 0, voC, cU, (unsigned)(t + 3) * 128u, 1, cur.B1, t + 3);
        }
        {
            const int t = nt - 2;
            MW_SP(0, 0, X, 1, 0, 1, 1, voC, cU, (unsigned)(t + 1) * 128u, 0, nB, 0);
            MW_SP(0, 1, Y, 1, 1, 0, 0, voN, nU, 0u, 1, nB1, 0);
            MW_SP(1, 0, X, 0, 0, 0, 1, voN, nU, 0u, 0, nB, 1);
            MW_SP(1, 1, Y, 0, 1, 1, 0, voN, nU, 128u, 1, nB1, 1);
        }
        asm volatile("s_nop 15\n\ts_nop 7" ::: "memory");
        if (wr == 0) MW_BAR;
        E(acc, cur, wr, wc, fr, fq);
        if (!has_next) break;
#pragma unroll
        for (int a = 0; a < 2; ++a)
#pragma unroll
            for (int b = 0; b < 2; ++b)
#pragma unroll
                for (int m = 0; m < 4; ++m)
#pragma unroll
                    for (int n = 0; n < 2; ++n) acc[a][b][m][n] = (f32x4){0.f, 0.f, 0.f, 0.f};
        cur = nxt; cU = nU; ++ui;
        if constexpr (GATHER) {
#pragma unroll
            for (int h = 0; h < 2; ++h)
#pragma unroll
                for (int i = 0; i < 2; ++i) voC[h][i] = MW_VO_voN(h, i); }
        if (wr == 1) MW_BAR;
    }
    MW_WAIT_V(0);
    MW_BAR;
#undef MW_SB
#undef MW_SA
#undef MW_STAGE_A
#undef MW_BLOAD
#undef MW_BWRITE
#undef MW_TR
#undef MW_TRA
#undef MW_LDB_A1
#undef MW_LDB_A
#undef MW_LDA_A1
#undef MW_LDA_A
#undef MW_LDB
#undef MW_LDA
#undef MW_MMA
#undef MW_WAIT_V
#undef MW_WAIT_L
#undef MW_BAR
#undef MW_SCHED
#undef MW_SETVO
#undef MW_VO_voC
#undef MW_VO_voN
#undef MW_SP
}
}

#define XB_TMO      128
#define XB_XCNT(j)  (256  + 64 * (j))
#define XB_XSUB(j)  (1280 + 64 * (j))
#define XB_XGEN(j)  (2304 + 64 * (j))
#define XB_TOP      3328
#define XB_TOPGEN   3392
#define XCD_BAR_WORDS 3456
#define XB_SPIN_CAP (1u << 18)
__device__ __forceinline__ unsigned xb_ld(unsigned* p)              { return __hip_atomic_load(p, __ATOMIC_RELAXED, __HIP_MEMORY_SCOPE_AGENT); }
__device__ __forceinline__ unsigned xb_add(unsigned* p, unsigned v) { return __hip_atomic_fetch_add(p, v, __ATOMIC_RELAXED, __HIP_MEMORY_SCOPE_AGENT); }
__device__ __forceinline__ unsigned xb_xcc_id() { return (unsigned)__builtin_amdgcn_s_getreg((3 << 11) | 20) & 0xFu; }
#define XB_SPIN(cond, bar) do { unsigned _sp = 0; while (cond) { __builtin_amdgcn_s_sleep(1); \
    if ((++_sp & 255u) == 0u) { if (xb_ld(&(bar)[XB_TMO])) break; if (_sp > XB_SPIN_CAP) { atomicAdd(&(bar)[XB_TMO], 1u); break; } } } } while (0)
struct XcdBarrier { unsigned* bar; unsigned x; volatile LAS unsigned* st; };
__device__ __forceinline__ XcdBarrier xcd_barrier_post(unsigned* bar, volatile LAS unsigned* st) {
    XcdBarrier b; b.bar = bar; b.x = xb_xcc_id(); b.st = st;
    if (threadIdx.x == 0) (void)xb_add(&bar[XB_XCNT(b.x)], 1u);
    return b;
}
__device__ __forceinline__ void xcd_barrier_complete(unsigned* bar, unsigned x, unsigned& nloc, unsigned& nx) {
    const unsigned G = gridDim.x * gridDim.y * gridDim.z;
    unsigned sum, cnt, mine, sp = 0u;
    for (;;) {
        sum = 0u; cnt = 0u; mine = 0u;
#pragma unroll
        for (unsigned j = 0; j < 16; ++j) { const unsigned c = xb_ld(&bar[XB_XCNT(j)]); sum += c; cnt += (c > 0u) ? 1u : 0u; mine = (j == x) ? c : mine; }
        if (sum == G) break;
        __builtin_amdgcn_s_sleep(1);
        if ((++sp & 255u) == 0u) { if (xb_ld(&bar[XB_TMO])) break; if (sp > XB_SPIN_CAP) { atomicAdd(&bar[XB_TMO], 1u); break; } }
    }
    nloc = mine > 0u ? mine : 1u; nx = cnt > 0u ? cnt : 1u;
}
__device__ __forceinline__ void xcd_barrier(const XcdBarrier& b) {
    asm volatile("s_waitcnt vmcnt(0)" ::: "memory");
    __syncthreads();
    if (threadIdx.x == 0) {
        unsigned* bar = b.bar;
        __builtin_amdgcn_s_waitcnt(0);
        unsigned nloc = b.st[0], nx = b.st[1];
        if (nloc == 0u) { xcd_barrier_complete(bar, b.x, nloc, nx); b.st[0] = nloc; b.st[1] = nx; }
        const unsigned old = xb_add(&bar[XB_XSUB(b.x)], 1u);
        const unsigned gen = old / nloc;
        if (old + 1u == (gen + 1u) * nloc) {
            __builtin_amdgcn_fence(__ATOMIC_RELEASE, "agent");
            asm volatile("s_waitcnt vmcnt(0)" ::: "memory");
            const unsigned og = xb_add(&bar[XB_TOP], 1u);
            const unsigned tg = og / nx;
            if (og + 1u == (tg + 1u) * nx) xb_add(&bar[XB_TOPGEN], 1u);
            else XB_SPIN(xb_ld(&bar[XB_TOPGEN]) == tg, bar);
            __builtin_amdgcn_fence(__ATOMIC_ACQUIRE, "agent");
            xb_add(&bar[XB_XGEN(b.x)], 1u);
            asm volatile("s_waitcnt vmcnt(0)" ::: "memory");
        } else {
            XB_SPIN(xb_ld(&bar[XB_XGEN(b.x)]) == gen, bar);
            __builtin_amdgcn_fence(__ATOMIC_ACQUIRE, "agent");
            asm volatile("s_waitcnt vmcnt(0)" ::: "memory");
        }
    }
    __syncthreads();
}

__device__ __forceinline__ void wave_arrive(volatile LAS unsigned* wcnt, unsigned* xcnt, unsigned nloc, unsigned* top) {
    asm volatile("s_waitcnt vmcnt(0)" ::: "memory");
    if (lane_now() == 0) {
        const unsigned o = __hip_atomic_fetch_add((LAS unsigned*)wcnt, 1u, __ATOMIC_RELAXED, __HIP_MEMORY_SCOPE_WORKGROUP);
        if (o == (unsigned)NWAVES - 1u) {
            *wcnt = 0u;
            const unsigned old = xb_add(xcnt, 1u);
            if (old + 1u == nloc) {
                __builtin_amdgcn_fence(__ATOMIC_RELEASE, "agent");
                asm volatile("s_waitcnt vmcnt(0)" ::: "memory");
                (void)xb_add(top, nloc);
            }
        }
    }
}
__device__ __forceinline__ void wg_wait_count(unsigned* ctr, unsigned target, unsigned* bar) {
    if (threadIdx.x == 0) {
        XB_SPIN(xb_ld(ctr) < target, bar);
        __builtin_amdgcn_fence(__ATOMIC_ACQUIRE, "agent");
        asm volatile("s_waitcnt vmcnt(0)" ::: "memory");
    }
    __syncthreads();
}

struct Frame {
    LAS unsigned char* lds; volatile LAS unsigned* MISC; gu32* ctl;
    int tid, lane, wave, vcu, G;
    const float *x, *norm1_w, *w_in, *gn_w, *conv_w, *w_o, *norm2_w, *rg_w, *rg_b, *re_w, *re_b, *w_gate, *w_up, *w_down, *fin_w;
    float* out; unsigned char* ws;
};
__device__ __forceinline__ float wave_sum(float v) {
#pragma unroll
    for (int o = 1; o < 64; o <<= 1) v += __shfl_xor(v, o);
    return v;
}

__device__ __forceinline__ int win_srccol(int c) {
    const int tile = c >> 8, bj = (c >> 7) & 1, p = c & 127;
    if (tile < 4) { const int head = (tile & 1) * 2 + bj; const int orig = 4 * (p >> 3) + (p & 3) + 64 * ((p >> 2) & 1); return (tile >> 1) * RW + head * HD + orig; }
    if (tile < 10) return 1024 + (c - 1024);
    const int t = tile - 10; return (bj ? 3072 : 2560) + 128 * t + p;
}
__device__ __forceinline__ void p0_transpose_item(const float* W, int ldw, int srccol, bf16* WT0, int Kd, int k0, const float* scale, LAS float* scr, int lane) {
    const int dn = 4 * (lane & 7), kr = lane >> 3;
    f32x4 v[8];
#pragma unroll
    for (int i = 0; i < 8; ++i) v[i] = *(const GAS f32x4*)(W + (size_t)(k0 + 8 * i + kr) * ldw + srccol);
#pragma unroll
    for (int i = 0; i < 8; ++i) { LAS float* s = scr + (8 * i + kr) * 33 + dn; s[0] = v[i].x; s[1] = v[i].y; s[2] = v[i].z; s[3] = v[i].w; }
    LDS_WAIT(); asm volatile("" ::: "memory");
    const int c = lane & 7;
    f32x4 s0 = (f32x4){1.f, 1.f, 1.f, 1.f}, s1 = s0;
    if (scale) { s0 = *(const GAS f32x4*)(scale + k0 + 8 * c); s1 = *(const GAS f32x4*)(scale + k0 + 8 * c + 4); }
#pragma unroll
    for (int j = 0; j < 4; ++j) { const int n = (lane >> 3) + 8 * j; const LAS float* s = scr + (8 * c) * 33 + n;
        v4u o; o.x = pk2(s[0 * 33] * s0.x, s[1 * 33] * s0.y); o.y = pk2(s[2 * 33] * s0.z, s[3 * 33] * s0.w); o.z = pk2(s[4 * 33] * s1.x, s[5 * 33] * s1.y); o.w = pk2(s[6 * 33] * s1.z, s[7 * 33] * s1.w);
        *(GAS v4u*)(WT0 + (size_t)n * Kd + k0 + 8 * c) = o; }
    LDS_WAIT(); asm volatile("" ::: "memory");
}
__device__ __forceinline__ void rms_row_to_bf16(const float* xrow, const float* w, bf16* orow, int lane) {
    const GAS f32x4* xr = (const GAS f32x4*)xrow + lane;
    f32x4 v[4]; float s = 0.f;
#pragma unroll
    for (int j = 0; j < 4; ++j) { v[j] = xr[64 * j]; s += (v[j].x * v[j].x + v[j].y * v[j].y) + (v[j].z * v[j].z + v[j].w * v[j].w); }
    const float rs = 1.f / sqrtf(wave_sum(s) * (1.f / D) + EPS);
    GAS unsigned long long* o8 = (GAS unsigned long long*)orow + lane;
#pragma unroll
    for (int j = 0; j < 4; ++j) { const f32x4 ww = ((const GAS f32x4*)w)[lane + 64 * j];
        o8[64 * j] = (unsigned long long)pk2(v[j].x * rs * ww.x, v[j].y * rs * ww.y) | ((unsigned long long)pk2(v[j].z * rs * ww.z, v[j].w * rs * ww.w) << 32); }
}
__device__ __forceinline__ void p0_prologue(Frame& F) {
    LAS float* scr = (LAS float*)(F.lds + RING_OFF + F.wave * 16384);
    const int gw = F.vcu * NWAVES + F.wave, NGW = F.G * NWAVES, lane = F.lane;
    bf16* WinT = (bf16*)(F.ws + WS_WINT); bf16* WoT = (bf16*)(F.ws + WS_WOT);
    constexpr int I_IN = (D / 64) * (INC / 32), I_O = (D / 64) * (D / 32);
    constexpr int NITEMS = I_IN + I_O;
    for (int it = gw; it < NITEMS; it += NGW) {
        int r = it;
        if (r < I_IN) { const int nb = r % (INC / 32), kb = r / (INC / 32); const int n0 = 32 * nb;
            p0_transpose_item(F.w_in, INC, win_srccol(n0 + 4 * (lane & 7)), WinT + (size_t)n0 * D, D, 64 * kb, nullptr, scr, lane); continue; }
        r -= I_IN;
        { const int nb = r % (D / 32), kb = r / (D / 32); const int n0 = 32 * nb;
            p0_transpose_item(F.w_o, D, n0 + 4 * (lane & 7), WoT + (size_t)n0 * D, D, 64 * kb, nullptr, scr, lane); }
    }
    for (int idx = F.vcu * 512 + F.tid; idx < M; idx += F.G * 512) ((float*)(F.ws + WS_SSQ))[idx] = 0.f;
    { bf16* WrT = (bf16*)(F.ws + WS_WRT);
      for (int idx = F.vcu * 512 + F.tid; idx < 128 * D; idx += F.G * 512) {
          const int n = idx >> 10, k = idx & 1023; float v = 0.f;
          if (n < 8) v = F.rg_w[k * NG + n];
          else if (n < 72) { const int gg = (n - 8) >> 3, ee = (n - 8) & 7; v = F.re_w[((size_t)gg * D + k) * EPG + ee]; }
          WrT[idx] = (bf16)f2bf(v); } }
    bf16* XN = (bf16*)(F.ws + WS_XN);
    for (int m = gw; m < M; m += NGW) rms_row_to_bf16(F.x + (size_t)m * D, F.norm1_w, XN + (size_t)m * D, lane);
    float* rc = (float*)(F.ws + WS_ROPE); float* rsn = rc + SEQ * 64;
    for (int idx = F.vcu * 512 + F.tid; idx < SEQ * 64; idx += F.G * 512) {
        const int i = idx & 63, pos = idx >> 6;
        const float inv = (float)exp2(-(double)i * (13.287712379549449 / 64.0));
        const float ang = (float)pos * inv;
        const double rev = (double)ang * 0.15915494309189535;
        const float fr = (float)(rev - floor(rev));
        rc[idx] = __builtin_amdgcn_cosf(fr); rsn[idx] = __builtin_amdgcn_sinf(fr);
    }
}

struct InProjSched {
    int c, G; const void* Wb0; const void* Wb1; unsigned Wbytes;
    __device__ __forceinline__ bool next(int i, pg8::Unit& u) const {
        constexpr int nM = M / 256, nN = INC / 256, nwg = nM * nN;
        const int L = i * G + c; if (L >= nwg) return false;
        int wgid = L; { const int q = nwg / 8, r = nwg % 8, xcd = wgid % 8, off = wgid / 8; wgid = (xcd < r ? xcd * (q + 1) : r * (q + 1) + (xcd - r) * q) + off; }
        const int nig = 8 * nN, gid = wgid / nig, fm = gid * 8;
        u.pm = fm + ((wgid % nig) % 8); u.pn = (wgid % nig) / 8; u.arow0 = u.pm * 256; u.e = i; u.rb = 0; u.nvalid = 256;
        u.B = (unsigned)u.pn * (256u * D * 2u); u.B1 = u.B; return true;
    }
    __device__ __forceinline__ int arow(const pg8::Unit&, int) const { return 0; }
};
struct EpiInProj {
    static constexpr bool PERM = true;
    bf16* base; const float *rc, *rs; unsigned *xc1, *top1; volatile LAS unsigned* misc;
    __device__ __forceinline__ void operator()(const f32x4 (&acc)[2][2][4][2], const pg8::Unit& u, int wr, int wc, int fr, int fq) const {
        const int row0 = u.pm * 256 + wr * 64 + fr; const int pn = u.pn;
        if (pn < 4) {
            bf16* dst = base + (size_t)(pn >> 1) * (8u << 20); const float sc = (pn < 2) ? 0.08838834764831845f : 1.0f;
            const int i0 = 4 * (4 * wc + fq);
#pragma unroll
            for (int ai = 0; ai < 2; ++ai)
#pragma unroll
                for (int m = 0; m < 4; ++m) { const int r = row0 + ai * 128 + m * 16; const int pos = r & (SEQ - 1);
                    const f32x4 cs = *(const f32x4*)(rc + pos * 64 + i0), sn = *(const f32x4*)(rs + pos * 64 + i0);
#pragma unroll
                    for (int bj = 0; bj < 2; ++bj) { const f32x4 x1 = acc[ai][bj][m][0], x2 = acc[ai][bj][m][1];
                        const f32x4 o1 = (x1 * cs - x2 * sn) * sc, o2 = (x2 * cs + x1 * sn) * sc;
                        v4u w; w.x = cvt_pk_bf16(o1[0], o1[1]); w.y = cvt_pk_bf16(o1[2], o1[3]); w.z = cvt_pk_bf16(o2[0], o2[1]); w.w = cvt_pk_bf16(o2[2], o2[3]);
                        *(v4u*)(dst + (size_t)r * RW + ((pn & 1) * 2 + bj) * HD + wc * 32 + 8 * fq) = w; } }
        } else if (pn < 10) {
            bf16* dst = base + (size_t)(pn >> 1) * (8u << 20);
#pragma unroll
            for (int ai = 0; ai < 2; ++ai)
#pragma unroll
                for (int m = 0; m < 4; ++m) { const int r = row0 + ai * 128 + m * 16;
#pragma unroll
                    for (int bj = 0; bj < 2; ++bj) { const f32x4 v0 = acc[ai][bj][m][0], v1 = acc[ai][bj][m][1];
                        v4u w; w.x = cvt_pk_bf16(v0[0], v0[1]); w.y = cvt_pk_bf16(v0[2], v0[3]); w.z = cvt_pk_bf16(v1[0], v1[1]); w.w = cvt_pk_bf16(v1[2], v1[3]);
                        *(v4u*)(dst + (size_t)r * RW + (pn & 1) * 256 + bj * 128 + wc * 32 + 8 * fq) = w; } }
        } else {
            const int t = pn - 10; bf16* cub = base + (size_t)5 * (8u << 20);
#pragma unroll
            for (int ai = 0; ai < 2; ++ai)
#pragma unroll
                for (int m = 0; m < 4; ++m) { const int r = row0 + ai * 128 + m * 16;
                    const f32x4 v0 = acc[ai][0][m][0] * acc[ai][1][m][0], v1 = acc[ai][0][m][1] * acc[ai][1][m][1];
                    v4u w; w.x = cvt_pk_bf16(v0[0], v0[1]); w.y = cvt_pk_bf16(v0[2], v0[3]); w.z = cvt_pk_bf16(v1[0], v1[1]); w.w = cvt_pk_bf16(v1[2], v1[3]);
                    *(v4u*)(cub + (size_t)r * RW + t * 128 + wc * 32 + 8 * fq) = w; }
        }
        if (u.e == 1) wave_arrive(misc + 12, xc1, misc[8], top1);
    }
};


typedef short s16x4 __attribute__((ext_vector_type(4)));
typedef short v4i16_t __attribute__((ext_vector_type(4)));
__device__ __forceinline__ unsigned offb(unsigned row, unsigned ch) { return 256u * row + 16u * (ch ^ (((row & 3u) << 2) | ((row >> 2) & 3u))); }
__device__ __forceinline__ bf16x8 tr_frag(const LAS unsigned char* img, int lane, int c, int ks) {
    const unsigned g = lane >> 4, q = (lane & 15) >> 2, p = lane & 3;
    const unsigned a0 = offb(32 * ks + 8 * g + q, 2 * c + (p >> 1)) + 8 * (p & 1), a1 = offb(32 * ks + 8 * g + 4 + q, 2 * c + (p >> 1)) + 8 * (p & 1);
    const s16x4 lo = __builtin_bit_cast(s16x4, __builtin_amdgcn_ds_read_tr16_b64_v4i16((LAS v4i16_t*)(img + a0)));
    const s16x4 hi = __builtin_bit_cast(s16x4, __builtin_amdgcn_ds_read_tr16_b64_v4i16((LAS v4i16_t*)(img + a1)));
    return (bf16x8){lo[0], lo[1], lo[2], lo[3], hi[0], hi[1], hi[2], hi[3]};
}
__device__ __forceinline__ bf16x8 row_frag(const LAS unsigned char* img, int lane, int rb, int s) { return *(const LAS bf16x8*)(img + offb((lane & 15) + 16 * rb, 4 * s + (lane >> 4))); }
__device__ __forceinline__ float lg2_gamma(int h) { return log2f(1.0f - exp2f(-5.0f - (float)h)); }
__device__ __forceinline__ float silu_f(float g) { return g * __builtin_amdgcn_rcpf(1.0f + __expf(-g)); }

__device__ __forceinline__ void tile_load(v4u (&r)[4], const bf16* base, size_t row_stride, int tid) {
#pragma unroll
    for (int i = 0; i < 4; ++i) { const int id = tid + 512 * i, row = id >> 4, ch = id & 15; r[i] = *(const GAS v4u*)(base + (size_t)row * row_stride + 8 * ch); }
}
template <bool KSCALE>
__device__ __forceinline__ void tile_write(const v4u (&r)[4], LAS unsigned char* img, int tid, float lg2) {
#pragma unroll
    for (int i = 0; i < 4; ++i) { const int id = tid + 512 * i, row = id >> 4, ch = id & 15; v4u kv = r[i];
        if (KSCALE) { const float kd = exp2f((float)(CH - 1 - row) * lg2);
            kv.x = pk2(bflo(kv.x) * kd, bfhi(kv.x) * kd); kv.y = pk2(bflo(kv.y) * kd, bfhi(kv.y) * kd); kv.z = pk2(bflo(kv.z) * kd, bfhi(kv.z) * kd); kv.w = pk2(bflo(kv.w) * kd, bfhi(kv.w) * kd); }
        *(LAS v4u*)(img + offb(row, ch)) = kv; }
}
__device__ __forceinline__ void p2_kv_phase(Frame& F, const int u0, const int ustride) {
    bf16* KVT = (bf16*)(F.ws + WS_KVT);
    const bf16* kb = (const bf16*)(F.ws + WS_KB); const bf16* vb = (const bf16*)(F.ws + WS_VB);
    LAS unsigned char* Kimg = F.lds; LAS unsigned char* Vimg = F.lds + 32768;
    const int lane = F.lane, w = F.wave, g = lane >> 4, fr = lane & 15, tid = F.tid;
    LAS unsigned char* stg = F.lds + 65536 + 4096 * w;
    v4u rk[4], rv[4];
    int u = u0;
    if (u < NB * NCH * NH) { const int h = u & 3, n = (u >> 2) & 31, b = u >> 7; const size_t row0 = (size_t)b * SEQ + (size_t)n * CH;
        tile_load(rk, kb + row0 * RW + h * HD, RW, tid); tile_load(rv, vb + row0 * RW + h * HD, RW, tid); }
    for (; u < NB * NCH * NH; u += ustride) {
        const int h = u & 3;
        tile_write<true>(rk, Kimg, tid, lg2_gamma(h)); tile_write<false>(rv, Vimg, tid, 0.f);
        __syncthreads();
        { const int u2 = u + ustride; if (u2 < NB * NCH * NH) { const int h2 = u2 & 3, n2 = (u2 >> 2) & 31, b2 = u2 >> 7; const size_t r2 = (size_t)b2 * SEQ + (size_t)n2 * CH;
            tile_load(rk, kb + r2 * RW + h2 * HD, RW, tid); tile_load(rv, vb + r2 * RW + h2 * HD, RW, tid); } }
        bf16x8 af[4];
#pragma unroll
        for (int ks = 0; ks < 4; ++ks) af[ks] = tr_frag(Vimg, lane, w, ks);
#pragma unroll
        for (int cd = 0; cd < 8; ++cd) {
            f32x4 acc = (f32x4){0.f, 0.f, 0.f, 0.f};
#pragma unroll
            for (int ks = 0; ks < 4; ++ks) acc = __builtin_amdgcn_mfma_f32_16x16x32_bf16(af[ks], tr_frag(Kimg, lane, cd, ks), acc, 0, 0, 0);
#pragma unroll
            for (int r = 0; r < 4; ++r) ((LAS bf16*)stg)[(4 * g + r) * HD + 16 * cd + fr] = (bf16)f2bf(acc[r]);
        }
        LDS_WAIT();
#pragma unroll
        for (int k = 0; k < 4; ++k) { const int id = lane + 64 * k, row = id >> 4, ch = id & 15;
            *(GAS v4u*)(KVT + (size_t)u * (HD * HD) + (size_t)(16 * w + row) * HD + 8 * ch) = *(const LAS v4u*)(stg + row * 256 + ch * 16); }
        __syncthreads();
    }
}
__device__ __forceinline__ void p3_scan_phase(Frame& F, const int u0, const int ustride) {
    const bf16* KVT = (const bf16*)(F.ws + WS_KVT); bf16* prevT = (bf16*)(F.ws + WS_PREVT);
    for (int idx = u0 * 512 + F.tid; idx < NB * NH * HD * HD / 4; idx += ustride * 512) {
        const int de4 = idx & 4095, h = (idx >> 12) & 3, b = idx >> 14;
        const float cd = exp2f((float)CH * lg2_gamma(h));
        float s0 = 0.f, s1 = 0.f, s2 = 0.f, s3 = 0.f;
#pragma unroll 8
        for (int n = 0; n < NCH; ++n) {
            const size_t o = (size_t)((b * NCH + n) * NH + h) * (HD * HD) + 4 * de4;
            const v2u kvv = *(const GAS v2u*)(KVT + o);
            v2u pw; pw.x = pk2(s0, s1); pw.y = pk2(s2, s3);
            *(GAS v2u*)(prevT + o) = pw;
            s0 = cd * s0 + bflo(kvv.x); s1 = cd * s1 + bfhi(kvv.x); s2 = cd * s2 + bflo(kvv.y); s3 = cd * s3 + bfhi(kvv.y);
        }
    }
}
__device__ __forceinline__ void p4_retout_phase(Frame& F) {
    const bf16* qb = (const bf16*)(F.ws + WS_QB); const bf16* gbuf = (const bf16*)(F.ws + WS_GB); const bf16* prevT = (const bf16*)(F.ws + WS_PREVT);
    const bf16* kb = (const bf16*)(F.ws + WS_KB); const bf16* vb = (const bf16*)(F.ws + WS_VB);
    bf16* mixb = (bf16*)(F.ws + WS_MIXB);
    LAS unsigned char* Kimg = F.lds; LAS unsigned char* Vimg = F.lds + 32768; LAS unsigned char* Simg = F.lds + 65536;
    const int lane = F.lane, w = F.wave, g = lane >> 4, fr = lane & 15, tid = F.tid;
    LAS unsigned char* Pimg = F.lds + 98304 + 4096 * w;
    v4u rk[4], rv[4], rp[4];
    int u = blockIdx.x;
    if (u < NB * NCH * NH) { const int h = u & 3, n = (u >> 2) & 31, b = u >> 7; const size_t row0 = (size_t)b * SEQ + (size_t)n * CH;
        tile_load(rk, kb + row0 * RW + h * HD, RW, tid); tile_load(rv, vb + row0 * RW + h * HD, RW, tid); tile_load(rp, prevT + (size_t)u * (HD * HD), HD, tid); }
    for (; u < NB * NCH * NH; u += F.G) {
        const int h = u & 3, n = (u >> 2) & 31, b = u >> 7; const size_t row0 = (size_t)b * SEQ + (size_t)n * CH;
        const float lg2 = lg2_gamma(h);
        tile_write<false>(rk, Kimg, tid, 0.f); tile_write<false>(rv, Vimg, tid, 0.f); tile_write<false>(rp, Simg, tid, 0.f);
        const int i0 = 16 * w;
        bf16x8 qf[4];
#pragma unroll
        for (int s = 0; s < 4; ++s) qf[s] = *(const GAS bf16x8*)(qb + (row0 + i0 + fr) * RW + h * HD + 32 * s + 8 * g);
        __syncthreads();
        { const int u2 = u + F.G; if (u2 < NB * NCH * NH) { const int h2 = u2 & 3, n2 = (u2 >> 2) & 31, b2 = u2 >> 7; const size_t r2 = (size_t)b2 * SEQ + (size_t)n2 * CH;
            tile_load(rk, kb + r2 * RW + h2 * HD, RW, tid); tile_load(rv, vb + r2 * RW + h2 * HD, RW, tid); tile_load(rp, prevT + (size_t)u2 * (HD * HD), HD, tid); } }
        const int njt = (w | 1) + 1;
        for (int jt = 0; jt < njt; ++jt) {
            f32x4 acc = (f32x4){0.f, 0.f, 0.f, 0.f};
#pragma unroll
            for (int s = 0; s < 4; ++s) acc = __builtin_amdgcn_mfma_f32_16x16x32_bf16(row_frag(Kimg, lane, jt, s), qf[s], acc, 0, 0, 0);
            const int i = i0 + fr, jb = 16 * jt + 4 * g;
            float pv[4];
#pragma unroll
            for (int r = 0; r < 4; ++r) { const int j = jb + r; const float v = acc[r] * exp2f((float)(i - j) * lg2); pv[r] = (i >= j) ? v : 0.f; }
            v2u w2; w2.x = pk2(pv[0], pv[1]); w2.y = pk2(pv[2], pv[3]);
            *(LAS v2u*)(Pimg + offb(fr, 2 * jt + (g >> 1)) + 8 * (g & 1)) = w2;
        }
        LDS_WAIT();
        float qd[4];
#pragma unroll
        for (int r = 0; r < 4; ++r) qd[r] = exp2f((float)(i0 + 4 * g + r + 1) * lg2);
        const int ksmax = w >> 1;
        f32x4 o[8];
#pragma unroll
        for (int et = 0; et < 8; ++et) {
            f32x4 acc = (f32x4){0.f, 0.f, 0.f, 0.f};
#pragma unroll
            for (int s = 0; s < 4; ++s) acc = __builtin_amdgcn_mfma_f32_16x16x32_bf16(qf[s], row_frag(Simg, lane, et, s), acc, 0, 0, 0);
#pragma unroll
            for (int r = 0; r < 4; ++r) acc[r] *= qd[r];
            for (int ks = 0; ks <= ksmax; ++ks) acc = __builtin_amdgcn_mfma_f32_16x16x32_bf16(row_frag(Pimg, lane, 0, ks), tr_frag(Vimg, lane, et, ks), acc, 0, 0, 0);
            o[et] = acc;
        }
        float mu[4], rstd[4];
#pragma unroll
        for (int r = 0; r < 4; ++r) { float sm = 0.f;
#pragma unroll
            for (int et = 0; et < 8; ++et) sm += o[et][r];
            sm += __shfl_xor(sm, 1); sm += __shfl_xor(sm, 2); sm += __shfl_xor(sm, 4); sm += __shfl_xor(sm, 8);
            mu[r] = sm * (1.0f / HD); float q2 = 0.f;
#pragma unroll
            for (int et = 0; et < 8; ++et) { const float d = o[et][r] - mu[r]; q2 += d * d; }
            q2 += __shfl_xor(q2, 1); q2 += __shfl_xor(q2, 2); q2 += __shfl_xor(q2, 4); q2 += __shfl_xor(q2, 8);
            rstd[r] = 1.0f / sqrtf(q2 * (1.0f / HD) + EPS); }
        LDS_WAIT();
        LAS bf16* stg = (LAS bf16*)Pimg;
#pragma unroll
        for (int et = 0; et < 8; ++et) { const float gw = F.gn_w[h * HD + 16 * et + fr];
#pragma unroll
            for (int r = 0; r < 4; ++r) stg[(4 * g + r) * HD + 16 * et + fr] = (bf16)f2bf((o[et][r] - mu[r]) * rstd[r] * gw); }
        LDS_WAIT();
#pragma unroll
        for (int k = 0; k < 4; ++k) {
            const int id = lane + 64 * k, row = id >> 4, ch = id & 15;
            const v4u yv = *(const LAS v4u*)(Pimg + row * 256 + ch * 16);
            const size_t grow = row0 + i0 + row;
            const v4u gv = *(const GAS v4u*)(gbuf + grow * RW + h * HD + 8 * ch);
            v4u ov;
            ov.x = pk2(silu_f(bflo(gv.x)) * bflo(yv.x), silu_f(bfhi(gv.x)) * bfhi(yv.x)); ov.y = pk2(silu_f(bflo(gv.y)) * bflo(yv.y), silu_f(bfhi(gv.y)) * bfhi(yv.y));
            ov.z = pk2(silu_f(bflo(gv.z)) * bflo(yv.z), silu_f(bfhi(gv.z)) * bfhi(yv.z)); ov.w = pk2(silu_f(bflo(gv.w)) * bflo(yv.w), silu_f(bfhi(gv.w)) * bfhi(yv.w));
            *(GAS v4u*)(mixb + grow * D + h * HD + 8 * ch) = ov;
        }
        __syncthreads();
    }
    const bf16* gbb = (const bf16*)(F.ws + WS_GBB); const bf16* cub = (const bf16*)(F.ws + WS_CUB);
    for (int id = blockIdx.x * 512 + F.tid; id < M * 64; id += F.G * 512) {
        const int row = id >> 6, ch = id & 63, t = row & (SEQ - 1);
        const v4u c2 = *(const GAS v4u*)(cub + (size_t)row * CW + 8 * ch);
        v4u c1 = (v4u){0u, 0u, 0u, 0u}, c0 = c1;
        if (t >= 1) c1 = *(const GAS v4u*)(cub + (size_t)(row - 1) * CW + 8 * ch);
        if (t >= 2) c0 = *(const GAS v4u*)(cub + (size_t)(row - 2) * CW + 8 * ch);
        const v4u gv = *(const GAS v4u*)(gbb + (size_t)row * CW + 8 * ch);
        float wk[3][8];
#pragma unroll
        for (int k = 0; k < 3; ++k) { const f32x4 a = *(const GAS f32x4*)(F.conv_w + k * CW + 8 * ch), bq = *(const GAS f32x4*)(F.conv_w + k * CW + 8 * ch + 4);
            wk[k][0] = a.x; wk[k][1] = a.y; wk[k][2] = a.z; wk[k][3] = a.w; wk[k][4] = bq.x; wk[k][5] = bq.y; wk[k][6] = bq.z; wk[k][7] = bq.w; }
        const unsigned c0a[4] = {c0.x, c0.y, c0.z, c0.w}, c1a[4] = {c1.x, c1.y, c1.z, c1.w}, c2a[4] = {c2.x, c2.y, c2.z, c2.w}, ga[4] = {gv.x, gv.y, gv.z, gv.w};
        unsigned oa[4];
#pragma unroll
        for (int x = 0; x < 4; ++x) {
            const float lo = bflo(ga[x]) * (wk[0][2 * x] * bflo(c0a[x]) + wk[1][2 * x] * bflo(c1a[x]) + wk[2][2 * x] * bflo(c2a[x]));
            const float hi = bfhi(ga[x]) * (wk[0][2 * x + 1] * bfhi(c0a[x]) + wk[1][2 * x + 1] * bfhi(c1a[x]) + wk[2][2 * x + 1] * bfhi(c2a[x]));
            oa[x] = pk2(lo, hi); }
        *(GAS v4u*)(mixb + (size_t)row * D + RW + 8 * ch) = (v4u){oa[0], oa[1], oa[2], oa[3]};
    }
}

struct OutProjSched {
    int c, G; const void* Wb0; const void* Wb1; unsigned Wbytes;
    __device__ __forceinline__ bool next(int i, pg8::Unit& u) const {
        constexpr int nN = D / 256, nwg = (M / 256) * nN;
        const int L = i * G + c; if (L >= nwg) return false;
        const int wgid = (L % 8) * (nwg / 8) + L / 8;
        const int nig = 8 * nN, gid = wgid / nig, fm = gid * 8;
        u.pm = fm + ((wgid % nig) % 8); u.pn = (wgid % nig) / 8; u.arow0 = u.pm * 256; u.e = 0; u.rb = 0; u.nvalid = 256;
        u.B = (unsigned)u.pn * (256u * D * 2u); u.B1 = u.B; return true;
    }
    __device__ __forceinline__ int arow(const pg8::Unit&, int) const { return 0; }
};
struct EpiOutProj {
    static constexpr bool PERM = true;
    const float* x; const float* nw2; bf16* xn2; float* ssq;
    __device__ __forceinline__ void operator()(const f32x4 (&acc)[2][2][4][2], const pg8::Unit& u, int wr, int wc, int fr, int fq) const {
        const int row0 = u.pm * 256 + wr * 64 + fr, col0 = u.pn * 256 + wc * 32 + 8 * fq;
        f32x4 nwv[2][2];
#pragma unroll
        for (int bj = 0; bj < 2; ++bj) { nwv[bj][0] = *(const f32x4*)(nw2 + col0 + bj * 128); nwv[bj][1] = *(const f32x4*)(nw2 + col0 + bj * 128 + 4); }
#pragma unroll
        for (int ai = 0; ai < 2; ++ai)
#pragma unroll
            for (int m = 0; m < 4; ++m) { const size_t r = (size_t)(row0 + ai * 128 + m * 16); float ss = 0.f;
#pragma unroll
                for (int bj = 0; bj < 2; ++bj) { const size_t o = r * D + col0 + bj * 128;
                    const f32x4 v0 = acc[ai][bj][m][0] + *(const f32x4*)(x + o), v1 = acc[ai][bj][m][1] + *(const f32x4*)(x + o + 4);
                    ss += (v0[0] * v0[0] + v0[1] * v0[1]) + (v0[2] * v0[2] + v0[3] * v0[3]) + (v1[0] * v1[0] + v1[1] * v1[1]) + (v1[2] * v1[2] + v1[3] * v1[3]);
                    const f32x4 s0 = v0 * nwv[bj][0], s1 = v1 * nwv[bj][1];
                    v4u w; w.x = cvt_pk_bf16(s0[0], s0[1]); w.y = cvt_pk_bf16(s0[2], s0[3]); w.z = cvt_pk_bf16(s1[0], s1[1]); w.w = cvt_pk_bf16(s1[2], s1[3]);
                    *(v4u*)(xn2 + o) = w; }
                ss += __shfl_xor(ss, 16); ss += __shfl_xor(ss, 32);
                if (fq == 0) atomicAdd(ssq + r, ss); }
    }
};

__device__ __forceinline__ void p6_router_phase(Frame& F) {
    const bf16* xn2 = (const bf16*)(F.ws + WS_XN); const bf16* WrT = (const bf16*)(F.ws + WS_WRT);
    int* cnt = (int*)(F.ws + WS_CTL) + CW_CNT; int* tokl = (int*)(F.ws + WS_TOKL); float* rsl = (float*)(F.ws + WS_RSL); float* gatel = (float*)(F.ws + WS_GATEL);
    const float* ssq = (const float*)(F.ws + WS_SSQ);
    const int lane = F.lane, w = F.wave, g = lane >> 4, fr = lane & 15;
    constexpr int LS = 84;
    LAS float* slab = (LAS float*)F.lds + (w & 3) * (64 * LS);
    if (w == 0) { ((LAS int*)(F.lds + 4 * 64 * LS * 4))[lane] = 0; LDS_WAIT(); }
    for (int cb = (int)blockIdx.x; cb < M / 64; cb += F.G) {
        f32x4 acc[4][5];
#pragma unroll
        for (int rb = 0; rb < 4; ++rb)
#pragma unroll
            for (int t = 0; t < 5; ++t) acc[rb][t] = (f32x4){0.f, 0.f, 0.f, 0.f};
        const bf16* arow = xn2 + (size_t)(64 * cb + fr) * D + 128 * w + 8 * g;
        const bf16* brow = WrT + (size_t)fr * D + 128 * w + 8 * g;
#pragma unroll
        for (int s4 = 0; s4 < 4; ++s4) {
            bf16x8 bfr[5];
#pragma unroll
            for (int t = 0; t < 5; ++t) bfr[t] = *(const GAS bf16x8*)(brow + (size_t)(16 * t) * D + 32 * s4);
#pragma unroll
            for (int rb = 0; rb < 4; ++rb) { const bf16x8 a = *(const GAS bf16x8*)(arow + (size_t)(16 * rb) * D + 32 * s4);
#pragma unroll
                for (int t = 0; t < 5; ++t) acc[rb][t] = __builtin_amdgcn_mfma_f32_16x16x32_bf16(a, bfr[t], acc[rb][t], 0, 0, 0); }
        }
        if (w < 4) {
#pragma unroll
            for (int rb = 0; rb < 4; ++rb)
#pragma unroll
                for (int t = 0; t < 5; ++t)
#pragma unroll
                    for (int r = 0; r < 4; ++r) slab[(16 * rb + 4 * g + r) * LS + 16 * t + fr] = acc[rb][t][r];
        }
        __syncthreads();
        if (w >= 4) {
#pragma unroll
            for (int rb = 0; rb < 4; ++rb)
#pragma unroll
                for (int t = 0; t < 5; ++t)
#pragma unroll
                    for (int r = 0; r < 4; ++r) { LAS float* p = slab + (16 * rb + 4 * g + r) * LS + 16 * t + fr; *p = *p + acc[rb][t][r]; }
        }
        __syncthreads();
        if (w == 0) {
            const int tok = 64 * cb + lane;
            const LAS float* L0 = (const LAS float*)F.lds + lane * LS;
            const float rs = 1.0f / sqrtf(ssq[tok] * (1.0f / D) + EPS);
            float gl[8];
#pragma unroll
            for (int n = 0; n < 8; ++n) gl[n] = (((L0[n] + L0[64 * LS + n]) + L0[2 * 64 * LS + n]) + L0[3 * 64 * LS + n]) * rs + F.rg_b[n];
            int gs = 0; float gm = gl[0];
#pragma unroll
            for (int n = 1; n < 8; ++n) if (gl[n] > gm) { gm = gl[n]; gs = n; }
            float den = 0.f;
#pragma unroll
            for (int n = 0; n < 8; ++n) den += __expf(gl[n] - gm);
            const float pg = 1.0f / den;
            float el[8];
#pragma unroll
            for (int e = 0; e < 8; ++e) { const int n = 8 + gs * 8 + e; el[e] = (((L0[n] + L0[64 * LS + n]) + L0[2 * 64 * LS + n]) + L0[3 * 64 * LS + n]) * rs + F.re_b[gs * EPG + e]; }
            int i1 = 0; float m1 = el[0];
#pragma unroll
            for (int e = 1; e < 8; ++e) if (el[e] > m1) { m1 = el[e]; i1 = e; }
            int i2 = 0; float m2 = -3.0e38f;
#pragma unroll
            for (int e = 0; e < 8; ++e) if (e != i1 && el[e] > m2) { m2 = el[e]; i2 = e; }
            const float rr = __expf(m2 - m1); const float w1 = 1.0f / (1.0f + rr), w2 = rr / (1.0f + rr);
            const int e1 = gs * EPG + i1, e2 = gs * EPG + i2;
            LAS int* hist = (LAS int*)(F.lds + 4 * 64 * LS * 4);
            const int l1 = __hip_atomic_fetch_add(hist + e1, 1, __ATOMIC_RELAXED, __HIP_MEMORY_SCOPE_WORKGROUP), l2 = __hip_atomic_fetch_add(hist + e2, 1, __ATOMIC_RELAXED, __HIP_MEMORY_SCOPE_WORKGROUP);
            LDS_WAIT(); asm volatile("" ::: "memory");
            { const int c = hist[lane]; int base = 0; if (c > 0) base = atomicAdd(cnt + lane * CNT_STRIDE, c); hist[64 + lane] = base; hist[lane] = 0; }
            LDS_WAIT(); asm volatile("" ::: "memory");
            const int r1 = hist[64 + e1] + l1, r2 = hist[64 + e2] + l2;
            tokl[e1 * M + r1] = tok * 2;     rsl[e1 * M + r1] = rs; gatel[e1 * M + r1] = pg * w1;
            tokl[e2 * M + r2] = tok * 2 + 1; rsl[e2 * M + r2] = rs; gatel[e2 * M + r2] = pg * w2;
        }
        __syncthreads();
    }
}

__device__ __forceinline__ const char* uniform_ptr(const char* p) {
    const unsigned long long v = (unsigned long long)p;
    const unsigned lo = __builtin_amdgcn_readfirstlane((unsigned)v), hi = __builtin_amdgcn_readfirstlane((unsigned)(v >> 32));
    return (const char*)(((unsigned long long)hi << 32) | lo);
}
struct MoeSched {
    int half;
    int wave; int c, G; int total, limit; const LAS int* tab;
    const void* Wb0; const void* Wb1; unsigned Wbytes; unsigned off1; unsigned estride; int colstep; int ldwb; const int* tokl;
    __device__ __forceinline__ void init(const int* cnt, int lane, LAS int* table) {
        const int my_cnt = __hip_atomic_load(cnt + lane * CNT_STRIDE, __ATOMIC_RELAXED, __HIP_MEMORY_SCOPE_AGENT), my_nb = (my_cnt + 255) >> 8;
        int v = my_nb;
#pragma unroll
        for (int o = 1; o < 64; o <<= 1) { const int t = __shfl_up(v, o); if (lane >= o) v += t; }
        table[lane] = 4 * (v - my_nb); table[64 + lane] = my_nb; table[128 + lane] = my_cnt; total = 4 * __builtin_amdgcn_readlane(v, 63); limit = (total / G) * G; tab = table;
    }
    __device__ __forceinline__ bool next(int i, pg8::Unit& u) const {
        const int j = i * G + c; int L, hf = 0;
        if (half) { if (j >= 2 * (total - limit)) return false; L = limit + (j >> 1); hf = j & 1; } else { if (j >= limit) return false; L = j; }
        int wgid = L; { const int q = total / 8, r = total % 8, xcd = wgid % 8, off = wgid / 8; wgid = (xcd < r ? xcd * (q + 1) : r * (q + 1) + (xcd - r) * q) + off; }
        const int ln = (int)__builtin_amdgcn_mbcnt_hi(~0u, __builtin_amdgcn_mbcnt_lo(~0u, 0u));
        const int my_b4 = tab[ln], my_nb = tab[64 + ln];
        const bool hit = (wgid >= my_b4) && (wgid < my_b4 + 4 * my_nb);
        const unsigned long long mk = __ballot(hit);
        const int e = __builtin_amdgcn_readfirstlane((int)__builtin_ctzll(mk));
        const int b4 = __builtin_amdgcn_readfirstlane(tab[e]), nb = __builtin_amdgcn_readfirstlane(tab[64 + e]), ce = __builtin_amdgcn_readfirstlane(tab[128 + e]);
        const int within = wgid - b4; u.pn = __builtin_amdgcn_readfirstlane(within / nb); const int blk = within - u.pn * nb;
        const int rows = half ? 128 : 256;
        u.e = e; u.rb = (blk << 8) + 128 * hf; u.pm = (b4 >> 2) + blk; u.arow0 = (u.pm << 8) + 128 * hf;
        int nv = ce - u.rb; nv = nv < 0 ? 0 : nv; u.nvalid = nv < rows ? nv : rows;
        u.B = (unsigned)e * estride + (unsigned)u.pn * (unsigned)colstep; u.B1 = u.B + off1; return true;
    }
    __device__ __forceinline__ int arow(const pg8::Unit& u, int rl) const { return rl < u.nvalid ? (tokl[u.e * M + u.rb + rl] >> 1) : 0; }
};
struct EpiMoe1 {
    bf16* hb; const float* rsl;
    __device__ __forceinline__ void operator()(const f32x4 (&acc)[2][4][2], const pg8::Unit& u, int wr, int wc, int fr, int fq) const {
#pragma unroll
        for (int m = 0; m < 4; ++m) { const int rl = wr * 64 + m * 16 + fr;
            const float rs = rsl[u.e * M + u.rb + rl];
            f32x4 v0, v1;
#pragma unroll
            for (int j = 0; j < 4; ++j) { v0[j] = silu_f(acc[0][m][0][j] * rs) * (acc[1][m][0][j] * rs); v1[j] = silu_f(acc[0][m][1][j] * rs) * (acc[1][m][1][j] * rs); }
            v4u w; w.x = cvt_pk_bf16(v0[0], v0[1]); w.y = cvt_pk_bf16(v0[2], v0[3]); w.z = cvt_pk_bf16(v1[0], v1[1]); w.w = cvt_pk_bf16(v1[2], v1[3]);
            *(v4u*)(hb + (size_t)(u.arow0 + rl) * FF + u.pn * 128 + wc * 32 + 8 * fq) = w; }
    }
};
struct EpiMoe2 {
    bf16* yb; const int* tokl; const float* gatel;
    __device__ __forceinline__ void operator()(const f32x4 (&acc)[2][4][2], const pg8::Unit& u, int wr, int wc, int fr, int fq) const {
#pragma unroll
        for (int m = 0; m < 4; ++m) { const int rl = wr * 64 + m * 16 + fr;
            if (rl < u.nvalid) {
                const int dst = tokl[u.e * M + u.rb + rl]; const float gt = gatel[u.e * M + u.rb + rl];
#pragma unroll
                for (int bj = 0; bj < 2; ++bj) { const f32x4 v0 = acc[bj][m][0] * gt, v1 = acc[bj][m][1] * gt;
                    v4u w; w.x = cvt_pk_bf16(v0[0], v0[1]); w.y = cvt_pk_bf16(v0[2], v0[3]); w.z = cvt_pk_bf16(v1[0], v1[1]); w.w = cvt_pk_bf16(v1[2], v1[3]);
                    *(v4u*)(yb + (size_t)dst * D + u.pn * 256 + bj * 128 + wc * 32 + 8 * fq) = w; } } }
    }
};

struct EpiMoe1W {
    bf16* hb; const float* rsl;
    __device__ __forceinline__ void operator()(const f32x4 (&acc)[2][2][4][2], const pg8::Unit& u, int wr, int wc, int fr, int fq) const {
#pragma unroll
        for (int ai = 0; ai < 2; ++ai)
#pragma unroll
            for (int m = 0; m < 4; ++m) { const int rl = ai * 128 + wr * 64 + m * 16 + fr;
                const float rs = rsl[u.e * M + u.rb + rl];
                f32x4 v0, v1;
#pragma unroll
                for (int j = 0; j < 4; ++j) { v0[j] = silu_f(acc[ai][0][m][0][j] * rs) * (acc[ai][1][m][0][j] * rs); v1[j] = silu_f(acc[ai][0][m][1][j] * rs) * (acc[ai][1][m][1][j] * rs); }
                v4u w; w.x = cvt_pk_bf16(v0[0], v0[1]); w.y = cvt_pk_bf16(v0[2], v0[3]); w.z = cvt_pk_bf16(v1[0], v1[1]); w.w = cvt_pk_bf16(v1[2], v1[3]);
                *(v4u*)(hb + (size_t)(u.arow0 + rl) * FF + u.pn * 128 + wc * 32 + 8 * fq) = w; }
    }
};
struct EpiMoe2W {
    bf16* yb; const int* tokl; const float* gatel;
    __device__ __forceinline__ void operator()(const f32x4 (&acc)[2][2][4][2], const pg8::Unit& u, int wr, int wc, int fr, int fq) const {
#pragma unroll
        for (int ai = 0; ai < 2; ++ai)
#pragma unroll
            for (int m = 0; m < 4; ++m) { const int rl = ai * 128 + wr * 64 + m * 16 + fr;
                if (rl < u.nvalid) {
                    const int dst = tokl[u.e * M + u.rb + rl]; const float gt = gatel[u.e * M + u.rb + rl];
#pragma unroll
                    for (int bj = 0; bj < 2; ++bj) { const f32x4 v0 = acc[ai][bj][m][0] * gt, v1 = acc[ai][bj][m][1] * gt;
                        v4u w; w.x = cvt_pk_bf16(v0[0], v0[1]); w.y = cvt_pk_bf16(v0[2], v0[3]); w.z = cvt_pk_bf16(v1[0], v1[1]); w.w = cvt_pk_bf16(v1[2], v1[3]);
                        *(v4u*)(yb + (size_t)dst * D + u.pn * 256 + bj * 128 + wc * 32 + 8 * fq) = w; } } }
    }
};

__device__ __forceinline__ void p9_final_phase(Frame& F) {
    const bf16* xb2 = (const bf16*)(F.ws + WS_XN); const bf16* yb = (const bf16*)(F.ws + WS_YB);
    const int gw = F.vcu * NWAVES + F.wave, NGW = F.G * NWAVES, lane = lane_now();
    for (int row = gw; row < M; row += NGW) {
        float v[16]; float ss = 0.f;
#pragma unroll
        for (int c = 0; c < 2; ++c) {
            const int ch = lane + 64 * c;
            const v4u a = *(const GAS v4u*)(xb2 + (size_t)row * D + 8 * ch), b1 = *(const GAS v4u*)(yb + (size_t)(2 * row) * D + 8 * ch), b2 = *(const GAS v4u*)(yb + (size_t)(2 * row + 1) * D + 8 * ch);
            const unsigned aa[4] = {a.x, a.y, a.z, a.w}, bb[4] = {b1.x, b1.y, b1.z, b1.w}, cc[4] = {b2.x, b2.y, b2.z, b2.w};
            const f32x4 n0 = *(const GAS f32x4*)(F.norm2_w + 8 * ch), n1 = *(const GAS f32x4*)(F.norm2_w + 8 * ch + 4);
            const float inw[8] = {1.0f / n0[0], 1.0f / n0[1], 1.0f / n0[2], 1.0f / n0[3], 1.0f / n1[0], 1.0f / n1[1], 1.0f / n1[2], 1.0f / n1[3]};
#pragma unroll
            for (int x = 0; x < 4; ++x) { const float lo = bflo(aa[x]) * inw[2 * x] + (bflo(bb[x]) + bflo(cc[x])), hi = bfhi(aa[x]) * inw[2 * x + 1] + (bfhi(bb[x]) + bfhi(cc[x])); v[8 * c + 2 * x] = lo; v[8 * c + 2 * x + 1] = hi; ss += lo * lo + hi * hi; }
        }
        const float rs = 1.0f / sqrtf(wave_sum(ss) * (1.0f / D) + EPS);
#pragma unroll
        for (int c = 0; c < 2; ++c) {
            const int ch = lane + 64 * c;
            const f32x4 w0 = *(const GAS f32x4*)(F.fin_w + 8 * ch), w1 = *(const GAS f32x4*)(F.fin_w + 8 * ch + 4);
            f32x4 o0, o1;
#pragma unroll
            for (int x = 0; x < 4; ++x) { o0[x] = v[8 * c + x] * rs * w0[x]; o1[x] = v[8 * c + 4 + x] * rs * w1[x]; }
            *(GAS f32x4*)(F.out + (size_t)row * D + 8 * ch) = o0; *(GAS f32x4*)(F.out + (size_t)row * D + 8 * ch + 4) = o1;
        }
    }
}

struct Args { const float* in[15]; float* out; unsigned char* ws; int ph_lo, ph_hi, li, pad; };
__global__ void __launch_bounds__(NWAVES * 64, 2) mega_fwd(Args args) {
    extern __shared__ __attribute__((aligned(16))) unsigned char lds[];
    Frame F;
    F.lds = (LAS unsigned char*)lds; F.MISC = (volatile LAS unsigned*)(F.lds + MISC_OFF);
    F.tid = threadIdx.x; F.lane = F.tid & 63; F.wave = __builtin_amdgcn_readfirstlane(F.tid >> 6);
    F.G = gridDim.x; { const int bx = blockIdx.x; F.vcu = (F.G % 8 == 0) ? (bx % 8) * (F.G / 8) + bx / 8 : bx; }
    F.ws = args.ws; F.ctl = (gu32*)(args.ws + WS_CTL); F.out = args.out;
    F.x = args.in[0]; F.norm1_w = args.in[1]; F.w_in = args.in[2]; F.gn_w = args.in[3]; F.conv_w = args.in[4]; F.w_o = args.in[5]; F.norm2_w = args.in[6];
    F.rg_w = args.in[7]; F.rg_b = args.in[8]; F.re_w = args.in[9]; F.re_b = args.in[10]; F.w_gate = args.in[11]; F.w_up = args.in[12]; F.w_down = args.in[13]; F.fin_w = args.in[14];
    for (int u = F.tid; u < (LDS_BYTES - LDSCTL_OFF) / 4; u += NWAVES * 64) ((LAS unsigned*)(F.lds + LDSCTL_OFF))[u] = 0u;
    __syncthreads();
    XcdBarrier bar = xcd_barrier_post((unsigned*)(F.ctl + CW_BAR) + args.li * XCD_BAR_WORDS, F.MISC + 8);
    const int lo = args.ph_lo, hi = args.ph_hi;
    const bool early = (F.G == 256);
    if (early && blockIdx.x >= 128 && threadIdx.x == 0) (void)xb_add((unsigned*)(F.ctl + CW_ECNT) + 64 * bar.x, 1u);
#define IN(k) (lo <= (k) && (k) < hi)
#define BOTH(k) (IN(k) && IN((k) + 1))
    if (IN(0)) { p0_prologue(F); if (BOTH(0)) xcd_barrier(bar); }
    if (IN(1)) {
        InProjSched S{(int)blockIdx.x, F.G, (const void*)(F.ws + WS_WINT), (const void*)(F.ws + WS_WINT), (unsigned)(INC * D * 2)};
        static_assert(WS_KB - WS_QB == 16 * MiB && WS_VB - WS_KB == 16 * MiB && WS_GB - WS_VB == 16 * MiB && WS_GBB - WS_GB == 16 * MiB && WS_CUB - WS_GBB == 16 * MiB, "EpiInProj strides");
        EpiInProj E{(bf16*)(F.ws + WS_QB), (const float*)(F.ws + WS_ROPE), (const float*)(F.ws + WS_ROPE) + SEQ * 64, (unsigned*)(F.ctl + CW_X1) + 64 * bar.x, (unsigned*)(F.ctl + CW_E1), F.MISC};
        pg8::gemm_phase<EpiInProj, InProjSched, false, true>(F.lds + RING_OFF, (const void*)(F.ws + WS_XN), (unsigned)(M * D * 2), D, S, E);
        if (BOTH(1) && !early) xcd_barrier(bar);
    }
    {
        const int bx = (int)blockIdx.x; const bool mine = !early || bx >= 128; const int pi = early ? bx - 128 : bx, pstr = early ? 128 : F.G;
        if (IN(2)) {
            if (mine) {
                if (early) wg_wait_count((unsigned*)(F.ctl + CW_E1), 256u, bar.bar);
                p2_kv_phase(F, pi, pstr);
                if (early) { wave_arrive(F.MISC + 12, (unsigned*)(F.ctl + CW_X2) + 64 * bar.x, xb_ld((unsigned*)(F.ctl + CW_ECNT) + 64 * bar.x), (unsigned*)(F.ctl + CW_E2)); wg_wait_count((unsigned*)(F.ctl + CW_E2), 128u, bar.bar); }
            }
            if (BOTH(2) && !early) xcd_barrier(bar);
        }
        if (IN(3)) { if (mine) p3_scan_phase(F, pi, pstr); if (BOTH(3)) xcd_barrier(bar); }
    }
    if (IN(4)) { p4_retout_phase(F); if (BOTH(4)) xcd_barrier(bar); }
    if (IN(5)) {
        OutProjSched S{(int)blockIdx.x, F.G, (const void*)(F.ws + WS_WOT), (const void*)(F.ws + WS_WOT), (unsigned)(D * D * 2)};
        EpiOutProj E{F.x, F.norm2_w, (bf16*)(F.ws + WS_XN), (float*)(F.ws + WS_SSQ)};
        pg8::gemm_phase<EpiOutProj, OutProjSched, false, false>(F.lds + RING_OFF, (const void*)(F.ws + WS_MIXB), (unsigned)(M * D * 2), D, S, E);
        if (BOTH(5)) xcd_barrier(bar);
    }
    if (IN(6)) { p6_router_phase(F); if (BOTH(6)) xcd_barrier(bar); }
    if (IN(7)) {
        MoeSched S; S.half = 0; S.wave = F.wave; S.c = (int)blockIdx.x; S.G = F.G; S.Wb0 = (const void*)F.w_gate; S.Wb1 = (const void*)F.w_up; S.Wbytes = (unsigned)(NE * D * FF * 4); S.off1 = 0; S.estride = (unsigned)(D * FF * 4); S.colstep = 128 * 4; S.ldwb = FF * 4; S.tokl = (const int*)(F.ws + WS_TOKL);
        S.init((const int*)(F.ws + WS_CTL) + CW_CNT, lane_now(), (LAS int*)(F.lds + LDSCTL_OFF + 1024)); __syncthreads();
        { EpiMoe1W E{(bf16*)(F.ws + WS_HB), (const float*)(F.ws + WS_RSL)};
          mw::gemm_w<EpiMoe1W, MoeSched, true>(F.lds + RING_OFF, (const void*)(F.ws + WS_XN), (unsigned)(M * D * 2), D, S, E); }
        S.half = 1;
        { EpiMoe1 E{(bf16*)(F.ws + WS_HB), (const float*)(F.ws + WS_RSL)};
          mz::gemm_z<EpiMoe1, MoeSched, true>(F.lds + RING_OFF, (const void*)(F.ws + WS_XN), (unsigned)(M * D * 2), D, S, E); }
        if (BOTH(7)) xcd_barrier(bar);
    }
    if (IN(8)) {
        MoeSched S; S.half = 0; S.wave = F.wave; S.c = (int)blockIdx.x; S.G = F.G; S.Wb0 = (const void*)F.w_down; S.Wb1 = (const void*)F.w_down; S.Wbytes = (unsigned)(NE * FF * D * 4); S.off1 = 128 * 4; S.estride = (unsigned)(FF * D * 4); S.colstep = 256 * 4; S.ldwb = D * 4; S.tokl = (const int*)(F.ws + WS_TOKL);
        S.init((const int*)(F.ws + WS_CTL) + CW_CNT, lane_now(), (LAS int*)(F.lds + LDSCTL_OFF + 1024)); __syncthreads();
        { EpiMoe2W E{(bf16*)(F.ws + WS_YB), (const int*)(F.ws + WS_TOKL), (const float*)(F.ws + WS_GATEL)};
          mw::gemm_w<EpiMoe2W, MoeSched, false>(F.lds + RING_OFF, (const void*)(F.ws + WS_HB), (unsigned)(49152u * FF * 2u), FF, S, E); }
        S.half = 1;
        { EpiMoe2 E{(bf16*)(F.ws + WS_YB), (const int*)(F.ws + WS_TOKL), (const float*)(F.ws + WS_GATEL)};
          mz::gemm_z<EpiMoe2, MoeSched, false>(F.lds + RING_OFF, (const void*)(F.ws + WS_HB), (unsigned)(49152u * FF * 2u), FF, S, E); }
        if (BOTH(8)) xcd_barrier(bar);
    }
    if (IN(9)) { p9_final_phase(F); }
#undef IN
#undef BOTH
}

extern "C" void kernel_launch(void* const* d_in, const int* in_sizes, int n_in, void* d_out, int out_size, void* d_ws, size_t ws_size, hipStream_t stream) {
    static int grid = 0;
    if (grid == 0) {
        int dev = 0, cus = 0, per_cu = 0;
        if (hipGetDevice(&dev) != hipSuccess || hipDeviceGetAttribute(&cus, hipDeviceAttributeMultiprocessorCount, dev) != hipSuccess) { fprintf(stderr, "kernel_launch: device query failed\n"); grid = -1; return; }
        if (hipFuncSetAttribute((const void*)mega_fwd, hipFuncAttributeMaxDynamicSharedMemorySize, LDS_BYTES) != hipSuccess) { fprintf(stderr, "kernel_launch: hipFuncSetAttribute failed\n"); grid = -1; return; }
        if (hipOccupancyMaxActiveBlocksPerMultiprocessor(&per_cu, (const void*)mega_fwd, NWAVES * 64, LDS_BYTES) != hipSuccess || per_cu < 1) fprintf(stderr, "kernel_launch: occupancy query reports %d blocks per CU\n", per_cu);
        (void)hipGetLastError();
        grid = cus;
    }
    if (grid < 0) return;
    char* ws = (char*)d_ws; float* out = (float*)d_out;
    (void)hipMemsetAsync(ws + WS_CTL, 0, CTL_ZERO_BYTES, stream);
    Args a{};
    for (int i = 0; i < 15; ++i) a.in[i] = (const float*)d_in[i];
    a.out = out; a.ws = (unsigned char*)d_ws;
    a.ph_lo = 0; a.ph_hi = 10; a.li = 0; hipLaunchKernelGGL(mega_fwd, dim3(grid), dim3(NWAVES * 64), LDS_BYTES, stream, a);
}
```

```cpp
#include <hip/hip_runtime.h>
#include <cstdio>
#include <cstdint>

constexpr int NB = 4, SEQ = 4096, D = 1024, M = NB * SEQ;
constexpr int RW = 512, NH = 4, HD = 128, CW = 512, INC = 3584, CH = 128, NCH = SEQ / CH;
constexpr int NG = 8, EPG = 8, NE = 64, FF = 512;
constexpr float EPS = 1e-6f;
constexpr int NWAVES = 8;

#define GAS __attribute__((address_space(1)))
#define LAS __attribute__((address_space(3)))
typedef unsigned short bf16;
typedef unsigned v4u __attribute__((ext_vector_type(4)));
typedef unsigned v2u __attribute__((ext_vector_type(2)));
typedef float f32x4 __attribute__((ext_vector_type(4)));
typedef short bf16x8 __attribute__((ext_vector_type(8)));
typedef GAS unsigned gu32;
#define RLX_AGENT __ATOMIC_RELAXED, __HIP_MEMORY_SCOPE_AGENT
#define LDS_WAIT() asm volatile("s_waitcnt lgkmcnt(0)" ::: "memory")
#define VM_WAIT() asm volatile("s_waitcnt vmcnt(0)" ::: "memory")

__device__ __forceinline__ unsigned f2bf(float f) { unsigned u = __builtin_bit_cast(unsigned, f); return (u + 0x7fffu + ((u >> 16) & 1u)) >> 16; }
__device__ __forceinline__ unsigned pk2(float lo, float hi) { return f2bf(lo) | (f2bf(hi) << 16); }
__device__ __forceinline__ float bf2f(unsigned short b) { return __builtin_bit_cast(float, (unsigned)b << 16); }
__device__ __forceinline__ float bflo(unsigned w) { return __builtin_bit_cast(float, w << 16); }
__device__ __forceinline__ float bfhi(unsigned w) { return __builtin_bit_cast(float, w & 0xffff0000u); }
__device__ __forceinline__ unsigned cvt_pk_bf16(float lo, float hi) { unsigned r; asm volatile("v_cvt_pk_bf16_f32 %0, %1, %2" : "=v"(r) : "v"(lo), "v"(hi)); return r; }

__device__ __forceinline__ int lane_now() { int l; asm volatile("v_mbcnt_lo_u32_b32 %0, -1, 0\n\tv_mbcnt_hi_u32_b32 %0, -1, %0" : "=v"(l)); return l; }
constexpr size_t MiB = 1u << 20;
constexpr size_t WS_CTL = 0, CTL_ZERO_BYTES = 512 * 1024;
constexpr size_t WS_WRT = 1 * MiB;
constexpr size_t WS_ROPE = 2 * MiB;
constexpr size_t WS_WOT = 4 * MiB;
constexpr size_t WS_WINT = 6 * MiB;
constexpr size_t WS_TOKL = 14 * MiB, WS_RSL = 18 * MiB, WS_GATEL = 22 * MiB;
constexpr size_t WS_SSQ = 13 * MiB;
constexpr size_t WS_QB = 224 * MiB, WS_KB = 240 * MiB, WS_VB = 256 * MiB, WS_GB = 272 * MiB, WS_GBB = 288 * MiB, WS_CUB = 304 * MiB, WS_PREVT = 320 * MiB;
constexpr size_t WS_YB = 224 * MiB;
constexpr size_t WS_HB = 288 * MiB;
constexpr size_t WS_XN = 336 * MiB;
constexpr size_t WS_KVT = 368 * MiB;
constexpr size_t WS_MIXB = 368 * MiB;
constexpr size_t WS_END = 400 * MiB;

constexpr int CW_TMO = 0, CW_CODE = 1;
constexpr int CW_E1 = 256, CW_E2 = 320, CW_ECNT = 1024, CW_X1 = 2048, CW_X2 = 3072;
constexpr int CW_BAR = 4096;
constexpr int CW_CNT = 49152, CNT_STRIDE = 1088;

constexpr int RING_OFF = 0, RING_BYTES = 131072;
constexpr int LDSCTL_OFF = RING_BYTES, MISC_OFF = LDSCTL_OFF + 320;
constexpr int LDS_BYTES = 147456;

namespace pg8 {
typedef short s16x4_t __attribute__((ext_vector_type(4)));
typedef short v4i16g_t __attribute__((ext_vector_type(4)));
constexpr int BM = 256, BK = 64, HALF = 128, HTB = HALF * BK * 2, STAGE_BYTES = 8 * HTB, NXCD = 8, WGM = 8;
__host__ __device__ __forceinline__ int lds_byte(int r, int c) { const int st = (r >> 4) * 2 + (c >> 5), rr = r & 15, cc = c & 31, ob = rr * 64 + cc * 2; return st * 1024 + (ob ^ (((ob >> 9) & 1) << 5)); }
__host__ __device__ __forceinline__ void stage_rc(int b, int& R, int& C) { const int st = b / 1024, sb = b % 1024, swz = sb ^ (((sb >> 9) & 1) << 5); R = (st >> 1) * 16 + swz / 64; C = (st & 1) * 32 + (swz % 64) / 2; }
__host__ __device__ __forceinline__ int perm32(int rho) { const int n = rho >> 4, i = rho & 15; return 8 * (i >> 2) + 4 * n + (i & 3); }

struct Unit { int arow0; int pm, pn; int e, rb, nvalid; unsigned B, B1; };

template <class Epi, class Sched, bool GATHER, bool ALIGN_EPI, bool BF32 = false>
__device__ __forceinline__ void gemm_phase(LAS unsigned char* lds, const void* Amat, const unsigned Abytes, const int K, const Sched& S, const Epi& E) {
    const __amdgpu_buffer_rsrc_t rA = __builtin_amdgcn_make_buffer_rsrc((void*)Amat, 0, Abytes, 0x00020000);
    const __amdgpu_buffer_rsrc_t rB0 = __builtin_amdgcn_make_buffer_rsrc((void*)S.Wb0, 0, S.Wbytes, 0x00020000), rB1 = __builtin_amdgcn_make_buffer_rsrc((void*)S.Wb1, 0, S.Wbytes, 0x00020000);
    const int tid = threadIdx.x, wid = __builtin_amdgcn_readfirstlane(tid >> 6), lane = tid & 63, wr = wid >> 2, wc = wid & 3, fr = lane & 15, fq = lane >> 4;
    const int nt = K / BK;
    int Rv[2], Cv[2]; unsigned voffB[2];
#pragma unroll
    for (int i = 0; i < 2; ++i) { stage_rc(tid * 16 + i * 8192, Rv[i], Cv[i]); const int Rb = Epi::PERM ? ((Rv[i] & ~31) + perm32(Rv[i] & 31)) : Rv[i]; voffB[i] = (unsigned)(Rb * K + Cv[i]) * 2u; }
    const unsigned kstep = (unsigned)(BK * 2);
    const unsigned hstepB = (unsigned)(HALF * K * 2);
    const unsigned ldsw = (unsigned)wid * 1024u;
    const int aoff = lds_byte(wr * 64 + fr, fq * 8), boff = lds_byte(wc * 32 + fr, fq * 8);
    size_t ldwb = 0; if constexpr (BF32) ldwb = (size_t)S.ldwb;
    const int bk0 = tid >> 5, bmm = tid & 31;
    const unsigned bwoff = (256u * bk0 + 16u * ((unsigned)(bmm >> 1) ^ ((((unsigned)bk0 & 3u) << 2) | (((unsigned)bk0 >> 2) & 3u)))) + 8u * (((unsigned)bmm & 1u) ^ (((unsigned)bk0 >> 3) & 1u));
    const unsigned bgoff = (unsigned)bk0 * (unsigned)ldwb + (unsigned)bmm * 16u;
    unsigned trb[2][2];
#pragma unroll
    for (int t = 0; t < 2; ++t)
#pragma unroll
        for (int nf = 0; nf < 2; ++nf) { const unsigned row = 8u * fq + 4u * t + ((unsigned)fr >> 2), ch = 4u * wc + ((unsigned)fr & 3u);
            trb[t][nf] = 256u * row + 16u * (ch ^ (((row & 3u) << 2) | ((row >> 2) & 3u))) + 8u * ((unsigned)nf ^ ((unsigned)fq & 1u)); }
    unsigned bgo[4];
#pragma unroll
    for (int i = 0; i < 4; ++i) bgo[i] = bgoff + (unsigned)(16 * i) * (unsigned)ldwb;
    f32x4 R[4];
#define PG8_SA(b, h) (((BF32 ? 4 : 0) + (b) * 2 + (h)) * HTB)
#define PG8_SB(b, h) (((BF32 ? 0 : 4) + (b) * 2 + (h)) * HTB)
#define PG8_STAGE_B(bufoff, so) do { _Pragma("unroll") for (int _i = 0; _i < 2; ++_i) \
        __builtin_amdgcn_raw_ptr_buffer_load_lds(rB0, (LAS void*)(lds + (bufoff) + ldsw + _i * 8192), 16, (int)voffB[_i], (int)(so), 0, 0); } while (0)
#define PG8_STAGE_A(bufoff, vo, kb) do { _Pragma("unroll") for (int _i = 0; _i < 2; ++_i) \
        __builtin_amdgcn_raw_ptr_buffer_load_lds(rA, (LAS void*)(lds + (bufoff) + ldsw + _i * 8192), 16, (int)(vo)[_i], (int)(kb), 0, 0); } while (0)
#define PG8_LDA(dst, b, h) do { _Pragma("unroll") for (int m = 0; m < 4; ++m) _Pragma("unroll") for (int k = 0; k < 2; ++k) dst[m][k] = *(const LAS bf16x8*)(lds + PG8_SA(b, h) + aoff + m * 2048 + k * 1024); } while (0)
#define PG8_LDB(dst, b, h) do { _Pragma("unroll") for (int n = 0; n < 2; ++n) _Pragma("unroll") for (int k = 0; k < 2; ++k) dst[n][k] = *(const LAS bf16x8*)(lds + PG8_SB(b, h) + boff + n * 2048 + k * 1024); } while (0)
#define PG8_BLOAD(h, so, kt) do { const int _so = (int)((so) + (unsigned)(kt) * 64u * (unsigned)ldwb); _Pragma("unroll") for (int _i = 0; _i < 4; ++_i) \
        R[_i] = __builtin_bit_cast(f32x4, __builtin_amdgcn_raw_buffer_load_b128((h) ? rB1 : rB0, (int)bgo[_i], _so, 0)); } while (0)
#define PG8_BWRITE(bufoff) do { _Pragma("unroll") for (int _i = 0; _i < 4; ++_i) { v2u _w; _w.x = cvt_pk_bf16(R[_i].x, R[_i].y); _w.y = cvt_pk_bf16(R[_i].z, R[_i].w); *(LAS v2u*)(lds + (bufoff) + bwoff + 4096 * _i) = _w; } } while (0)
#define PG8_TR(addr) __builtin_bit_cast(s16x4_t, __builtin_amdgcn_ds_read_tr16_b64_v4i16((LAS v4i16g_t*)(addr)))
#define PG8_LDBT(dst, b, h) do { _Pragma("unroll") for (int n = 0; n < 2; ++n) _Pragma("unroll") for (int k = 0; k < 2; ++k) { \
        const s16x4_t _lo = PG8_TR(lds + PG8_SB(b, h) + trb[0][n] + 8192 * k), _hi = PG8_TR(lds + PG8_SB(b, h) + trb[1][n] + 8192 * k); \
        dst[n][k] = (bf16x8){_lo[0], _lo[1], _lo[2], _lo[3], _hi[0], _hi[1], _hi[2], _hi[3]}; } } while (0)
#define PG8_LDBX(dst, b, h) do { if constexpr (BF32) { PG8_LDBT(dst, b, h); } else { PG8_LDB(dst, b, h); } } while (0)
#define PG8_MMA(ai, bj, At, Bt) do { __builtin_amdgcn_s_setprio(1); _Pragma("unroll") for (int m = 0; m < 4; ++m) _Pragma("unroll") for (int n = 0; n < 2; ++n) _Pragma("unroll") for (int k = 0; k < 2; ++k) \
        acc[ai][bj][m][n] = __builtin_amdgcn_mfma_f32_16x16x32_bf16(Bt[n][k], At[m][k], acc[ai][bj][m][n], 0, 0, 0); __builtin_amdgcn_s_setprio(0); } while (0)
#define PG8_WAIT_V(n) asm volatile("s_waitcnt vmcnt(" #n ")" ::: "memory")
#define PG8_WAIT_L(n) asm volatile("s_waitcnt lgkmcnt(" #n ")" ::: "memory")
#define PG8_BAR __builtin_amdgcn_s_barrier()
#define PG8_SCHED __builtin_amdgcn_sched_barrier(0)
#define PG8_SETVO(vo, u) do { _Pragma("unroll") for (int _h = 0; _h < 2; ++_h) _Pragma("unroll") for (int _i = 0; _i < 2; ++_i) { \
        const int _row = GATHER ? S.arow(u, _h * HALF + Rv[_i]) : (u).arow0 + _h * HALF + Rv[_i]; (vo)[_h][_i] = (unsigned)(_row * K + Cv[_i]) * 2u; } } while (0)
    Unit cur, nxt; int ui = 0;
    if (!S.next(0, cur)) return;
    unsigned voC[2][2], voN[2][2];
    PG8_SETVO(voC, cur);
    f32x4 acc[2][2][4][2];
#pragma unroll
    for (int a = 0; a < 2; ++a)
#pragma unroll
        for (int b = 0; b < 2; ++b)
#pragma unroll
            for (int m = 0; m < 4; ++m)
#pragma unroll
                for (int n = 0; n < 2; ++n) acc[a][b][m][n] = (f32x4){0.f, 0.f, 0.f, 0.f};
    bf16x8 At[4][2], B0[2][2], B1[2][2];
    unsigned cB = cur.B, cB1 = cur.B1;
    if constexpr (BF32) {
        PG8_STAGE_A(PG8_SA(0, 0), voC[0], 0); PG8_STAGE_A(PG8_SA(0, 1), voC[1], 0);
        PG8_BLOAD(0, cB, 0); PG8_BWRITE(PG8_SB(0, 0)); PG8_BLOAD(1, cB1, 0); PG8_BWRITE(PG8_SB(0, 1));
        PG8_WAIT_V(0); PG8_WAIT_L(0);
        if (wr == 1) PG8_BAR;
        PG8_BAR;
        PG8_STAGE_A(PG8_SA(1, 0), voC[0], kstep); PG8_BLOAD(0, cB, 1);
        PG8_BAR;
    } else {
    PG8_STAGE_B(PG8_SB(0, 0), cB); PG8_STAGE_B(PG8_SB(0, 1), cB + hstepB); PG8_STAGE_A(PG8_SA(0, 0), voC[0], 0); PG8_STAGE_A(PG8_SA(0, 1), voC[1], 0);
    if (wr == 1) PG8_BAR;
    PG8_WAIT_V(2); PG8_BAR;
    PG8_STAGE_B(PG8_SB(1, 0), cB + kstep); PG8_STAGE_A(PG8_SA(1, 0), voC[0], kstep); PG8_STAGE_B(PG8_SB(1, 1), cB + hstepB + kstep);
    PG8_WAIT_V(6); PG8_BAR;
    }
    for (;;) {
        const bool has_next = S.next(ui + 1, nxt);
        const unsigned nB = has_next ? nxt.B : cB, nB1 = has_next ? nxt.B1 : cB1;
        if (has_next) { PG8_SETVO(voN, nxt); } else {
#pragma unroll
            for (int h = 0; h < 2; ++h)
#pragma unroll
                for (int i = 0; i < 2; ++i) voN[h][i] = voC[h][i]; }
        for (int t = 0; t < nt; t += 2) {
            const bool last = (t == nt - 2);
            const unsigned kb1 = (unsigned)(t + 1) * kstep;
            const unsigned kb2 = last ? 0u : (unsigned)(t + 2) * kstep, kb3 = kb2 + kstep;
            const unsigned b2 = last ? nB : cB + (unsigned)(t + 2) * kstep, b3 = b2 + kstep;
            unsigned vo2[2][2];
#pragma unroll
            for (int h = 0; h < 2; ++h)
#pragma unroll
                for (int i = 0; i < 2; ++i) vo2[h][i] = last ? voN[h][i] : voC[h][i];
            if constexpr (BF32) {
            const unsigned h20 = last ? nB : cB; const int kt2 = last ? 0 : t + 2;
            PG8_LDBT(B0, 0, 0); PG8_SCHED; PG8_LDA(At, 0, 0); PG8_BWRITE(PG8_SB(1, 0)); PG8_STAGE_A(PG8_SA(1, 1), voC[1], kb1); PG8_BLOAD(1, cB1, t + 1);
            PG8_WAIT_L(0); PG8_BAR; PG8_MMA(0, 0, At, B0); PG8_SCHED; PG8_LDBT(B0, 0, 1); PG8_WAIT_L(0); PG8_SCHED; PG8_MMA(0, 1, At, B0); PG8_BAR; PG8_SCHED;
            PG8_LDBT(B0, 0, 0); PG8_SCHED; PG8_LDA(At, 0, 1); PG8_BWRITE(PG8_SB(1, 1)); PG8_STAGE_A(PG8_SA(0, 0), vo2[0], kb2); PG8_BLOAD(0, h20, kt2);
            PG8_WAIT_L(0); PG8_BAR; PG8_MMA(1, 0, At, B0); PG8_SCHED; PG8_LDBT(B0, 0, 1); PG8_WAIT_L(0); PG8_SCHED; PG8_MMA(1, 1, At, B0); PG8_BAR; PG8_SCHED;
            const unsigned h21 = last ? nB1 : cB1;
            PG8_LDBT(B0, 1, 0); PG8_SCHED; PG8_LDA(At, 1, 0); PG8_BWRITE(PG8_SB(0, 0)); PG8_STAGE_A(PG8_SA(0, 1), vo2[1], kb2); PG8_BLOAD(1, h21, kt2);
            PG8_WAIT_L(0); PG8_BAR; PG8_MMA(0, 0, At, B0); PG8_SCHED; PG8_LDBT(B0, 1, 1); PG8_WAIT_L(0); PG8_SCHED; PG8_MMA(0, 1, At, B0); PG8_BAR; PG8_SCHED;
            PG8_LDA(At, 1, 1); PG8_LDBT(B0, 1, 0); PG8_SCHED; PG8_BWRITE(PG8_SB(0, 1)); PG8_STAGE_A(PG8_SA(1, 0), vo2[0], kb3); PG8_BLOAD(0, h20, kt2 + 1);
            PG8_WAIT_L(0); PG8_BAR; PG8_MMA(1, 0, At, B0); PG8_SCHED; PG8_LDBT(B0, 1, 1); PG8_WAIT_L(0); PG8_SCHED; PG8_MMA(1, 1, At, B0); PG8_BAR; PG8_SCHED;
            } else {
            PG8_LDB(B0, 0, 0); PG8_LDB(B1, 0, 1); PG8_SCHED; PG8_LDA(At, 0, 0); PG8_STAGE_A(PG8_SA(1, 1), voC[1], kb1);
            PG8_WAIT_V(8); PG8_WAIT_L(0); PG8_BAR; PG8_MMA(0, 0, At, B0); PG8_MMA(0, 1, At, B1); PG8_BAR; PG8_SCHED;
            PG8_LDA(At, 0, 1); PG8_STAGE_B(PG8_SB(0, 0), b2); PG8_STAGE_B(PG8_SB(0, 1), b2 + hstepB); PG8_STAGE_A(PG8_SA(0, 0), vo2[0], kb2);
            PG8_WAIT_V(8); PG8_WAIT_L(0); PG8_BAR; PG8_MMA(1, 0, At, B0); PG8_MMA(1, 1, At, B1); PG8_BAR; PG8_SCHED;
            PG8_LDB(B0, 1, 0); PG8_LDB(B1, 1, 1); PG8_SCHED; PG8_LDA(At, 1, 0); PG8_STAGE_A(PG8_SA(0, 1), vo2[1], kb2);
            PG8_WAIT_V(8); PG8_WAIT_L(0); PG8_BAR; PG8_MMA(0, 0, At, B0); PG8_MMA(0, 1, At, B1); PG8_BAR; PG8_SCHED;
            PG8_LDA(At, 1, 1); PG8_STAGE_B(PG8_SB(1, 0), b3); PG8_STAGE_B(PG8_SB(1, 1), b3 + hstepB); PG8_STAGE_A(PG8_SA(1, 0), vo2[0], kb3);
            PG8_WAIT_V(8); PG8_WAIT_L(0); PG8_BAR; PG8_MMA(1, 0, At, B0); PG8_MMA(1, 1, At, B1); PG8_BAR; PG8_SCHED;
            }
        }
        if constexpr (ALIGN_EPI) { if (wr == 0) PG8_BAR; }
        E(acc, cur, wr, wc, fr, fq);
        if (!has_next) break;
#pragma unroll
        for (int a = 0; a < 2; ++a)
#pragma unroll
            for (int b = 0; b < 2; ++b)
#pragma unroll
                for (int m = 0; m < 4; ++m)
#pragma unroll
                    for (int n = 0; n < 2; ++n) acc[a][b][m][n] = (f32x4){0.f, 0.f, 0.f, 0.f};
        cur = nxt; cB = nB; cB1 = nB1; ++ui;
#pragma unroll
        for (int h = 0; h < 2; ++h)
#pragma unroll
            for (int i = 0; i < 2; ++i) voC[h][i] = voN[h][i];
        if constexpr (ALIGN_EPI) { if (wr == 1) PG8_BAR; }
    }
    PG8_WAIT_V(0);
    if constexpr (!ALIGN_EPI) { if (wr == 0) PG8_BAR; }
    PG8_BAR;
#undef PG8_SA
#undef PG8_SB
#undef PG8_STAGE_A
#undef PG8_STAGE_B
#undef PG8_LDA
#undef PG8_LDB
#undef PG8_LDBT
#undef PG8_LDBX
#undef PG8_TR
#undef PG8_BLOAD
#undef PG8_BWRITE
#undef PG8_MMA
#undef PG8_WAIT_V
#undef PG8_WAIT_L
#undef PG8_BAR
#undef PG8_SCHED
#undef PG8_SETVO
}
}


namespace mz {
using pg8::lds_byte; using pg8::stage_rc; using pg8::Unit; using pg8::s16x4_t; using pg8::v4i16g_t;
template <class Epi, class Sched, bool GATHER>
__device__ __forceinline__ void gemm_z(LAS unsigned char* lds, const void* Amat, const unsigned Abytes, const int K, const Sched& S, const Epi& E) {
    const __amdgpu_buffer_rsrc_t rA = __builtin_amdgcn_make_buffer_rsrc((void*)Amat, 0, Abytes, 0x00020000);
    const __amdgpu_buffer_rsrc_t rB0 = __builtin_amdgcn_make_buffer_rsrc((void*)S.Wb0, 0, S.Wbytes, 0x00020000), rB1 = __builtin_amdgcn_make_buffer_rsrc((void*)S.Wb1, 0, S.Wbytes, 0x00020000);
    const int tid = threadIdx.x, wid = __builtin_amdgcn_readfirstlane(tid >> 6), lane = tid & 63, wr = wid >> 2, wc = wid & 3, fr = lane & 15, fq = lane >> 4;
    const int nt = K / 64;
    const unsigned ldwb = (unsigned)S.ldwb, ktb = 64u * ldwb;
    int Rv[2], Cv[2];
#pragma unroll
    for (int i = 0; i < 2; ++i) stage_rc(tid * 16 + i * 8192, Rv[i], Cv[i]);
    const unsigned ldsw = (unsigned)wid * 1024u;
    const int aoff = lds_byte(wr * 64 + fr, fq * 8);
    const int bk0 = tid >> 5, bmm = tid & 31;
    const unsigned bwoff = (256u * bk0 + 16u * ((unsigned)(bmm >> 1) ^ ((((unsigned)bk0 & 3u) << 2) | (((unsigned)bk0 >> 2) & 3u)))) + 8u * (((unsigned)bmm & 1u) ^ (((unsigned)bk0 >> 3) & 1u));
    unsigned bgo[4];
#pragma unroll
    for (int i = 0; i < 4; ++i) bgo[i] = (unsigned)(bk0 + 16 * i) * ldwb + (unsigned)bmm * 16u;
    unsigned trb[2][2];
#pragma unroll
    for (int t = 0; t < 2; ++t)
#pragma unroll
        for (int nf = 0; nf < 2; ++nf) { const unsigned row = 8u * fq + 4u * t + ((unsigned)fr >> 2), ch = 4u * wc + ((unsigned)fr & 3u);
            trb[t][nf] = 256u * row + 16u * (ch ^ (((row & 3u) << 2) | ((row >> 2) & 3u))) + 8u * ((unsigned)nf ^ ((unsigned)fq & 1u)); }
#define MZ_SB(p, h) (((p) * 2 + (h)) * 16384)
#define MZ_SA(q) (65536 + (q) * 16384)
#define MZ_STAGE_A(q, vo, kb) do { _Pragma("unroll") for (int _i = 0; _i < 2; ++_i) \
        __builtin_amdgcn_raw_ptr_buffer_load_lds(rA, (LAS void*)(lds + MZ_SA(q) + ldsw + _i * 8192), 16, (int)(vo)[_i], (int)(kb), 0, 0); } while (0)
#define MZ_BLOAD(X, so0, so1, kt) do { const int _s0 = (int)((so0) + (unsigned)(kt) * ktb), _s1 = (int)((so1) + (unsigned)(kt) * ktb); _Pragma("unroll") for (int _i = 0; _i < 4; ++_i) { \
        X[0][_i] = __builtin_bit_cast(f32x4, __builtin_amdgcn_raw_buffer_load_b128(rB0, (int)bgo[_i], _s0, 0)); X[1][_i] = __builtin_bit_cast(f32x4, __builtin_amdgcn_raw_buffer_load_b128(rB1, (int)bgo[_i], _s1, 0)); } } while (0)
#define MZ_BWRITE(X, p) do { _Pragma("unroll") for (int _h = 0; _h < 2; ++_h) _Pragma("unroll") for (int _i = 0; _i < 4; ++_i) { v2u _w; _w.x = cvt_pk_bf16(X[_h][_i].x, X[_h][_i].y); _w.y = cvt_pk_bf16(X[_h][_i].z, X[_h][_i].w); \
        *(LAS v2u*)(lds + MZ_SB(p, _h) + bwoff + 4096 * _i) = _w; } } while (0)
#define MZ_TR(addr) __builtin_bit_cast(s16x4_t, __builtin_amdgcn_ds_read_tr16_b64_v4i16((LAS v4i16g_t*)(addr)))
#define MZ_LDB(dst, p, h) do { _Pragma("unroll") for (int n = 0; n < 2; ++n) _Pragma("unroll") for (int k = 0; k < 2; ++k) { \
        const s16x4_t _lo = MZ_TR(lds + MZ_SB(p, h) + trb[0][n] + 8192 * k), _hi = MZ_TR(lds + MZ_SB(p, h) + trb[1][n] + 8192 * k); \
        dst[n][k] = (bf16x8){_lo[0], _lo[1], _lo[2], _lo[3], _hi[0], _hi[1], _hi[2], _hi[3]}; } } while (0)
#define MZ_LDA(q) do { _Pragma("unroll") for (int m = 0; m < 4; ++m) _Pragma("unroll") for (int k = 0; k < 2; ++k) At[m][k] = *(const LAS bf16x8*)(lds + MZ_SA(q) + aoff + m * 2048 + k * 1024); } while (0)
#define MZ_MMA() do { __builtin_amdgcn_s_setprio(1); _Pragma("unroll") for (int m = 0; m < 4; ++m) _Pragma("unroll") for (int n = 0; n < 2; ++n) _Pragma("unroll") for (int k = 0; k < 2; ++k) { \
        acc[0][m][n] = __builtin_amdgcn_mfma_f32_16x16x32_bf16(B0[n][k], At[m][k], acc[0][m][n], 0, 0, 0); acc[1][m][n] = __builtin_amdgcn_mfma_f32_16x16x32_bf16(B1[n][k], At[m][k], acc[1][m][n], 0, 0, 0); } \
        __builtin_amdgcn_s_setprio(0); } while (0)
#define MZ_WAIT_V(n) asm volatile("s_waitcnt vmcnt(" #n ")" ::: "memory")
#define MZ_WAIT_L(n) asm volatile("s_waitcnt lgkmcnt(" #n ")" ::: "memory")
#define MZ_BAR __builtin_amdgcn_s_barrier()
#define MZ_SCHED __builtin_amdgcn_sched_barrier(0)
#define MZ_SETVO(vo, u) do { _Pragma("unroll") for (int _i = 0; _i < 2; ++_i) { const int _row = GATHER ? S.arow(u, Rv[_i]) : (u).arow0 + Rv[_i]; (vo)[_i] = (unsigned)(_row * K + Cv[_i]) * 2u; } } while (0)
#define MZ_SP(q, p, X, avo, akb, b0, b1, bkt) do { \
        MZ_LDA(q); MZ_LDB(B0, p, 0); MZ_LDB(B1, p, 1); MZ_SCHED; MZ_BWRITE(X, (p) ^ 1); MZ_STAGE_A(((q) + 2) & 3, avo, akb); MZ_BLOAD(X, b0, b1, bkt); \
        MZ_WAIT_V(18); MZ_WAIT_L(0); MZ_BAR; MZ_MMA(); MZ_BAR; MZ_SCHED; } while (0)
    Unit cur, nxt; int ui = 0;
    if (!S.next(0, cur)) return;
    unsigned voC[2], voN[2];
    MZ_SETVO(voC, cur);
    f32x4 acc[2][4][2];
#pragma unroll
    for (int b = 0; b < 2; ++b)
#pragma unroll
        for (int m = 0; m < 4; ++m)
#pragma unroll
            for (int n = 0; n < 2; ++n) acc[b][m][n] = (f32x4){0.f, 0.f, 0.f, 0.f};
    bf16x8 At[4][2], B0[2][2], B1[2][2];
    f32x4 P[2][4], Q[2][4];
    MZ_STAGE_A(0, voC, 0); MZ_STAGE_A(1, voC, 128);
    MZ_BLOAD(P, cur.B, cur.B1, 0); MZ_BWRITE(P, 0);
    MZ_WAIT_V(0); MZ_WAIT_L(0);
    if (wr == 1) MZ_BAR;
    MZ_BAR;
    MZ_BLOAD(P, cur.B, cur.B1, 1); MZ_BLOAD(Q, cur.B, cur.B1, 2);
    for (;;) {
        const bool has_next = S.next(ui + 1, nxt);
        const unsigned nB = has_next ? nxt.B : cur.B, nB1 = has_next ? nxt.B1 : cur.B1;
        if (has_next) { MZ_SETVO(voN, nxt); } else { voN[0] = voC[0]; voN[1] = voC[1]; }
        for (int t = 0; t < nt; t += 4) {
            const bool last = (t == nt - 4);
            MZ_SP(0, 0, P, voC, (unsigned)(t + 2) * 128u, cur.B, cur.B1, t + 3);
            { const unsigned b0 = last ? nB : cur.B, b1 = last ? nB1 : cur.B1; const int bkt = last ? 0 : t + 4;
              MZ_SP(1, 1, Q, voC, (unsigned)(t + 3) * 128u, b0, b1, bkt); }
            { const unsigned b0 = last ? nB : cur.B, b1 = last ? nB1 : cur.B1; const int bkt = last ? 1 : t + 5;
              unsigned av[2]; av[0] = last ? voN[0] : voC[0]; av[1] = last ? voN[1] : voC[1]; const unsigned akb = last ? 0u : (unsigned)(t + 4) * 128u;
              MZ_SP(2, 0, P, av, akb, b0, b1, bkt); }
            { const unsigned b0 = last ? nB : cur.B, b1 = last ? nB1 : cur.B1; const int bkt = last ? 2 : t + 6;
              unsigned av[2]; av[0] = last ? voN[0] : voC[0]; av[1] = last ? voN[1] : voC[1]; const unsigned akb = last ? 128u : (unsigned)(t + 5) * 128u;
              MZ_SP(3, 1, Q, av, akb, b0, b1, bkt); }
        }
        if (wr == 0) MZ_BAR;
        E(acc, cur, wr, wc, fr, fq);
        if (!has_next) break;
#pragma unroll
        for (int b = 0; b < 2; ++b)
#pragma unroll
            for (int m = 0; m < 4; ++m)
#pragma unroll
                for (int n = 0; n < 2; ++n) acc[b][m][n] = (f32x4){0.f, 0.f, 0.f, 0.f};
        cur = nxt; ++ui; voC[0] = voN[0]; voC[1] = voN[1];
        if (wr == 1) MZ_BAR;
    }
    MZ_WAIT_V(0);
    MZ_BAR;
#undef MZ_SB
#undef MZ_SA
#undef MZ_STAGE_A
#undef MZ_BLOAD
#undef MZ_BWRITE
#undef MZ_TR
#undef MZ_LDB
#undef MZ_LDA
#undef MZ_MMA
#undef MZ_WAIT_V
#undef MZ_WAIT_L
#undef MZ_BAR
#undef MZ_SCHED
#undef MZ_SETVO
#undef MZ_SP
}
}


namespace mw {
using pg8::lds_byte; using pg8::stage_rc; using pg8::Unit; using pg8::s16x4_t; using pg8::v4i16g_t;
template <class Epi, class Sched, bool GATHER>
__device__ __forceinline__ void gemm_w(LAS unsigned char* lds, const void* Amat, const unsigned Abytes, const int K, const Sched& S, const Epi& E) {
    const __amdgpu_buffer_rsrc_t rA = __builtin_amdgcn_make_buffer_rsrc((void*)Amat, 0, Abytes, 0x00020000);
    const __amdgpu_buffer_rsrc_t rB0 = __builtin_amdgcn_make_buffer_rsrc((void*)S.Wb0, 0, S.Wbytes, 0x00020000), rB1 = __builtin_amdgcn_make_buffer_rsrc((void*)S.Wb1, 0, S.Wbytes, 0x00020000);
    const int wid = S.wave, lane = lane_now(), tid = wid * 64 + lane, wr = wid >> 2, wc = wid & 3, fr = lane & 15, fq = lane >> 4;
    const int nt = K / 64;
    const unsigned ldwb = (unsigned)S.ldwb, ktb = 64u * ldwb, pstep = 16u * ldwb, hA = (unsigned)(128 * K * 2);
    int Rv[2], Cv[2]; unsigned al[2];
#pragma unroll
    for (int i = 0; i < 2; ++i) { stage_rc(tid * 16 + i * 8192, Rv[i], Cv[i]); al[i] = (unsigned)(Rv[i] * K + Cv[i]) * 2u; }
    const unsigned ldsw = (unsigned)wid * 1024u;
    const int aoff = lds_byte(wr * 64 + fr, fq * 8);
    const int bk0 = tid >> 5, bmm = tid & 31;
    const unsigned bwoff = (256u * bk0 + 16u * ((unsigned)(bmm >> 1) ^ ((((unsigned)bk0 & 3u) << 2) | (((unsigned)bk0 >> 2) & 3u)))) + 8u * (((unsigned)bmm & 1u) ^ (((unsigned)bk0 >> 3) & 1u));
    const unsigned bgoff = (unsigned)bk0 * ldwb + (unsigned)bmm * 16u;
    unsigned trb[2];
#pragma unroll
    for (int t = 0; t < 2; ++t) { const unsigned row = 8u * fq + 4u * t + ((unsigned)fr >> 2), ch = 4u * wc + ((unsigned)fr & 3u);
        trb[t] = 256u * row + 16u * (ch ^ (((row & 3u) << 2) | ((row >> 2) & 3u))) + 8u * ((unsigned)fq & 1u); }
    unsigned tra[2][2];
#pragma unroll
    for (int t = 0; t < 2; ++t)
#pragma unroll
        for (int n = 0; n < 2; ++n) tra[t][n] = (unsigned)(__SIZE_TYPE__)lds + (trb[t] ^ (8u * n));
#define MW_SB(b, h) (((b) * 2 + (h)) * 16384)
#define MW_SA(b, h) ((4 + (b) * 2 + (h)) * 16384)
#define MW_TRA(dst, a, off) asm volatile("ds_read_b64_tr_b16 %0, %1 offset:%2" : "=v"(dst) : "v"(a), "n"(off))
#define MW_LDB_A1(dst, b, h, n, k) do { v2u _lo, _hi; MW_TRA(_lo, tra[0][n], MW_SB(b, h) + 8192 * (k)); MW_TRA(_hi, tra[1][n], MW_SB(b, h) + 8192 * (k)); \
        dst[n][k] = __builtin_bit_cast(bf16x8, (v4u){_lo.x, _lo.y, _hi.x, _hi.y}); } while (0)
#define MW_LDB_A(dst, b, h) do { MW_LDB_A1(dst, b, h, 0, 0); MW_LDB_A1(dst, b, h, 0, 1); MW_LDB_A1(dst, b, h, 1, 0); MW_LDB_A1(dst, b, h, 1, 1); } while (0)
    const unsigned aad = (unsigned)(__SIZE_TYPE__)lds + 65536u + (unsigned)aoff;
#define MW_LDA_A1(b, h, m, k) asm volatile("ds_read_b128 %0, %1 offset:%2" : "=v"(At[m][k]) : "v"(aad), "n"(((b) * 2 + (h)) * 16384 + (m) * 2048 + (k) * 1024))
#define MW_LDA_A(b, h) do { MW_LDA_A1(b, h, 0, 0); MW_LDA_A1(b, h, 0, 1); MW_LDA_A1(b, h, 1, 0); MW_LDA_A1(b, h, 1, 1); MW_LDA_A1(b, h, 2, 0); MW_LDA_A1(b, h, 2, 1); MW_LDA_A1(b, h, 3, 0); MW_LDA_A1(b, h, 3, 1); } while (0)
#define MW_VO_voC(h, i) voC[h][i]
#define MW_VO_voN(h, i) voNt[(2 * (h) + (i)) * 512]
#define MW_STAGE_A(b, h, vo, uo, kb) do { _Pragma("unroll") for (int _i = 0; _i < 2; ++_i) { \
        if constexpr (GATHER) __builtin_amdgcn_raw_ptr_buffer_load_lds(rA, (LAS void*)(lds + MW_SA(b, h) + ldsw + _i * 8192), 16, (int)MW_VO_##vo(h, _i), (int)(kb), 0, 0); \
        else __builtin_amdgcn_raw_ptr_buffer_load_lds(rA, (LAS void*)(lds + MW_SA(b, h) + ldsw + _i * 8192), 16, (int)al[_i], (int)((uo) + (h) * hA + (kb)), 0, 0); } } while (0)
#define MW_BLOAD(X, h, so, kt) do { const unsigned _s = (so) + (unsigned)(kt) * ktb; _Pragma("unroll") for (int _i = 0; _i < 4; ++_i) \
        X[_i] = __builtin_bit_cast(f32x4, __builtin_amdgcn_raw_buffer_load_b128((h) ? rB1 : rB0, (int)bgoff, (int)(_s + (unsigned)_i * pstep), 0)); } while (0)
#define MW_BWRITE(X, b, h) do { _Pragma("unroll") for (int _i = 0; _i < 4; ++_i) { v2u _w; _w.x = cvt_pk_bf16(X[_i].x, X[_i].y); _w.y = cvt_pk_bf16(X[_i].z, X[_i].w); *(LAS v2u*)(lds + MW_SB(b, h) + bwoff + 4096 * _i) = _w; } } while (0)
#define MW_TR(addr) __builtin_bit_cast(s16x4_t, __builtin_amdgcn_ds_read_tr16_b64_v4i16((LAS v4i16g_t*)(addr)))
#define MW_LDB(b, h) do { _Pragma("unroll") for (int n = 0; n < 2; ++n) _Pragma("unroll") for (int k = 0; k < 2; ++k) { \
        const s16x4_t _lo = MW_TR(lds + MW_SB(b, h) + (trb[0] ^ (8u * n)) + 8192 * k), _hi = MW_TR(lds + MW_SB(b, h) + (trb[1] ^ (8u * n)) + 8192 * k); \
        B0[n][k] = (bf16x8){_lo[0], _lo[1], _lo[2], _lo[3], _hi[0], _hi[1], _hi[2], _hi[3]}; } } while (0)
#define MW_LDA(b, h) do { _Pragma("unroll") for (int m = 0; m < 4; ++m) _Pragma("unroll") for (int k = 0; k < 2; ++k) At[m][k] = *(const LAS bf16x8*)(lds + MW_SA(b, h) + aoff + m * 2048 + k * 1024); } while (0)
#define MW_MMA(ai, bj, Bf) do { __builtin_amdgcn_s_setprio(1); _Pragma("unroll") for (int k = 0; k < 2; ++k) _Pragma("unroll") for (int m = 0; m < 4; ++m) _Pragma("unroll") for (int n = 0; n < 2; ++n)   \
        asm volatile("v_mfma_f32_16x16x32_bf16 %0, %1, %2, %0" : "+v"(acc[ai][bj][m][n]) : "v"(Bf[n][k]), "v"(At[m][k]));   \
        __builtin_amdgcn_s_setprio(0); } while (0)
#define MW_WAIT_V(n) asm volatile("s_waitcnt vmcnt(" #n ")" ::: "memory")
#define MW_WAIT_L(n) asm volatile("s_waitcnt lgkmcnt(" #n ")" ::: "memory")
#define MW_BAR __builtin_amdgcn_s_barrier()
#define MW_SCHED __builtin_amdgcn_sched_barrier(0)
#define MW_SETVO(vo, u) do { if constexpr (GATHER) { const int _t = wid * 64 + lane_now();   \
        _Pragma("unroll") for (int _i = 0; _i < 2; ++_i) { int _R, _C; stage_rc(_t * 16 + _i * 8192, _R, _C); _Pragma("unroll") for (int _h = 0; _h < 2; ++_h) { \
        const int _row = S.arow(u, _h * 128 + _R); MW_VO_##vo(_h, _i) = (unsigned)(_row * K + _C) * 2u; } } } } while (0)
#define MW_SP(rb, ai, X, wb, wh, sb, sh, svo, suo, skb, lh, lso, lkt) do { \
        MW_LDB_A(B0, rb, 0); MW_LDB_A(B1, rb, 1); MW_SCHED; MW_LDA_A(rb, ai); MW_BWRITE(X, wb, wh); MW_STAGE_A(sb, sh, svo, suo, skb); \
        MW_WAIT_L(0); MW_BAR; MW_MMA(ai, 0, B0); MW_MMA(ai, 1, B1); MW_SCHED; MW_BLOAD(X, lh, lso, lkt); MW_SCHED; MW_BAR; MW_SCHED; } while (0)
    Unit cur, nxt; int ui = 0;
    if (!S.next(0, cur)) return;
    unsigned voC[2][2];
    LAS unsigned* const voNt = (LAS unsigned*)(lds + 131072 + 2048) + tid;
    MW_SETVO(voC, cur);
    f32x4 acc[2][2][4][2];
#pragma unroll
    for (int a = 0; a < 2; ++a)
#pragma unroll
        for (int b = 0; b < 2; ++b)
#pragma unroll
            for (int m = 0; m < 4; ++m)
#pragma unroll
                for (int n = 0; n < 2; ++n) acc[a][b][m][n] = (f32x4){0.f, 0.f, 0.f, 0.f};
    bf16x8 At[4][2], B0[2][2], B1[2][2];
    f32x4 X[4], Y[4];
    unsigned cU = (unsigned)cur.arow0 * (unsigned)(K * 2);
    MW_STAGE_A(0, 0, voC, cU, 0u); MW_STAGE_A(0, 1, voC, cU, 0u);
    MW_BLOAD(X, 0, cur.B, 0); MW_BWRITE(X, 0, 0); MW_BLOAD(Y, 1, cur.B1, 0); MW_BWRITE(Y, 0, 1);
    MW_WAIT_V(0); MW_WAIT_L(0);
    if (wr == 1) MW_BAR;
    MW_BAR;
    MW_STAGE_A(1, 0, voC, cU, 128u); MW_BLOAD(X, 0, cur.B, 1); MW_BLOAD(Y, 1, cur.B1, 1);
    MW_BAR;
    for (;;) {
        const bool has_next = S.next(ui + 1, nxt);
        const unsigned nB = has_next ? nxt.B : cur.B, nB1 = has_next ? nxt.B1 : cur.B1, nU = has_next ? (unsigned)nxt.arow0 * (unsigned)(K * 2) : cU;
        if constexpr (GATHER) { if (has_next) { MW_SETVO(voN, nxt); } else {
#pragma unroll
            for (int h = 0; h < 2; ++h)
#pragma unroll
                for (int i = 0; i < 2; ++i) MW_VO_voN(h, i) = voC[h][i]; } }
        for (int t = 0; t < nt - 2; t += 2) {
            MW_SP(0, 0, X, 1, 0, 1, 1, voC, cU, (unsigned)(t + 1) * 128u, 0, cur.B, t + 2);
            MW_SP(0, 1, Y, 1, 1, 0, 0, voC, cU, (unsigned)(t + 2) * 128u, 1, cur.B1, t + 2);
            MW_SP(1, 0, X, 0, 0, 0, 1, voC, cU, (unsigned)(t + 2) * 128u, 0, cur.B, t + 3);
            MW_SP(1, 1, Y, 0, 1, 1, 0, voC, cU, (unsigned)(t + 3) * 128u, 1, cur.B1, t + 3);
        }
        {
            const int t = nt - 2;
            MW_SP(0, 0, X, 1, 0, 1, 1, voC, cU, (unsigned)(t + 1) * 128u, 0, nB, 0);
            MW_SP(0, 1, Y, 1, 1, 0, 0, voN, nU, 0u, 1, nB1, 0);
            MW_SP(1, 0, X, 0, 0, 0, 1, voN, nU, 0u, 0, nB, 1);
            MW_SP(1, 1, Y, 0, 1, 1, 0, voN, nU, 128u, 1, nB1, 1);
        }
        asm volatile("s_nop 15\n\ts_nop 7" ::: "memory");
        if (wr == 0) MW_BAR;
        E(acc, cur, wr, wc, fr, fq);
        if (!has_next) break;
#pragma unroll
        for (int a = 0; a < 2; ++a)
#pragma unroll
            for (int b = 0; b < 2; ++b)
#pragma unroll
                for (int m = 0; m < 4; ++m)
#pragma unroll
                    for (int n = 0; n < 2; ++n) acc[a][b][m][n] = (f32x4){0.f, 0.f, 0.f, 0.f};
        cur = nxt; cU = nU; ++ui;
        if constexpr (GATHER) {
#pragma unroll
            for (int h = 0; h < 2; ++h)
#pragma unroll
                for (int i = 0; i < 2; ++i) voC[h][i] = MW_VO_voN(h, i); }
        if (wr == 1) MW_BAR;
    }
    MW_WAIT_V(0);
    MW_BAR;
#undef MW_SB
#undef MW_SA
#undef MW_STAGE_A
#undef MW_BLOAD
#undef MW_BWRITE
#undef MW_TR
#undef MW_TRA
#undef MW_LDB_A1
#undef MW_LDB_A
#undef MW_LDA_A1
#undef MW_LDA_A
#undef MW_LDB
#undef MW_LDA
#undef MW_MMA
#undef MW_WAIT_V
#undef MW_WAIT_L
#undef MW_BAR
#undef MW_SCHED
#undef MW_SETVO
#undef MW_VO_voC
#undef MW_VO_voN
#undef MW_SP
}
}

#define XB_TMO      128
#define XB_XCNT(j)  (256  + 64 * (j))
#define XB_XSUB(j)  (1280 + 64 * (j))
#define XB_XGEN(j)  (2304 + 64 * (j))
#define XB_TOP      3328
#define XB_TOPGEN   3392
#define XCD_BAR_WORDS 3456
#define XB_SPIN_CAP (1u << 18)
__device__ __forceinline__ unsigned xb_ld(unsigned* p)              { return __hip_atomic_load(p, __ATOMIC_RELAXED, __HIP_MEMORY_SCOPE_AGENT); }
__device__ __forceinline__ unsigned xb_add(unsigned* p, unsigned v) { return __hip_atomic_fetch_add(p, v, __ATOMIC_RELAXED, __HIP_MEMORY_SCOPE_AGENT); }
__device__ __forceinline__ unsigned xb_xcc_id() { return (unsigned)__builtin_amdgcn_s_getreg((3 << 11) | 20) & 0xFu; }
#define XB_SPIN(cond, bar) do { unsigned _sp = 0; while (cond) { __builtin_amdgcn_s_sleep(1); \
    if ((++_sp & 255u) == 0u) { if (xb_ld(&(bar)[XB_TMO])) break; if (_sp > XB_SPIN_CAP) { atomicAdd(&(bar)[XB_TMO], 1u); break; } } } } while (0)
struct XcdBarrier { unsigned* bar; unsigned x; volatile LAS unsigned* st; };
__device__ __forceinline__ XcdBarrier xcd_barrier_post(unsigned* bar, volatile LAS unsigned* st) {
    XcdBarrier b; b.bar = bar; b.x = xb_xcc_id(); b.st = st;
    if (threadIdx.x == 0) (void)xb_add(&bar[XB_XCNT(b.x)], 1u);
    return b;
}
__device__ __forceinline__ void xcd_barrier_complete(unsigned* bar, unsigned x, unsigned& nloc, unsigned& nx) {
    const unsigned G = gridDim.x * gridDim.y * gridDim.z;
    unsigned sum, cnt, mine, sp = 0u;
    for (;;) {
        sum = 0u; cnt = 0u; mine = 0u;
#pragma unroll
        for (unsigned j = 0; j < 16; ++j) { const unsigned c = xb_ld(&bar[XB_XCNT(j)]); sum += c; cnt += (c > 0u) ? 1u : 0u; mine = (j == x) ? c : mine; }
        if (sum == G) break;
        __builtin_amdgcn_s_sleep(1);
        if ((++sp & 255u) == 0u) { if (xb_ld(&bar[XB_TMO])) break; if (sp > XB_SPIN_CAP) { atomicAdd(&bar[XB_TMO], 1u); break; } }
    }
    nloc = mine > 0u ? mine : 1u; nx = cnt > 0u ? cnt : 1u;
}
__device__ __forceinline__ void xcd_barrier(const XcdBarrier& b) {
    asm volatile("s_waitcnt vmcnt(0)" ::: "memory");
    __syncthreads();
    if (threadIdx.x == 0) {
        unsigned* bar = b.bar;
        __builtin_amdgcn_s_waitcnt(0);
        unsigned nloc = b.st[0], nx = b.st[1];
        if (nloc == 0u) { xcd_barrier_complete(bar, b.x, nloc, nx); b.st[0] = nloc; b.st[1] = nx; }
        const unsigned old = xb_add(&bar[XB_XSUB(b.x)], 1u);
        const unsigned gen = old / nloc;
        if (old + 1u == (gen + 1u) * nloc) {
            __builtin_amdgcn_fence(__ATOMIC_RELEASE, "agent");
            asm volatile("s_waitcnt vmcnt(0)" ::: "memory");
            const unsigned og = xb_add(&bar[XB_TOP], 1u);
            const unsigned tg = og / nx;
            if (og + 1u == (tg + 1u) * nx) xb_add(&bar[XB_TOPGEN], 1u);
            else XB_SPIN(xb_ld(&bar[XB_TOPGEN]) == tg, bar);
            __builtin_amdgcn_fence(__ATOMIC_ACQUIRE, "agent");
            xb_add(&bar[XB_XGEN(b.x)], 1u);
            asm volatile("s_waitcnt vmcnt(0)" ::: "memory");
        } else {
            XB_SPIN(xb_ld(&bar[XB_XGEN(b.x)]) == gen, bar);
            __builtin_amdgcn_fence(__ATOMIC_ACQUIRE, "agent");
            asm volatile("s_waitcnt vmcnt(0)" ::: "memory");
        }
    }
    __syncthreads();
}

__device__ __forceinline__ void wave_arrive(volatile LAS unsigned* wcnt, unsigned* xcnt, unsigned nloc, unsigned* top) {
    asm volatile("s_waitcnt vmcnt(0)" ::: "memory");
    if (lane_now() == 0) {
        const unsigned o = __hip_atomic_fetch_add((LAS unsigned*)wcnt, 1u, __ATOMIC_RELAXED, __HIP_MEMORY_SCOPE_WORKGROUP);
        if (o == (unsigned)NWAVES - 1u) {
            *wcnt = 0u;
            const unsigned old = xb_add(xcnt, 1u);
            if (old + 1u == nloc) {
                __builtin_amdgcn_fence(__ATOMIC_RELEASE, "agent");
                asm volatile("s_waitcnt vmcnt(0)" ::: "memory");
                (void)xb_add(top, nloc);
            }
        }
    }
}
__device__ __forceinline__ void wg_wait_count(unsigned* ctr, unsigned target, unsigned* bar) {
    if (threadIdx.x == 0) {
        XB_SPIN(xb_ld(ctr) < target, bar);
        __builtin_amdgcn_fence(__ATOMIC_ACQUIRE, "agent");
        asm volatile("s_waitcnt vmcnt(0)" ::: "memory");
    }
    __syncthreads();
}

struct Frame {
    LAS unsigned char* lds; volatile LAS unsigned* MISC; gu32* ctl;
    int tid, lane, wave, vcu, G;
    const float *x, *norm1_w, *w_in, *gn_w, *conv_w, *w_o, *norm2_w, *rg_w, *rg_b, *re_w, *re_b, *w_gate, *w_up, *w_down, *fin_w;
    float* out; unsigned char* ws;
};
__device__ __forceinline__ float wave_sum(float v) {
#pragma unroll
    for (int o = 1; o < 64; o <<= 1) v += __shfl_xor(v, o);
    return v;
}

__device__ __forceinline__ int win_srccol(int c) {
    const int tile = c >> 8, bj = (c >> 7) & 1, p = c & 127;
    if (tile < 4) { const int head = (tile & 1) * 2 + bj; const int orig = 4 * (p >> 3) + (p & 3) + 64 * ((p >> 2) & 1); return (tile >> 1) * RW + head * HD + orig; }
    if (tile < 10) return 1024 + (c - 1024);
    const int t = tile - 10; return (bj ? 3072 : 2560) + 128 * t + p;
}
__device__ __forceinline__ void p0_transpose_item(const float* W, int ldw, int srccol, bf16* WT0, int Kd, int k0, const float* scale, LAS float* scr, int lane) {
    const int dn = 4 * (lane & 7), kr = lane >> 3;
    f32x4 v[8];
#pragma unroll
    for (int i = 0; i < 8; ++i) v[i] = *(const GAS f32x4*)(W + (size_t)(k0 + 8 * i + kr) * ldw + srccol);
#pragma unroll
    for (int i = 0; i < 8; ++i) { LAS float* s = scr + (8 * i + kr) * 33 + dn; s[0] = v[i].x; s[1] = v[i].y; s[2] = v[i].z; s[3] = v[i].w; }
    LDS_WAIT(); asm volatile("" ::: "memory");
    const int c = lane & 7;
    f32x4 s0 = (f32x4){1.f, 1.f, 1.f, 1.f}, s1 = s0;
    if (scale) { s0 = *(const GAS f32x4*)(scale + k0 + 8 * c); s1 = *(const GAS f32x4*)(scale + k0 + 8 * c + 4); }
#pragma unroll
    for (int j = 0; j < 4; ++j) { const int n = (lane >> 3) + 8 * j; const LAS float* s = scr + (8 * c) * 33 + n;
        v4u o; o.x = pk2(s[0 * 33] * s0.x, s[1 * 33] * s0.y); o.y = pk2(s[2 * 33] * s0.z, s[3 * 33] * s0.w); o.z = pk2(s[4 * 33] * s1.x, s[5 * 33] * s1.y); o.w = pk2(s[6 * 33] * s1.z, s[7 * 33] * s1.w);
        *(GAS v4u*)(WT0 + (size_t)n * Kd + k0 + 8 * c) = o; }
    LDS_WAIT(); asm volatile("" ::: "memory");
}
__device__ __forceinline__ void rms_row_to_bf16(const float* xrow, const float* w, bf16* orow, int lane) {
    const GAS f32x4* xr = (const GAS f32x4*)xrow + lane;
    f32x4 v[4]; float s = 0.f;
#pragma unroll
    for (int j = 0; j < 4; ++j) { v[j] = xr[64 * j]; s += (v[j].x * v[j].x + v[j].y * v[j].y) + (v[j].z * v[j].z + v[j].w * v[j].w); }
    const float rs = 1.f / sqrtf(wave_sum(s) * (1.f / D) + EPS);
    GAS unsigned long long* o8 = (GAS unsigned long long*)orow + lane;
#pragma unroll
    for (int j = 0; j < 4; ++j) { const f32x4 ww = ((const GAS f32x4*)w)[lane + 64 * j];
        o8[64 * j] = (unsigned long long)pk2(v[j].x * rs * ww.x, v[j].y * rs * ww.y) | ((unsigned long long)pk2(v[j].z * rs * ww.z, v[j].w * rs * ww.w) << 32); }
}
__device__ __forceinline__ void rms_row2_to_bf16(const float* x0, const float* x1, const float* w, bf16* o0, bf16* o1, int lane) {
    const GAS f32x4* xr0 = (const GAS f32x4*)x0 + lane; const GAS f32x4* xr1 = (const GAS f32x4*)x1 + lane;
    f32x4 v0[4], v1[4]; float s0 = 0.f, s1 = 0.f;
#pragma unroll
    for (int j = 0; j < 4; ++j) v0[j] = xr0[64 * j];
#pragma unroll
    for (int j = 0; j < 4; ++j) v1[j] = xr1[64 * j];
#pragma unroll
    for (int j = 0; j < 4; ++j) { s0 += (v0[j].x * v0[j].x + v0[j].y * v0[j].y) + (v0[j].z * v0[j].z + v0[j].w * v0[j].w); s1 += (v1[j].x * v1[j].x + v1[j].y * v1[j].y) + (v1[j].z * v1[j].z + v1[j].w * v1[j].w); }
    const float r0 = 1.f / sqrtf(wave_sum(s0) * (1.f / D) + EPS), r1 = 1.f / sqrtf(wave_sum(s1) * (1.f / D) + EPS);
    GAS unsigned long long* p0 = (GAS unsigned long long*)o0 + lane; GAS unsigned long long* p1 = (GAS unsigned long long*)o1 + lane;
#pragma unroll
    for (int j = 0; j < 4; ++j) { const f32x4 ww = ((const GAS f32x4*)w)[lane + 64 * j];
        p0[64 * j] = (unsigned long long)pk2(v0[j].x * r0 * ww.x, v0[j].y * r0 * ww.y) | ((unsigned long long)pk2(v0[j].z * r0 * ww.z, v0[j].w * r0 * ww.w) << 32);
        p1[64 * j] = (unsigned long long)pk2(v1[j].x * r1 * ww.x, v1[j].y * r1 * ww.y) | ((unsigned long long)pk2(v1[j].z * r1 * ww.z, v1[j].w * r1 * ww.w) << 32); }
}
__device__ __forceinline__ void p0_prologue(Frame& F) {
    LAS float* scr = (LAS float*)(F.lds + RING_OFF + F.wave * 16384);
    const int gw = F.vcu * NWAVES + F.wave, NGW = F.G * NWAVES, lane = F.lane;
    bf16* WinT = (bf16*)(F.ws + WS_WINT); bf16* WoT = (bf16*)(F.ws + WS_WOT);
    constexpr int I_IN = (D / 64) * (INC / 32), I_O = (D / 64) * (D / 32);
    constexpr int NITEMS = I_IN + I_O;
    for (int it = gw; it < NITEMS; it += NGW) {
        int r = it;
        if (r < I_IN) { const int nb = r % (INC / 32), kb = r / (INC / 32); const int n0 = 32 * nb;
            p0_transpose_item(F.w_in, INC, win_srccol(n0 + 4 * (lane & 7)), WinT + (size_t)n0 * D, D, 64 * kb, nullptr, scr, lane); continue; }
        r -= I_IN;
        { const int nb = r % (D / 32), kb = r / (D / 32); const int n0 = 32 * nb;
            p0_transpose_item(F.w_o, D, n0 + 4 * (lane & 7), WoT + (size_t)n0 * D, D, 64 * kb, nullptr, scr, lane); }
    }
    for (int idx = F.vcu * 512 + F.tid; idx < M; idx += F.G * 512) ((float*)(F.ws + WS_SSQ))[idx] = 0.f;
    { bf16* WrT = (bf16*)(F.ws + WS_WRT);
      for (int idx = F.vcu * 512 + F.tid; idx < 128 * D; idx += F.G * 512) {
          const int n = idx >> 10, k = idx & 1023; float v = 0.f;
          if (n < 8) v = F.rg_w[k * NG + n];
          else if (n < 72) { const int gg = (n - 8) >> 3, ee = (n - 8) & 7; v = F.re_w[((size_t)gg * D + k) * EPG + ee]; }
          WrT[idx] = (bf16)f2bf(v); } }
    bf16* XN = (bf16*)(F.ws + WS_XN);
    static_assert(M % 2 == 0, "row pairs");
    for (int m = gw; m < M / 2; m += NGW) rms_row2_to_bf16(F.x + (size_t)m * D, F.x + (size_t)(m + M / 2) * D, F.norm1_w, XN + (size_t)m * D, XN + (size_t)(m + M / 2) * D, lane);
    float* rc = (float*)(F.ws + WS_ROPE); float* rsn = rc + SEQ * 64;
    for (int idx = F.vcu * 512 + F.tid; idx < SEQ * 64; idx += F.G * 512) {
        const int i = idx & 63, pos = idx >> 6;
        const float inv = (float)exp2(-(double)i * (13.287712379549449 / 64.0));
        const float ang = (float)pos * inv;
        const double rev = (double)ang * 0.15915494309189535;
        const float fr = (float)(rev - floor(rev));
        rc[idx] = __builtin_amdgcn_cosf(fr); rsn[idx] = __builtin_amdgcn_sinf(fr);
    }
}

struct InProjSched {
    int c, G; const void* Wb0; const void* Wb1; unsigned Wbytes;
    __device__ __forceinline__ bool next(int i, pg8::Unit& u) const {
        constexpr int nM = M / 256, nN = INC / 256, nwg = nM * nN;
        const int L = i * G + c; if (L >= nwg) return false;
        int wgid = L; { const int q = nwg / 8, r = nwg % 8, xcd = wgid % 8, off = wgid / 8; wgid = (xcd < r ? xcd * (q + 1) : r * (q + 1) + (xcd - r) * q) + off; }
        const int nig = 8 * nN, gid = wgid / nig, fm = gid * 8;
        u.pm = fm + ((wgid % nig) % 8); u.pn = (wgid % nig) / 8; u.arow0 = u.pm * 256; u.e = i; u.rb = 0; u.nvalid = 256;
        u.B = (unsigned)u.pn * (256u * D * 2u); u.B1 = u.B; return true;
    }
    __device__ __forceinline__ int arow(const pg8::Unit&, int) const { return 0; }
};
struct EpiInProj {
    static constexpr bool PERM = true;
    bf16* base; const float *rc, *rs; unsigned *xc1, *top1; volatile LAS unsigned* misc;
    __device__ __forceinline__ void operator()(const f32x4 (&acc)[2][2][4][2], const pg8::Unit& u, int wr, int wc, int fr, int fq) const {
        const int row0 = u.pm * 256 + wr * 64 + fr; const int pn = u.pn;
        if (pn < 4) {
            bf16* dst = base + (size_t)(pn >> 1) * (8u << 20); const float sc = (pn < 2) ? 0.08838834764831845f : 1.0f;
            const int i0 = 4 * (4 * wc + fq);
#pragma unroll
            for (int ai = 0; ai < 2; ++ai)
#pragma unroll
                for (int m = 0; m < 4; ++m) { const int r = row0 + ai * 128 + m * 16; const int pos = r & (SEQ - 1);
                    const f32x4 cs = *(const f32x4*)(rc + pos * 64 + i0), sn = *(const f32x4*)(rs + pos * 64 + i0);
#pragma unroll
                    for (int bj = 0; bj < 2; ++bj) { const f32x4 x1 = acc[ai][bj][m][0], x2 = acc[ai][bj][m][1];
                        const f32x4 o1 = (x1 * cs - x2 * sn) * sc, o2 = (x2 * cs + x1 * sn) * sc;
                        v4u w; w.x = cvt_pk_bf16(o1[0], o1[1]); w.y = cvt_pk_bf16(o1[2], o1[3]); w.z = cvt_pk_bf16(o2[0], o2[1]); w.w = cvt_pk_bf16(o2[2], o2[3]);
                        *(v4u*)(dst + (size_t)r * RW + ((pn & 1) * 2 + bj) * HD + wc * 32 + 8 * fq) = w; } }
        } else if (pn < 10) {
            bf16* dst = base + (size_t)(pn >> 1) * (8u << 20);
#pragma unroll
            for (int ai = 0; ai < 2; ++ai)
#pragma unroll
                for (int m = 0; m < 4; ++m) { const int r = row0 + ai * 128 + m * 16;
#pragma unroll
                    for (int bj = 0; bj < 2; ++bj) { const f32x4 v0 = acc[ai][bj][m][0], v1 = acc[ai][bj][m][1];
                        v4u w; w.x = cvt_pk_bf16(v0[0], v0[1]); w.y = cvt_pk_bf16(v0[2], v0[3]); w.z = cvt_pk_bf16(v1[0], v1[1]); w.w = cvt_pk_bf16(v1[2], v1[3]);
                        *(v4u*)(dst + (size_t)r * RW + (pn & 1) * 256 + bj * 128 + wc * 32 + 8 * fq) = w; } }
        } else {
            const int t = pn - 10; bf16* cub = base + (size_t)5 * (8u << 20);
#pragma unroll
            for (int ai = 0; ai < 2; ++ai)
#pragma unroll
                for (int m = 0; m < 4; ++m) { const int r = row0 + ai * 128 + m * 16;
                    const f32x4 v0 = acc[ai][0][m][0] * acc[ai][1][m][0], v1 = acc[ai][0][m][1] * acc[ai][1][m][1];
                    v4u w; w.x = cvt_pk_bf16(v0[0], v0[1]); w.y = cvt_pk_bf16(v0[2], v0[3]); w.z = cvt_pk_bf16(v1[0], v1[1]); w.w = cvt_pk_bf16(v1[2], v1[3]);
                    *(v4u*)(cub + (size_t)r * RW + t * 128 + wc * 32 + 8 * fq) = w; }
        }
        if (u.e == 1) wave_arrive(misc + 12, xc1, misc[8], top1);
    }
};


typedef short s16x4 __attribute__((ext_vector_type(4)));
typedef short v4i16_t __attribute__((ext_vector_type(4)));
__device__ __forceinline__ unsigned offb(unsigned row, unsigned ch) { return 256u * row + 16u * (ch ^ (((row & 3u) << 2) | ((row >> 2) & 3u))); }
__device__ __forceinline__ bf16x8 tr_frag(const LAS unsigned char* img, int lane, int c, int ks) {
    const unsigned g = lane >> 4, q = (lane & 15) >> 2, p = lane & 3;
    const unsigned a0 = offb(32 * ks + 8 * g + q, 2 * c + (p >> 1)) + 8 * (p & 1), a1 = offb(32 * ks + 8 * g + 4 + q, 2 * c + (p >> 1)) + 8 * (p & 1);
    const s16x4 lo = __builtin_bit_cast(s16x4, __builtin_amdgcn_ds_read_tr16_b64_v4i16((LAS v4i16_t*)(img + a0)));
    const s16x4 hi = __builtin_bit_cast(s16x4, __builtin_amdgcn_ds_read_tr16_b64_v4i16((LAS v4i16_t*)(img + a1)));
    return (bf16x8){lo[0], lo[1], lo[2], lo[3], hi[0], hi[1], hi[2], hi[3]};
}
__device__ __forceinline__ bf16x8 row_frag(const LAS unsigned char* img, int lane, int rb, int s) { return *(const LAS bf16x8*)(img + offb((lane & 15) + 16 * rb, 4 * s + (lane >> 4))); }
__device__ __forceinline__ float lg2_gamma(int h) { return log2f(1.0f - exp2f(-5.0f - (float)h)); }
__device__ __forceinline__ float silu_f(float g) { return g * __builtin_amdgcn_rcpf(1.0f + __expf(-g)); }

__device__ __forceinline__ void tile_load(v4u (&r)[4], const bf16* base, size_t row_stride, int tid) {
#pragma unroll
    for (int i = 0; i < 4; ++i) { const int id = tid + 512 * i, row = id >> 4, ch = id & 15; r[i] = *(const GAS v4u*)(base + (size_t)row * row_stride + 8 * ch); }
}
template <bool KSCALE>
__device__ __forceinline__ void tile_write(const v4u (&r)[4], LAS unsigned char* img, int tid, float lg2) {
#pragma unroll
    for (int i = 0; i < 4; ++i) { const int id = tid + 512 * i, row = id >> 4, ch = id & 15; v4u kv = r[i];
        if (KSCALE) { const float kd = exp2f((float)(CH - 1 - row) * lg2);
            kv.x = pk2(bflo(kv.x) * kd, bfhi(kv.x) * kd); kv.y = pk2(bflo(kv.y) * kd, bfhi(kv.y) * kd); kv.z = pk2(bflo(kv.z) * kd, bfhi(kv.z) * kd); kv.w = pk2(bflo(kv.w) * kd, bfhi(kv.w) * kd); }
        *(LAS v4u*)(img + offb(row, ch)) = kv; }
}
__device__ __forceinline__ void p2_kv_phase(Frame& F, const int u0, const int ustride) {
    bf16* KVT = (bf16*)(F.ws + WS_KVT);
    const bf16* kb = (const bf16*)(F.ws + WS_KB); const bf16* vb = (const bf16*)(F.ws + WS_VB);
    LAS unsigned char* Kimg = F.lds; LAS unsigned char* Vimg = F.lds + 32768;
    const int lane = F.lane, w = F.wave, g = lane >> 4, fr = lane & 15, tid = F.tid;
    LAS unsigned char* stg = F.lds + 65536 + 4096 * w;
    v4u rk[4], rv[4];
    int u = u0;
    if (u < NB * NCH * NH) { const int h = u & 3, n = (u >> 2) & 31, b = u >> 7; const size_t row0 = (size_t)b * SEQ + (size_t)n * CH;
        tile_load(rk, kb + row0 * RW + h * HD, RW, tid); tile_load(rv, vb + row0 * RW + h * HD, RW, tid); }
    for (; u < NB * NCH * NH; u += ustride) {
        const int h = u & 3;
        tile_write<true>(rk, Kimg, tid, lg2_gamma(h)); tile_write<false>(rv, Vimg, tid, 0.f);
        __syncthreads();
        { const int u2 = u + ustride; if (u2 < NB * NCH * NH) { const int h2 = u2 & 3, n2 = (u2 >> 2) & 31, b2 = u2 >> 7; const size_t r2 = (size_t)b2 * SEQ + (size_t)n2 * CH;
            tile_load(rk, kb + r2 * RW + h2 * HD, RW, tid); tile_load(rv, vb + r2 * RW + h2 * HD, RW, tid); } }
        bf16x8 af[4];
#pragma unroll
        for (int ks = 0; ks < 4; ++ks) af[ks] = tr_frag(Vimg, lane, w, ks);
#pragma unroll
        for (int cd = 0; cd < 8; ++cd) {
            f32x4 acc = (f32x4){0.f, 0.f, 0.f, 0.f};
#pragma unroll
            for (int ks = 0; ks < 4; ++ks) acc = __builtin_amdgcn_mfma_f32_16x16x32_bf16(af[ks], tr_frag(Kimg, lane, cd, ks), acc, 0, 0, 0);
#pragma unroll
            for (int r = 0; r < 4; ++r) ((LAS bf16*)stg)[(4 * g + r) * HD + 16 * cd + fr] = (bf16)f2bf(acc[r]);
        }
        LDS_WAIT();
#pragma unroll
        for (int k = 0; k < 4; ++k) { const int id = lane + 64 * k, row = id >> 4, ch = id & 15;
            *(GAS v4u*)(KVT + (size_t)u * (HD * HD) + (size_t)(16 * w + row) * HD + 8 * ch) = *(const LAS v4u*)(stg + row * 256 + ch * 16); }
        __syncthreads();
    }
}
__device__ __forceinline__ void p3_scan_phase(Frame& F, const int u0, const int ustride) {
    const bf16* KVT = (const bf16*)(F.ws + WS_KVT); bf16* prevT = (bf16*)(F.ws + WS_PREVT);
    for (int idx = u0 * 512 + F.tid; idx < NB * NH * HD * HD / 4; idx += ustride * 512) {
        const int de4 = idx & 4095, h = (idx >> 12) & 3, b = idx >> 14;
        const float cd = exp2f((float)CH * lg2_gamma(h));
        float s0 = 0.f, s1 = 0.f, s2 = 0.f, s3 = 0.f;
#pragma unroll 8
        for (int n = 0; n < NCH; ++n) {
            const size_t o = (size_t)((b * NCH + n) * NH + h) * (HD * HD) + 4 * de4;
            const v2u kvv = *(const GAS v2u*)(KVT + o);
            v2u pw; pw.x = pk2(s0, s1); pw.y = pk2(s2, s3);
            *(GAS v2u*)(prevT + o) = pw;
            s0 = cd * s0 + bflo(kvv.x); s1 = cd * s1 + bfhi(kvv.x); s2 = cd * s2 + bflo(kvv.y); s3 = cd * s3 + bfhi(kvv.y);
        }
    }
}
__device__ __forceinline__ void p4_retout_phase(Frame& F) {
    const bf16* qb = (const bf16*)(F.ws + WS_QB); const bf16* gbuf = (const bf16*)(F.ws + WS_GB); const bf16* prevT = (const bf16*)(F.ws + WS_PREVT);
    const bf16* kb = (const bf16*)(F.ws + WS_KB); const bf16* vb = (const bf16*)(F.ws + WS_VB);
    bf16* mixb = (bf16*)(F.ws + WS_MIXB);
    LAS unsigned char* Kimg = F.lds; LAS unsigned char* Vimg = F.lds + 32768; LAS unsigned char* Simg = F.lds + 65536;
    const int lane = F.lane, w = F.wave, g = lane >> 4, fr = lane & 15, tid = F.tid;
    LAS unsigned char* Pimg = F.lds + 98304 + 4096 * w;
    v4u rk[4], rv[4], rp[4], gvr[4];
    bf16x8 qf[4], qn[4];
    int u = blockIdx.x;
    if (u < NB * NCH * NH) { const int h = u & 3, n = (u >> 2) & 31, b = u >> 7; const size_t row0 = (size_t)b * SEQ + (size_t)n * CH;
        tile_load(rk, kb + row0 * RW + h * HD, RW, tid); tile_load(rv, vb + row0 * RW + h * HD, RW, tid); tile_load(rp, prevT + (size_t)u * (HD * HD), HD, tid);
#pragma unroll
        for (int s = 0; s < 4; ++s) qf[s] = *(const GAS bf16x8*)(qb + (row0 + 16 * w + fr) * RW + h * HD + 32 * s + 8 * g); }
    for (; u < NB * NCH * NH; u += F.G) {
        const int h = u & 3, n = (u >> 2) & 31, b = u >> 7; const size_t row0 = (size_t)b * SEQ + (size_t)n * CH;
        const float lg2 = lg2_gamma(h);
        tile_write<false>(rk, Kimg, tid, 0.f); tile_write<false>(rv, Vimg, tid, 0.f); tile_write<false>(rp, Simg, tid, 0.f);
        const int i0 = 16 * w;
        __syncthreads();
#pragma unroll
        for (int k = 0; k < 4; ++k) { const int id = lane + 64 * k, row = id >> 4, ch = id & 15; gvr[k] = *(const GAS v4u*)(gbuf + (row0 + i0 + row) * RW + h * HD + 8 * ch); }
        { const int u2 = u + F.G; if (u2 < NB * NCH * NH) { const int h2 = u2 & 3, n2 = (u2 >> 2) & 31, b2 = u2 >> 7; const size_t r2 = (size_t)b2 * SEQ + (size_t)n2 * CH;
            tile_load(rk, kb + r2 * RW + h2 * HD, RW, tid); tile_load(rv, vb + r2 * RW + h2 * HD, RW, tid); tile_load(rp, prevT + (size_t)u2 * (HD * HD), HD, tid);
#pragma unroll
            for (int s = 0; s < 4; ++s) qn[s] = *(const GAS bf16x8*)(qb + (r2 + i0 + fr) * RW + h2 * HD + 32 * s + 8 * g); } }
        const int njt = (w | 1) + 1;
        for (int jt = 0; jt < njt; ++jt) {
            f32x4 acc = (f32x4){0.f, 0.f, 0.f, 0.f};
#pragma unroll
            for (int s = 0; s < 4; ++s) acc = __builtin_amdgcn_mfma_f32_16x16x32_bf16(row_frag(Kimg, lane, jt, s), qf[s], acc, 0, 0, 0);
            const int i = i0 + fr, jb = 16 * jt + 4 * g;
            float pv[4];
#pragma unroll
            for (int r = 0; r < 4; ++r) { const int j = jb + r; const float v = acc[r] * exp2f((float)(i - j) * lg2); pv[r] = (i >= j) ? v : 0.f; }
            v2u w2; w2.x = pk2(pv[0], pv[1]); w2.y = pk2(pv[2], pv[3]);
            *(LAS v2u*)(Pimg + offb(fr, 2 * jt + (g >> 1)) + 8 * (g & 1)) = w2;
        }
        LDS_WAIT();
        float qd[4];
#pragma unroll
        for (int r = 0; r < 4; ++r) qd[r] = exp2f((float)(i0 + 4 * g + r + 1) * lg2);
        const int ksmax = w >> 1;
        f32x4 o[8];
#pragma unroll
        for (int et = 0; et < 8; ++et) {
            f32x4 acc = (f32x4){0.f, 0.f, 0.f, 0.f};
#pragma unroll
            for (int s = 0; s < 4; ++s) acc = __builtin_amdgcn_mfma_f32_16x16x32_bf16(qf[s], row_frag(Simg, lane, et, s), acc, 0, 0, 0);
#pragma unroll
            for (int r = 0; r < 4; ++r) acc[r] *= qd[r];
            for (int ks = 0; ks <= ksmax; ++ks) acc = __builtin_amdgcn_mfma_f32_16x16x32_bf16(row_frag(Pimg, lane, 0, ks), tr_frag(Vimg, lane, et, ks), acc, 0, 0, 0);
            o[et] = acc;
        }
        float mu[4], rstd[4];
#pragma unroll
        for (int r = 0; r < 4; ++r) { float sm = 0.f;
#pragma unroll
            for (int et = 0; et < 8; ++et) sm += o[et][r];
            sm += __shfl_xor(sm, 1); sm += __shfl_xor(sm, 2); sm += __shfl_xor(sm, 4); sm += __shfl_xor(sm, 8);
            mu[r] = sm * (1.0f / HD); float q2 = 0.f;
#pragma unroll
            for (int et = 0; et < 8; ++et) { const float d = o[et][r] - mu[r]; q2 += d * d; }
            q2 += __shfl_xor(q2, 1); q2 += __shfl_xor(q2, 2); q2 += __shfl_xor(q2, 4); q2 += __shfl_xor(q2, 8);
            rstd[r] = 1.0f / sqrtf(q2 * (1.0f / HD) + EPS); }
        LDS_WAIT();
        LAS bf16* stg = (LAS bf16*)Pimg;
#pragma unroll
        for (int et = 0; et < 8; ++et) { const float gw = F.gn_w[h * HD + 16 * et + fr];
#pragma unroll
            for (int r = 0; r < 4; ++r) stg[(4 * g + r) * HD + 16 * et + fr] = (bf16)f2bf((o[et][r] - mu[r]) * rstd[r] * gw); }
        LDS_WAIT();
#pragma unroll
        for (int k = 0; k < 4; ++k) {
            const int id = lane + 64 * k, row = id >> 4, ch = id & 15;
            const v4u yv = *(const LAS v4u*)(Pimg + row * 256 + ch * 16);
            const size_t grow = row0 + i0 + row;
            const v4u gv = gvr[k];
            v4u ov;
            ov.x = pk2(silu_f(bflo(gv.x)) * bflo(yv.x), silu_f(bfhi(gv.x)) * bfhi(yv.x)); ov.y = pk2(silu_f(bflo(gv.y)) * bflo(yv.y), silu_f(bfhi(gv.y)) * bfhi(yv.y));
            ov.z = pk2(silu_f(bflo(gv.z)) * bflo(yv.z), silu_f(bfhi(gv.z)) * bfhi(yv.z)); ov.w = pk2(silu_f(bflo(gv.w)) * bflo(yv.w), silu_f(bfhi(gv.w)) * bfhi(yv.w));
            *(GAS v4u*)(mixb + grow * D + h * HD + 8 * ch) = ov;
        }
#pragma unroll
        for (int s = 0; s < 4; ++s) qf[s] = qn[s];
        __syncthreads();
    }
    const bf16* gbb = (const bf16*)(F.ws + WS_GBB); const bf16* cub = (const bf16*)(F.ws + WS_CUB);
    for (int id = blockIdx.x * 512 + F.tid; id < M * 64; id += F.G * 512) {
        const int row = id >> 6, ch = id & 63, t = row & (SEQ - 1);
        const v4u c2 = *(const GAS v4u*)(cub + (size_t)row * CW + 8 * ch);
        v4u c1 = (v4u){0u, 0u, 0u, 0u}, c0 = c1;
        if (t >= 1) c1 = *(const GAS v4u*)(cub + (size_t)(row - 1) * CW + 8 * ch);
        if (t >= 2) c0 = *(const GAS v4u*)(cub + (size_t)(row - 2) * CW + 8 * ch);
        const v4u gv = *(const GAS v4u*)(gbb + (size_t)row * CW + 8 * ch);
        float wk[3][8];
#pragma unroll
        for (int k = 0; k < 3; ++k) { const f32x4 a = *(const GAS f32x4*)(F.conv_w + k * CW + 8 * ch), bq = *(const GAS f32x4*)(F.conv_w + k * CW + 8 * ch + 4);
            wk[k][0] = a.x; wk[k][1] = a.y; wk[k][2] = a.z; wk[k][3] = a.w; wk[k][4] = bq.x; wk[k][5] = bq.y; wk[k][6] = bq.z; wk[k][7] = bq.w; }
        const unsigned c0a[4] = {c0.x, c0.y, c0.z, c0.w}, c1a[4] = {c1.x, c1.y, c1.z, c1.w}, c2a[4] = {c2.x, c2.y, c2.z, c2.w}, ga[4] = {gv.x, gv.y, gv.z, gv.w};
        unsigned oa[4];
#pragma unroll
        for (int x = 0; x < 4; ++x) {
            const float lo = bflo(ga[x]) * (wk[0][2 * x] * bflo(c0a[x]) + wk[1][2 * x] * bflo(c1a[x]) + wk[2][2 * x] * bflo(c2a[x]));
            const float hi = bfhi(ga[x]) * (wk[0][2 * x + 1] * bfhi(c0a[x]) + wk[1][2 * x + 1] * bfhi(c1a[x]) + wk[2][2 * x + 1] * bfhi(c2a[x]));
            oa[x] = pk2(lo, hi); }
        *(GAS v4u*)(mixb + (size_t)row * D + RW + 8 * ch) = (v4u){oa[0], oa[1], oa[2], oa[3]};
    }
}

struct OutProjSched {
    int c, G; const void* Wb0; const void* Wb1; unsigned Wbytes;
    __device__ __forceinline__ bool next(int i, pg8::Unit& u) const {
        constexpr int nN = D / 256, nwg = (M / 256) * nN;
        const int L = i * G + c; if (L >= nwg) return false;
        const int wgid = (L % 8) * (nwg / 8) + L / 8;
        const int nig = 8 * nN, gid = wgid / nig, fm = gid * 8;
        u.pm = fm + ((wgid % nig) % 8); u.pn = (wgid % nig) / 8; u.arow0 = u.pm * 256; u.e = 0; u.rb = 0; u.nvalid = 256;
        u.B = (unsigned)u.pn * (256u * D * 2u); u.B1 = u.B; return true;
    }
    __device__ __forceinline__ int arow(const pg8::Unit&, int) const { return 0; }
};
struct EpiOutProj {
    static constexpr bool PERM = true;
    const float* x; const float* nw2; bf16* xn2; float* ssq;
    __device__ __forceinline__ void operator()(const f32x4 (&acc)[2][2][4][2], const pg8::Unit& u, int wr, int wc, int fr, int fq) const {
        const int row0 = u.pm * 256 + wr * 64 + fr, col0 = u.pn * 256 + wc * 32 + 8 * fq;
        f32x4 nwv[2][2];
#pragma unroll
        for (int bj = 0; bj < 2; ++bj) { nwv[bj][0] = *(const f32x4*)(nw2 + col0 + bj * 128); nwv[bj][1] = *(const f32x4*)(nw2 + col0 + bj * 128 + 4); }
#pragma unroll
        for (int ai = 0; ai < 2; ++ai)
#pragma unroll
            for (int m = 0; m < 4; ++m) { const size_t r = (size_t)(row0 + ai * 128 + m * 16); float ss = 0.f;
#pragma unroll
                for (int bj = 0; bj < 2; ++bj) { const size_t o = r * D + col0 + bj * 128;
                    const f32x4 v0 = acc[ai][bj][m][0] + *(const f32x4*)(x + o), v1 = acc[ai][bj][m][1] + *(const f32x4*)(x + o + 4);
                    ss += (v0[0] * v0[0] + v0[1] * v0[1]) + (v0[2] * v0[2] + v0[3] * v0[3]) + (v1[0] * v1[0] + v1[1] * v1[1]) + (v1[2] * v1[2] + v1[3] * v1[3]);
                    const f32x4 s0 = v0 * nwv[bj][0], s1 = v1 * nwv[bj][1];
                    v4u w; w.x = cvt_pk_bf16(s0[0], s0[1]); w.y = cvt_pk_bf16(s0[2], s0[3]); w.z = cvt_pk_bf16(s1[0], s1[1]); w.w = cvt_pk_bf16(s1[2], s1[3]);
                    *(v4u*)(xn2 + o) = w; }
                ss += __shfl_xor(ss, 16); ss += __shfl_xor(ss, 32);
                if (fq == 0) atomicAdd(ssq + r, ss); }
    }
};

__device__ __forceinline__ void p6_router_phase(Frame& F) {
    const bf16* xn2 = (const bf16*)(F.ws + WS_XN); const bf16* WrT = (const bf16*)(F.ws + WS_WRT);
    int* cnt = (int*)(F.ws + WS_CTL) + CW_CNT; int* tokl = (int*)(F.ws + WS_TOKL); float* rsl = (float*)(F.ws + WS_RSL); float* gatel = (float*)(F.ws + WS_GATEL);
    const float* ssq = (const float*)(F.ws + WS_SSQ);
    const int lane = F.lane, w = F.wave, g = lane >> 4, fr = lane & 15;
    constexpr int LS = 84;
    LAS float* slab = (LAS float*)F.lds + (w & 3) * (64 * LS);
    if (w == 0) { ((LAS int*)(F.lds + 4 * 64 * LS * 4))[lane] = 0; LDS_WAIT(); }
    for (int cb = (int)blockIdx.x; cb < M / 64; cb += F.G) {
        f32x4 acc[4][5];
#pragma unroll
        for (int rb = 0; rb < 4; ++rb)
#pragma unroll
            for (int t = 0; t < 5; ++t) acc[rb][t] = (f32x4){0.f, 0.f, 0.f, 0.f};
        const bf16* arow = xn2 + (size_t)(64 * cb + fr) * D + 128 * w + 8 * g;
        const bf16* brow = WrT + (size_t)fr * D + 128 * w + 8 * g;
#pragma unroll
        for (int s4 = 0; s4 < 4; ++s4) {
            bf16x8 bfr[5];
#pragma unroll
            for (int t = 0; t < 5; ++t) bfr[t] = *(const GAS bf16x8*)(brow + (size_t)(16 * t) * D + 32 * s4);
#pragma unroll
            for (int rb = 0; rb < 4; ++rb) { const bf16x8 a = *(const GAS bf16x8*)(arow + (size_t)(16 * rb) * D + 32 * s4);
#pragma unroll
                for (int t = 0; t < 5; ++t) acc[rb][t] = __builtin_amdgcn_mfma_f32_16x16x32_bf16(a, bfr[t], acc[rb][t], 0, 0, 0); }
        }
        if (w < 4) {
#pragma unroll
            for (int rb = 0; rb < 4; ++rb)
#pragma unroll
                for (int t = 0; t < 5; ++t)
#pragma unroll
                    for (int r = 0; r < 4; ++r) slab[(16 * rb + 4 * g + r) * LS + 16 * t + fr] = acc[rb][t][r];
        }
        __syncthreads();
        if (w >= 4) {
#pragma unroll
            for (int rb = 0; rb < 4; ++rb)
#pragma unroll
                for (int t = 0; t < 5; ++t)
#pragma unroll
                    for (int r = 0; r < 4; ++r) { LAS float* p = slab + (16 * rb + 4 * g + r) * LS + 16 * t + fr; *p = *p + acc[rb][t][r]; }
        }
        __syncthreads();
        if (w == 0) {
            const int tok = 64 * cb + lane;
            const LAS float* L0 = (const LAS float*)F.lds + lane * LS;
            const float rs = 1.0f / sqrtf(ssq[tok] * (1.0f / D) + EPS);
            float gl[8];
#pragma unroll
            for (int n = 0; n < 8; ++n) gl[n] = (((L0[n] + L0[64 * LS + n]) + L0[2 * 64 * LS + n]) + L0[3 * 64 * LS + n]) * rs + F.rg_b[n];
            int gs = 0; float gm = gl[0];
#pragma unroll
            for (int n = 1; n < 8; ++n) if (gl[n] > gm) { gm = gl[n]; gs = n; }
            float den = 0.f;
#pragma unroll
            for (int n = 0; n < 8; ++n) den += __expf(gl[n] - gm);
            const float pg = 1.0f / den;
            float el[8];
#pragma unroll
            for (int e = 0; e < 8; ++e) { const int n = 8 + gs * 8 + e; el[e] = (((L0[n] + L0[64 * LS + n]) + L0[2 * 64 * LS + n]) + L0[3 * 64 * LS + n]) * rs + F.re_b[gs * EPG + e]; }
            int i1 = 0; float m1 = el[0];
#pragma unroll
            for (int e = 1; e < 8; ++e) if (el[e] > m1) { m1 = el[e]; i1 = e; }
            int i2 = 0; float m2 = -3.0e38f;
#pragma unroll
            for (int e = 0; e < 8; ++e) if (e != i1 && el[e] > m2) { m2 = el[e]; i2 = e; }
            const float rr = __expf(m2 - m1); const float w1 = 1.0f / (1.0f + rr), w2 = rr / (1.0f + rr);
            const int e1 = gs * EPG + i1, e2 = gs * EPG + i2;
            LAS int* hist = (LAS int*)(F.lds + 4 * 64 * LS * 4);
            const int l1 = __hip_atomic_fetch_add(hist + e1, 1, __ATOMIC_RELAXED, __HIP_MEMORY_SCOPE_WORKGROUP), l2 = __hip_atomic_fetch_add(hist + e2, 1, __ATOMIC_RELAXED, __HIP_MEMORY_SCOPE_WORKGROUP);
            LDS_WAIT(); asm volatile("" ::: "memory");
            { const int c = hist[lane]; int base = 0; if (c > 0) base = atomicAdd(cnt + lane * CNT_STRIDE, c); hist[64 + lane] = base; hist[lane] = 0; }
            LDS_WAIT(); asm volatile("" ::: "memory");
            const int r1 = hist[64 + e1] + l1, r2 = hist[64 + e2] + l2;
            tokl[e1 * M + r1] = tok * 2;     rsl[e1 * M + r1] = rs; gatel[e1 * M + r1] = pg * w1;
            tokl[e2 * M + r2] = tok * 2 + 1; rsl[e2 * M + r2] = rs; gatel[e2 * M + r2] = pg * w2;
        }
        __syncthreads();
    }
}

__device__ __forceinline__ const char* uniform_ptr(const char* p) {
    const unsigned long long v = (unsigned long long)p;
    const unsigned lo = __builtin_amdgcn_readfirstlane((unsigned)v), hi = __builtin_amdgcn_readfirstlane((unsigned)(v >> 32));
    return (const char*)(((unsigned long long)hi << 32) | lo);
}
struct MoeSched {
    int half;
    int wave; int c, G; int total, limit; const LAS int* tab;
    const void* Wb0; const void* Wb1; unsigned Wbytes; unsigned off1; unsigned estride; int colstep; int ldwb; const int* tokl;
    __device__ __forceinline__ void init(const int* cnt, int lane, LAS int* table) {
        const int my_cnt = __hip_atomic_load(cnt + lane * CNT_STRIDE, __ATOMIC_RELAXED, __HIP_MEMORY_SCOPE_AGENT), my_nb = (my_cnt + 255) >> 8;
        int v = my_nb;
#pragma unroll
        for (int o = 1; o < 64; o <<= 1) { const int t = __shfl_up(v, o); if (lane >= o) v += t; }
        table[lane] = 4 * (v - my_nb); table[64 + lane] = my_nb; table[128 + lane] = my_cnt; total = 4 * __builtin_amdgcn_readlane(v, 63); limit = (total / G) * G; tab = table;
    }
    __device__ __forceinline__ bool next(int i, pg8::Unit& u) const {
        const int j = i * G + c; int L, hf = 0;
        if (half) { if (j >= 2 * (total - limit)) return false; L = limit + (j >> 1); hf = j & 1; } else { if (j >= limit) return false; L = j; }
        int wgid = L; { const int q = total / 8, r = total % 8, xcd = wgid % 8, off = wgid / 8; wgid = (xcd < r ? xcd * (q + 1) : r * (q + 1) + (xcd - r) * q) + off; }
        const int ln = (int)__builtin_amdgcn_mbcnt_hi(~0u, __builtin_amdgcn_mbcnt_lo(~0u, 0u));
        const int my_b4 = tab[ln], my_nb = tab[64 + ln];
        const bool hit = (wgid >= my_b4) && (wgid < my_b4 + 4 * my_nb);
        const unsigned long long mk = __ballot(hit);
        const int e = __builtin_amdgcn_readfirstlane((int)__builtin_ctzll(mk));
        const int b4 = __builtin_amdgcn_readfirstlane(tab[e]), nb = __builtin_amdgcn_readfirstlane(tab[64 + e]), ce = __builtin_amdgcn_readfirstlane(tab[128 + e]);
        const int within = wgid - b4; u.pn = __builtin_amdgcn_readfirstlane(within / nb); const int blk = within - u.pn * nb;
        const int rows = half ? 128 : 256;
        u.e = e; u.rb = (blk << 8) + 128 * hf; u.pm = (b4 >> 2) + blk; u.arow0 = (u.pm << 8) + 128 * hf;
        int nv = ce - u.rb; nv = nv < 0 ? 0 : nv; u.nvalid = nv < rows ? nv : rows;
        u.B = (unsigned)e * estride + (unsigned)u.pn * (unsigned)colstep; u.B1 = u.B + off1; return true;
    }
    __device__ __forceinline__ int arow(const pg8::Unit& u, int rl) const { return rl < u.nvalid ? (tokl[u.e * M + u.rb + rl] >> 1) : 0; }
};
struct EpiMoe1 {
    bf16* hb; const float* rsl;
    __device__ __forceinline__ void operator()(const f32x4 (&acc)[2][4][2], const pg8::Unit& u, int wr, int wc, int fr, int fq) const {
#pragma unroll
        for (int m = 0; m < 4; ++m) { const int rl = wr * 64 + m * 16 + fr;
            const float rs = rsl[u.e * M + u.rb + rl];
            f32x4 v0, v1;
#pragma unroll
            for (int j = 0; j < 4; ++j) { v0[j] = silu_f(acc[0][m][0][j] * rs) * (acc[1][m][0][j] * rs); v1[j] = silu_f(acc[0][m][1][j] * rs) * (acc[1][m][1][j] * rs); }
            v4u w; w.x = cvt_pk_bf16(v0[0], v0[1]); w.y = cvt_pk_bf16(v0[2], v0[3]); w.z = cvt_pk_bf16(v1[0], v1[1]); w.w = cvt_pk_bf16(v1[2], v1[3]);
            *(v4u*)(hb + (size_t)(u.arow0 + rl) * FF + u.pn * 128 + wc * 32 + 8 * fq) = w; }
    }
};
struct EpiMoe2 {
    bf16* yb; const int* tokl; const float* gatel;
    __device__ __forceinline__ void operator()(const f32x4 (&acc)[2][4][2], const pg8::Unit& u, int wr, int wc, int fr, int fq) const {
#pragma unroll
        for (int m = 0; m < 4; ++m) { const int rl = wr * 64 + m * 16 + fr;
            if (rl < u.nvalid) {
                const int dst = tokl[u.e * M + u.rb + rl]; const float gt = gatel[u.e * M + u.rb + rl];
#pragma unroll
                for (int bj = 0; bj < 2; ++bj) { const f32x4 v0 = acc[bj][m][0] * gt, v1 = acc[bj][m][1] * gt;
                    v4u w; w.x = cvt_pk_bf16(v0[0], v0[1]); w.y = cvt_pk_bf16(v0[2], v0[3]); w.z = cvt_pk_bf16(v1[0], v1[1]); w.w = cvt_pk_bf16(v1[2], v1[3]);
                    *(v4u*)(yb + (size_t)dst * D + u.pn * 256 + bj * 128 + wc * 32 + 8 * fq) = w; } } }
    }
};

struct EpiMoe1W {
    bf16* hb; const float* rsl;
    __device__ __forceinline__ void operator()(const f32x4 (&acc)[2][2][4][2], const pg8::Unit& u, int wr, int wc, int fr, int fq) const {
#pragma unroll
        for (int ai = 0; ai < 2; ++ai)
#pragma unroll
            for (int m = 0; m < 4; ++m) { const int rl = ai * 128 + wr * 64 + m * 16 + fr;
                const float rs = rsl[u.e * M + u.rb + rl];
                f32x4 v0, v1;
#pragma unroll
                for (int j = 0; j < 4; ++j) { v0[j] = silu_f(acc[ai][0][m][0][j] * rs) * (acc[ai][1][m][0][j] * rs); v1[j] = silu_f(acc[ai][0][m][1][j] * rs) * (acc[ai][1][m][1][j] * rs); }
                v4u w; w.x = cvt_pk_bf16(v0[0], v0[1]); w.y = cvt_pk_bf16(v0[2], v0[3]); w.z = cvt_pk_bf16(v1[0], v1[1]); w.w = cvt_pk_bf16(v1[2], v1[3]);
                *(v4u*)(hb + (size_t)(u.arow0 + rl) * FF + u.pn * 128 + wc * 32 + 8 * fq) = w; }
    }
};
struct EpiMoe2W {
    bf16* yb; const int* tokl; const float* gatel;
    __device__ __forceinline__ void operator()(const f32x4 (&acc)[2][2][4][2], const pg8::Unit& u, int wr, int wc, int fr, int fq) const {
#pragma unroll
        for (int ai = 0; ai < 2; ++ai)
#pragma unroll
            for (int m = 0; m < 4; ++m) { const int rl = ai * 128 + wr * 64 + m * 16 + fr;
                if (rl < u.nvalid) {
                    const int dst = tokl[u.e * M + u.rb + rl]; const float gt = gatel[u.e * M + u.rb + rl];
#pragma unroll
                    for (int bj = 0; bj < 2; ++bj) { const f32x4 v0 = acc[ai][bj][m][0] * gt, v1 = acc[ai][bj][m][1] * gt;
                        v4u w; w.x = cvt_pk_bf16(v0[0], v0[1]); w.y = cvt_pk_bf16(v0[2], v0[3]); w.z = cvt_pk_bf16(v1[0], v1[1]); w.w = cvt_pk_bf16(v1[2], v1[3]);
                        *(v4u*)(yb + (size_t)dst * D + u.pn * 256 + bj * 128 + wc * 32 + 8 * fq) = w; } } }
    }
};

__device__ __forceinline__ void p9_final_phase(Frame& F) {
    const bf16* xb2 = (const bf16*)(F.ws + WS_XN); const bf16* yb = (const bf16*)(F.ws + WS_YB);
    const int gw = F.vcu * NWAVES + F.wave, NGW = F.G * NWAVES, lane = lane_now();
    for (int row = gw; row < M; row += NGW) {
        float v[16]; float ss = 0.f;
#pragma unroll
        for (int c = 0; c < 2; ++c) {
            const int ch = lane + 64 * c;
            const v4u a = *(const GAS v4u*)(xb2 + (size_t)row * D + 8 * ch), b1 = *(const GAS v4u*)(yb + (size_t)(2 * row) * D + 8 * ch), b2 = *(const GAS v4u*)(yb + (size_t)(2 * row + 1) * D + 8 * ch);
            const unsigned aa[4] = {a.x, a.y, a.z, a.w}, bb[4] = {b1.x, b1.y, b1.z, b1.w}, cc[4] = {b2.x, b2.y, b2.z, b2.w};
            const f32x4 n0 = *(const GAS f32x4*)(F.norm2_w + 8 * ch), n1 = *(const GAS f32x4*)(F.norm2_w + 8 * ch + 4);
            const float inw[8] = {1.0f / n0[0], 1.0f / n0[1], 1.0f / n0[2], 1.0f / n0[3], 1.0f / n1[0], 1.0f / n1[1], 1.0f / n1[2], 1.0f / n1[3]};
#pragma unroll
            for (int x = 0; x < 4; ++x) { const float lo = bflo(aa[x]) * inw[2 * x] + (bflo(bb[x]) + bflo(cc[x])), hi = bfhi(aa[x]) * inw[2 * x + 1] + (bfhi(bb[x]) + bfhi(cc[x])); v[8 * c + 2 * x] = lo; v[8 * c + 2 * x + 1] = hi; ss += lo * lo + hi * hi; }
        }
        const float rs = 1.0f / sqrtf(wave_sum(ss) * (1.0f / D) + EPS);
#pragma unroll
        for (int c = 0; c < 2; ++c) {
            const int ch = lane + 64 * c;
            const f32x4 w0 = *(const GAS f32x4*)(F.fin_w + 8 * ch), w1 = *(const GAS f32x4*)(F.fin_w + 8 * ch + 4);
            f32x4 o0, o1;
#pragma unroll
            for (int x = 0; x < 4; ++x) { o0[x] = v[8 * c + x] * rs * w0[x]; o1[x] = v[8 * c + 4 + x] * rs * w1[x]; }
            *(GAS f32x4*)(F.out + (size_t)row * D + 8 * ch) = o0; *(GAS f32x4*)(F.out + (size_t)row * D + 8 * ch + 4) = o1;
        }
    }
}

struct Args { const float* in[15]; float* out; unsigned char* ws; int ph_lo, ph_hi, li, pad; };
__global__ void __launch_bounds__(NWAVES * 64, 2) mega_fwd(Args args) {
    extern __shared__ __attribute__((aligned(16))) unsigned char lds[];
    Frame F;
    F.lds = (LAS unsigned char*)lds; F.MISC = (volatile LAS unsigned*)(F.lds + MISC_OFF);
    F.tid = threadIdx.x; F.lane = F.tid & 63; F.wave = __builtin_amdgcn_readfirstlane(F.tid >> 6);
    F.G = gridDim.x; { const int bx = blockIdx.x; F.vcu = (F.G % 8 == 0) ? (bx % 8) * (F.G / 8) + bx / 8 : bx; }
    F.ws = args.ws; F.ctl = (gu32*)(args.ws + WS_CTL); F.out = args.out;
    F.x = args.in[0]; F.norm1_w = args.in[1]; F.w_in = args.in[2]; F.gn_w = args.in[3]; F.conv_w = args.in[4]; F.w_o = args.in[5]; F.norm2_w = args.in[6];
    F.rg_w = args.in[7]; F.rg_b = args.in[8]; F.re_w = args.in[9]; F.re_b = args.in[10]; F.w_gate = args.in[11]; F.w_up = args.in[12]; F.w_down = args.in[13]; F.fin_w = args.in[14];
    for (int u = F.tid; u < (LDS_BYTES - LDSCTL_OFF) / 4; u += NWAVES * 64) ((LAS unsigned*)(F.lds + LDSCTL_OFF))[u] = 0u;
    __syncthreads();
    XcdBarrier bar = xcd_barrier_post((unsigned*)(F.ctl + CW_BAR) + args.li * XCD_BAR_WORDS, F.MISC + 8);
    const int lo = args.ph_lo, hi = args.ph_hi;
    const bool early = (F.G == 256);
    if (early && blockIdx.x >= 128 && threadIdx.x == 0) (void)xb_add((unsigned*)(F.ctl + CW_ECNT) + 64 * bar.x, 1u);
#define IN(k) (lo <= (k) && (k) < hi)
#define BOTH(k) (IN(k) && IN((k) + 1))
    if (IN(0)) { p0_prologue(F); if (BOTH(0)) xcd_barrier(bar); }
    if (IN(1)) {
        InProjSched S{(int)blockIdx.x, F.G, (const void*)(F.ws + WS_WINT), (const void*)(F.ws + WS_WINT), (unsigned)(INC * D * 2)};
        static_assert(WS_KB - WS_QB == 16 * MiB && WS_VB - WS_KB == 16 * MiB && WS_GB - WS_VB == 16 * MiB && WS_GBB - WS_GB == 16 * MiB && WS_CUB - WS_GBB == 16 * MiB, "EpiInProj strides");
        EpiInProj E{(bf16*)(F.ws + WS_QB), (const float*)(F.ws + WS_ROPE), (const float*)(F.ws + WS_ROPE) + SEQ * 64, (unsigned*)(F.ctl + CW_X1) + 64 * bar.x, (unsigned*)(F.ctl + CW_E1), F.MISC};
        pg8::gemm_phase<EpiInProj, InProjSched, false, true>(F.lds + RING_OFF, (const void*)(F.ws + WS_XN), (unsigned)(M * D * 2), D, S, E);
        if (BOTH(1) && !early) xcd_barrier(bar);
    }
    {
        const int bx = (int)blockIdx.x; const bool mine = !early || bx >= 128; const int pi = early ? bx - 128 : bx, pstr = early ? 128 : F.G;
        if (IN(2)) {
            if (mine) {
                if (early) wg_wait_count((unsigned*)(F.ctl + CW_E1), 256u, bar.bar);
                p2_kv_phase(F, pi, pstr);
                if (early) { wave_arrive(F.MISC + 12, (unsigned*)(F.ctl + CW_X2) + 64 * bar.x, xb_ld((unsigned*)(F.ctl + CW_ECNT) + 64 * bar.x), (unsigned*)(F.ctl + CW_E2)); wg_wait_count((unsigned*)(F.ctl + CW_E2), 128u, bar.bar); }
            }
            if (BOTH(2) && !early) xcd_barrier(bar);
        }
        if (IN(3)) { if (mine) p3_scan_phase(F, pi, pstr); if (BOTH(3)) xcd_barrier(bar); }
    }
    if (IN(4)) { p4_retout_phase(F); if (BOTH(4)) xcd_barrier(bar); }
    if (IN(5)) {
        OutProjSched S{(int)blockIdx.x, F.G, (const void*)(F.ws + WS_WOT), (const void*)(F.ws + WS_WOT), (unsigned)(D * D * 2)};
        EpiOutProj E{F.x, F.norm2_w, (bf16*)(F.ws + WS_XN), (float*)(F.ws + WS_SSQ)};
        pg8::gemm_phase<EpiOutProj, OutProjSched, false, false>(F.lds + RING_OFF, (const void*)(F.ws + WS_MIXB), (unsigned)(M * D * 2), D, S, E);
        if (BOTH(5)) xcd_barrier(bar);
    }
    if (IN(6)) { p6_router_phase(F); if (BOTH(6)) xcd_barrier(bar); }
    if (IN(7)) {
        MoeSched S; S.half = 0; S.wave = F.wave; S.c = (int)blockIdx.x; S.G = F.G; S.Wb0 = (const void*)F.w_gate; S.Wb1 = (const void*)F.w_up; S.Wbytes = (unsigned)(NE * D * FF * 4); S.off1 = 0; S.estride = (unsigned)(D * FF * 4); S.colstep = 128 * 4; S.ldwb = FF * 4; S.tokl = (const int*)(F.ws + WS_TOKL);
        S.init((const int*)(F.ws + WS_CTL) + CW_CNT, lane_now(), (LAS int*)(F.lds + LDSCTL_OFF + 1024)); __syncthreads();
        { EpiMoe1W E{(bf16*)(F.ws + WS_HB), (const float*)(F.ws + WS_RSL)};
          mw::gemm_w<EpiMoe1W, MoeSched, true>(F.lds + RING_OFF, (const void*)(F.ws + WS_XN), (unsigned)(M * D * 2), D, S, E); }
        S.half = 1;
        { EpiMoe1 E{(bf16*)(F.ws + WS_HB), (const float*)(F.ws + WS_RSL)};
          mz::gemm_z<EpiMoe1, MoeSched, true>(F.lds + RING_OFF, (const void*)(F.ws + WS_XN), (unsigned)(M * D * 2), D, S, E); }
        if (BOTH(7)) xcd_barrier(bar);
    }
    if (IN(8)) {
        MoeSched S; S.half = 0; S.wave = F.wave; S.c = (int)blockIdx.x; S.G = F.G; S.Wb0 = (const void*)F.w_down; S.Wb1 = (const void*)F.w_down; S.Wbytes = (unsigned)(NE * FF * D * 4); S.off1 = 128 * 4; S.estride = (unsigned)(FF * D * 4); S.colstep = 256 * 4; S.ldwb = D * 4; S.tokl = (const int*)(F.ws + WS_TOKL);
        S.init((const int*)(F.ws + WS_CTL) + CW_CNT, lane_now(), (LAS int*)(F.lds + LDSCTL_OFF + 1024)); __syncthreads();
        { EpiMoe2W E{(bf16*)(F.ws + WS_YB), (const int*)(F.ws + WS_TOKL), (const float*)(F.ws + WS_GATEL)};
          mw::gemm_w<EpiMoe2W, MoeSched, false>(F.lds + RING_OFF, (const void*)(F.ws + WS_HB), (unsigned)(49152u * FF * 2u), FF, S, E); }
        S.half = 1;
        { EpiMoe2 E{(bf16*)(F.ws + WS_YB), (const int*)(F.ws + WS_TOKL), (const float*)(F.ws + WS_GATEL)};
          mz::gemm_z<EpiMoe2, MoeSched, false>(F.lds + RING_OFF, (const void*)(F.ws + WS_HB), (unsigned)(49152u * FF * 2u), FF, S, E); }
        if (BOTH(8)) xcd_barrier(bar);
    }
    if (IN(9)) { p9_final_phase(F); }
#undef IN
#undef BOTH
}

extern "C" void kernel_launch(void* const* d_in, const int* in_sizes, int n_in, void* d_out, int out_size, void* d_ws, size_t ws_size, hipStream_t stream) {
    static int grid = 0;
    if (grid == 0) {
        int dev = 0, cus = 0, per_cu = 0;
        if (hipGetDevice(&dev) != hipSuccess || hipDeviceGetAttribute(&cus, hipDeviceAttributeMultiprocessorCount, dev) != hipSuccess) { fprintf(stderr, "kernel_launch: device query failed\n"); grid = -1; return; }
        if (hipFuncSetAttribute((const void*)mega_fwd, hipFuncAttributeMaxDynamicSharedMemorySize, LDS_BYTES) != hipSuccess) { fprintf(stderr, "kernel_launch: hipFuncSetAttribute failed\n"); grid = -1; return; }
        if (hipOccupancyMaxActiveBlocksPerMultiprocessor(&per_cu, (const void*)mega_fwd, NWAVES * 64, LDS_BYTES) != hipSuccess || per_cu < 1) fprintf(stderr, "kernel_launch: occupancy query reports %d blocks per CU\n", per_cu);
        (void)hipGetLastError();
        grid = cus;
    }
    if (grid < 0) return;
    char* ws = (char*)d_ws; float* out = (float*)d_out;
    (void)hipMemsetAsync(ws + WS_CTL, 0, CTL_ZERO_BYTES, stream);
    Args a{};
    for (int i = 0; i < 15; ++i) a.in[i] = (const float*)d_in[i];
    a.out = out; a.ws = (unsigned char*)d_ws;
    a.ph_lo = 0; a.ph_hi = 10; a.li = 0; hipLaunchKernelGGL(mega_fwd, dim3(grid), dim3(NWAVES * 64), LDS_BYTES, stream, a);
}
```

```cpp
#include <hip/hip_runtime.h>
#include <cstdio>
#include <cstdint>

constexpr int NB = 4, SEQ = 4096, D = 1024, M = NB * SEQ;
constexpr int RW = 512, NH = 4, HD = 128, CW = 512, INC = 3584, CH = 128, NCH = SEQ / CH;
constexpr int NG = 8, EPG = 8, NE = 64, FF = 512;
constexpr float EPS = 1e-6f;
constexpr int NWAVES = 8;

#define GAS __attribute__((address_space(1)))
#define LAS __attribute__((address_space(3)))
typedef unsigned short bf16;
typedef unsigned v4u __attribute__((ext_vector_type(4)));
typedef unsigned v2u __attribute__((ext_vector_type(2)));
typedef float f32x4 __attribute__((ext_vector_type(4)));
typedef short bf16x8 __attribute__((ext_vector_type(8)));
typedef GAS unsigned gu32;
#define RLX_AGENT __ATOMIC_RELAXED, __HIP_MEMORY_SCOPE_AGENT
#define LDS_WAIT() asm volatile("s_waitcnt lgkmcnt(0)" ::: "memory")
#define VM_WAIT() asm volatile("s_waitcnt vmcnt(0)" ::: "memory")

__device__ __forceinline__ unsigned f2bf(float f) { unsigned u = __builtin_bit_cast(unsigned, f); return (u + 0x7fffu + ((u >> 16) & 1u)) >> 16; }
__device__ __forceinline__ unsigned pk2(float lo, float hi) { return f2bf(lo) | (f2bf(hi) << 16); }
__device__ __forceinline__ float bf2f(unsigned short b) { return __builtin_bit_cast(float, (unsigned)b << 16); }
__device__ __forceinline__ float bflo(unsigned w) { return __builtin_bit_cast(float, w << 16); }
__device__ __forceinline__ float bfhi(unsigned w) { return __builtin_bit_cast(float, w & 0xffff0000u); }
__device__ __forceinline__ unsigned cvt_pk_bf16(float lo, float hi) { unsigned r; asm volatile("v_cvt_pk_bf16_f32 %0, %1, %2" : "=v"(r) : "v"(lo), "v"(hi)); return r; }

__device__ __forceinline__ int lane_now() { int l; asm volatile("v_mbcnt_lo_u32_b32 %0, -1, 0\n\tv_mbcnt_hi_u32_b32 %0, -1, %0" : "=v"(l)); return l; }
constexpr size_t MiB = 1u << 20;
constexpr size_t WS_CTL = 0, CTL_ZERO_BYTES = 512 * 1024;
constexpr size_t WS_WRT = 1 * MiB;
constexpr size_t WS_ROPE = 2 * MiB;
constexpr size_t WS_WOT = 4 * MiB;
constexpr size_t WS_WINT = 6 * MiB;
constexpr size_t WS_TOKL = 14 * MiB, WS_RSL = 18 * MiB, WS_GATEL = 22 * MiB;
constexpr size_t WS_SSQ = 13 * MiB;
constexpr size_t WS_QB = 224 * MiB, WS_KB = 240 * MiB, WS_VB = 256 * MiB, WS_GB = 272 * MiB, WS_GBB = 288 * MiB, WS_CUB = 304 * MiB, WS_PREVT = 320 * MiB;
constexpr size_t WS_YB = 224 * MiB;
constexpr size_t WS_HB = 288 * MiB;
constexpr size_t WS_XN = 336 * MiB;
constexpr size_t WS_KVT = 368 * MiB;
constexpr size_t WS_MIXB = 368 * MiB;
constexpr size_t WS_END = 400 * MiB;

constexpr int CW_TMO = 0, CW_CODE = 1;
constexpr int CW_E1 = 256, CW_E2 = 320, CW_ECNT = 1024, CW_X1 = 2048, CW_X2 = 3072;
constexpr int CW_BAR = 4096;
constexpr int CW_CNT = 49152, CNT_STRIDE = 1088;

constexpr int RING_OFF = 0, RING_BYTES = 131072;
constexpr int LDSCTL_OFF = RING_BYTES, MISC_OFF = LDSCTL_OFF + 320;
constexpr int LDS_BYTES = 147456;

namespace pg8 {
typedef short s16x4_t __attribute__((ext_vector_type(4)));
typedef short v4i16g_t __attribute__((ext_vector_type(4)));
constexpr int BM = 256, BK = 64, HALF = 128, HTB = HALF * BK * 2, STAGE_BYTES = 8 * HTB, NXCD = 8, WGM = 8;
__host__ __device__ __forceinline__ int lds_byte(int r, int c) { const int st = (r >> 4) * 2 + (c >> 5), rr = r & 15, cc = c & 31, ob = rr * 64 + cc * 2; return st * 1024 + (ob ^ (((ob >> 9) & 1) << 5)); }
__host__ __device__ __forceinline__ void stage_rc(int b, int& R, int& C) { const int st = b / 1024, sb = b % 1024, swz = sb ^ (((sb >> 9) & 1) << 5); R = (st >> 1) * 16 + swz / 64; C = (st & 1) * 32 + (swz % 64) / 2; }
__host__ __device__ __forceinline__ int perm32(int rho) { const int n = rho >> 4, i = rho & 15; return 8 * (i >> 2) + 4 * n + (i & 3); }

struct Unit { int arow0; int pm, pn; int e, rb, nvalid; unsigned B, B1; };

template <class Epi, class Sched, bool GATHER, bool ALIGN_EPI, bool BF32 = false>
__device__ __forceinline__ void gemm_phase(LAS unsigned char* lds, const void* Amat, const unsigned Abytes, const int K, const Sched& S, const Epi& E) {
    const __amdgpu_buffer_rsrc_t rA = __builtin_amdgcn_make_buffer_rsrc((void*)Amat, 0, Abytes, 0x00020000);
    const __amdgpu_buffer_rsrc_t rB0 = __builtin_amdgcn_make_buffer_rsrc((void*)S.Wb0, 0, S.Wbytes, 0x00020000), rB1 = __builtin_amdgcn_make_buffer_rsrc((void*)S.Wb1, 0, S.Wbytes, 0x00020000);
    const int tid = threadIdx.x, wid = __builtin_amdgcn_readfirstlane(tid >> 6), lane = tid & 63, wr = wid >> 2, wc = wid & 3, fr = lane & 15, fq = lane >> 4;
    const int nt = K / BK;
    int Rv[2], Cv[2]; unsigned voffB[2];
#pragma unroll
    for (int i = 0; i < 2; ++i) { stage_rc(tid * 16 + i * 8192, Rv[i], Cv[i]); const int Rb = Epi::PERM ? ((Rv[i] & ~31) + perm32(Rv[i] & 31)) : Rv[i]; voffB[i] = (unsigned)(Rb * K + Cv[i]) * 2u; }
    const unsigned kstep = (unsigned)(BK * 2);
    const unsigned hstepB = (unsigned)(HALF * K * 2);
    const unsigned ldsw = (unsigned)wid * 1024u;
    const int aoff = lds_byte(wr * 64 + fr, fq * 8), boff = lds_byte(wc * 32 + fr, fq * 8);
    size_t ldwb = 0; if constexpr (BF32) ldwb = (size_t)S.ldwb;
    const int bk0 = tid >> 5, bmm = tid & 31;
    const unsigned bwoff = (256u * bk0 + 16u * ((unsigned)(bmm >> 1) ^ ((((unsigned)bk0 & 3u) << 2) | (((unsigned)bk0 >> 2) & 3u)))) + 8u * (((unsigned)bmm & 1u) ^ (((unsigned)bk0 >> 3) & 1u));
    const unsigned bgoff = (unsigned)bk0 * (unsigned)ldwb + (unsigned)bmm * 16u;
    unsigned trb[2][2];
#pragma unroll
    for (int t = 0; t < 2; ++t)
#pragma unroll
        for (int nf = 0; nf < 2; ++nf) { const unsigned row = 8u * fq + 4u * t + ((unsigned)fr >> 2), ch = 4u * wc + ((unsigned)fr & 3u);
            trb[t][nf] = 256u * row + 16u * (ch ^ (((row & 3u) << 2) | ((row >> 2) & 3u))) + 8u * ((unsigned)nf ^ ((unsigned)fq & 1u)); }
    unsigned bgo[4];
#pragma unroll
    for (int i = 0; i < 4; ++i) bgo[i] = bgoff + (unsigned)(16 * i) * (unsigned)ldwb;
    f32x4 R[4];
#define PG8_SA(b, h) (((BF32 ? 4 : 0) + (b) * 2 + (h)) * HTB)
#define PG8_SB(b, h) (((BF32 ? 0 : 4) + (b) * 2 + (h)) * HTB)
#define PG8_STAGE_B(bufoff, so) do { _Pragma("unroll") for (int _i = 0; _i < 2; ++_i) \
        __builtin_amdgcn_raw_ptr_buffer_load_lds(rB0, (LAS void*)(lds + (bufoff) + ldsw + _i * 8192), 16, (int)voffB[_i], (int)(so), 0, 0); } while (0)
#define PG8_STAGE_A(bufoff, vo, kb) do { _Pragma("unroll") for (int _i = 0; _i < 2; ++_i) \
        __builtin_amdgcn_raw_ptr_buffer_load_lds(rA, (LAS void*)(lds + (bufoff) + ldsw + _i * 8192), 16, (int)(vo)[_i], (int)(kb), 0, 0); } while (0)
#define PG8_LDA(dst, b, h) do { _Pragma("unroll") for (int m = 0; m < 4; ++m) _Pragma("unroll") for (int k = 0; k < 2; ++k) dst[m][k] = *(const LAS bf16x8*)(lds + PG8_SA(b, h) + aoff + m * 2048 + k * 1024); } while (0)
#define PG8_LDB(dst, b, h) do { _Pragma("unroll") for (int n = 0; n < 2; ++n) _Pragma("unroll") for (int k = 0; k < 2; ++k) dst[n][k] = *(const LAS bf16x8*)(lds + PG8_SB(b, h) + boff + n * 2048 + k * 1024); } while (0)
#define PG8_BLOAD(h, so, kt) do { const int _so = (int)((so) + (unsigned)(kt) * 64u * (unsigned)ldwb); _Pragma("unroll") for (int _i = 0; _i < 4; ++_i) \
        R[_i] = __builtin_bit_cast(f32x4, __builtin_amdgcn_raw_buffer_load_b128((h) ? rB1 : rB0, (int)bgo[_i], _so, 0)); } while (0)
#define PG8_BWRITE(bufoff) do { _Pragma("unroll") for (int _i = 0; _i < 4; ++_i) { v2u _w; _w.x = cvt_pk_bf16(R[_i].x, R[_i].y); _w.y = cvt_pk_bf16(R[_i].z, R[_i].w); *(LAS v2u*)(lds + (bufoff) + bwoff + 4096 * _i) = _w; } } while (0)
#define PG8_TR(addr) __builtin_bit_cast(s16x4_t, __builtin_amdgcn_ds_read_tr16_b64_v4i16((LAS v4i16g_t*)(addr)))
#define PG8_LDBT(dst, b, h) do { _Pragma("unroll") for (int n = 0; n < 2; ++n) _Pragma("unroll") for (int k = 0; k < 2; ++k) { \
        const s16x4_t _lo = PG8_TR(lds + PG8_SB(b, h) + trb[0][n] + 8192 * k), _hi = PG8_TR(lds + PG8_SB(b, h) + trb[1][n] + 8192 * k); \
        dst[n][k] = (bf16x8){_lo[0], _lo[1], _lo[2], _lo[3], _hi[0], _hi[1], _hi[2], _hi[3]}; } } while (0)
#define PG8_LDBX(dst, b, h) do { if constexpr (BF32) { PG8_LDBT(dst, b, h); } else { PG8_LDB(dst, b, h); } } while (0)
#define PG8_MMA(ai, bj, At, Bt) do { __builtin_amdgcn_s_setprio(1); _Pragma("unroll") for (int m = 0; m < 4; ++m) _Pragma("unroll") for (int n = 0; n < 2; ++n) _Pragma("unroll") for (int k = 0; k < 2; ++k) \
        acc[ai][bj][m][n] = __builtin_amdgcn_mfma_f32_16x16x32_bf16(Bt[n][k], At[m][k], acc[ai][bj][m][n], 0, 0, 0); __builtin_amdgcn_s_setprio(0); } while (0)
#define PG8_WAIT_V(n) asm volatile("s_waitcnt vmcnt(" #n ")" ::: "memory")
#define PG8_WAIT_L(n) asm volatile("s_waitcnt lgkmcnt(" #n ")" ::: "memory")
#define PG8_BAR __builtin_amdgcn_s_barrier()
#define PG8_SCHED __builtin_amdgcn_sched_barrier(0)
#define PG8_SETVO(vo, u) do { _Pragma("unroll") for (int _h = 0; _h < 2; ++_h) _Pragma("unroll") for (int _i = 0; _i < 2; ++_i) { \
        const int _row = GATHER ? S.arow(u, _h * HALF + Rv[_i]) : (u).arow0 + _h * HALF + Rv[_i]; (vo)[_h][_i] = (unsigned)(_row * K + Cv[_i]) * 2u; } } while (0)
    Unit cur, nxt; int ui = 0;
    if (!S.next(0, cur)) return;
    unsigned voC[2][2], voN[2][2];
    PG8_SETVO(voC, cur);
    f32x4 acc[2][2][4][2];
#pragma unroll
    for (int a = 0; a < 2; ++a)
#pragma unroll
        for (int b = 0; b < 2; ++b)
#pragma unroll
            for (int m = 0; m < 4; ++m)
#pragma unroll
                for (int n = 0; n < 2; ++n) acc[a][b][m][n] = (f32x4){0.f, 0.f, 0.f, 0.f};
    bf16x8 At[4][2], B0[2][2], B1[2][2];
    unsigned cB = cur.B, cB1 = cur.B1;
    if constexpr (BF32) {
        PG8_STAGE_A(PG8_SA(0, 0), voC[0], 0); PG8_STAGE_A(PG8_SA(0, 1), voC[1], 0);
        PG8_BLOAD(0, cB, 0); PG8_BWRITE(PG8_SB(0, 0)); PG8_BLOAD(1, cB1, 0); PG8_BWRITE(PG8_SB(0, 1));
        PG8_WAIT_V(0); PG8_WAIT_L(0);
        if (wr == 1) PG8_BAR;
        PG8_BAR;
        PG8_STAGE_A(PG8_SA(1, 0), voC[0], kstep); PG8_BLOAD(0, cB, 1);
        PG8_BAR;
    } else {
    PG8_STAGE_B(PG8_SB(0, 0), cB); PG8_STAGE_B(PG8_SB(0, 1), cB + hstepB); PG8_STAGE_A(PG8_SA(0, 0), voC[0], 0); PG8_STAGE_A(PG8_SA(0, 1), voC[1], 0);
    if (wr == 1) PG8_BAR;
    PG8_WAIT_V(2); PG8_BAR;
    PG8_STAGE_B(PG8_SB(1, 0), cB + kstep); PG8_STAGE_A(PG8_SA(1, 0), voC[0], kstep); PG8_STAGE_B(PG8_SB(1, 1), cB + hstepB + kstep);
    PG8_WAIT_V(6); PG8_BAR;
    }
    for (;;) {
        const bool has_next = S.next(ui + 1, nxt);
        const unsigned nB = has_next ? nxt.B : cB, nB1 = has_next ? nxt.B1 : cB1;
        if (has_next) { PG8_SETVO(voN, nxt); } else {
#pragma unroll
            for (int h = 0; h < 2; ++h)
#pragma unroll
                for (int i = 0; i < 2; ++i) voN[h][i] = voC[h][i]; }
        for (int t = 0; t < nt; t += 2) {
            const bool last = (t == nt - 2);
            const unsigned kb1 = (unsigned)(t + 1) * kstep;
            const unsigned kb2 = last ? 0u : (unsigned)(t + 2) * kstep, kb3 = kb2 + kstep;
            const unsigned b2 = last ? nB : cB + (unsigned)(t + 2) * kstep, b3 = b2 + kstep;
            unsigned vo2[2][2];
#pragma unroll
            for (int h = 0; h < 2; ++h)
#pragma unroll
                for (int i = 0; i < 2; ++i) vo2[h][i] = last ? voN[h][i] : voC[h][i];
            if constexpr (BF32) {
            const unsigned h20 = last ? nB : cB; const int kt2 = last ? 0 : t + 2;
            PG8_LDBT(B0, 0, 0); PG8_SCHED; PG8_LDA(At, 0, 0); PG8_BWRITE(PG8_SB(1, 0)); PG8_STAGE_A(PG8_SA(1, 1), voC[1], kb1); PG8_BLOAD(1, cB1, t + 1);
            PG8_WAIT_L(0); PG8_BAR; PG8_MMA(0, 0, At, B0); PG8_SCHED; PG8_LDBT(B0, 0, 1); PG8_WAIT_L(0); PG8_SCHED; PG8_MMA(0, 1, At, B0); PG8_BAR; PG8_SCHED;
            PG8_LDBT(B0, 0, 0); PG8_SCHED; PG8_LDA(At, 0, 1); PG8_BWRITE(PG8_SB(1, 1)); PG8_STAGE_A(PG8_SA(0, 0), vo2[0], kb2); PG8_BLOAD(0, h20, kt2);
            PG8_WAIT_L(0); PG8_BAR; PG8_MMA(1, 0, At, B0); PG8_SCHED; PG8_LDBT(B0, 0, 1); PG8_WAIT_L(0); PG8_SCHED; PG8_MMA(1, 1, At, B0); PG8_BAR; PG8_SCHED;
            const unsigned h21 = last ? nB1 : cB1;
            PG8_LDBT(B0, 1, 0); PG8_SCHED; PG8_LDA(At, 1, 0); PG8_BWRITE(PG8_SB(0, 0)); PG8_STAGE_A(PG8_SA(0, 1), vo2[1], kb2); PG8_BLOAD(1, h21, kt2);
            PG8_WAIT_L(0); PG8_BAR; PG8_MMA(0, 0, At, B0); PG8_SCHED; PG8_LDBT(B0, 1, 1); PG8_WAIT_L(0); PG8_SCHED; PG8_MMA(0, 1, At, B0); PG8_BAR; PG8_SCHED;
            PG8_LDA(At, 1, 1); PG8_LDBT(B0, 1, 0); PG8_SCHED; PG8_BWRITE(PG8_SB(0, 1)); PG8_STAGE_A(PG8_SA(1, 0), vo2[0], kb3); PG8_BLOAD(0, h20, kt2 + 1);
            PG8_WAIT_L(0); PG8_BAR; PG8_MMA(1, 0, At, B0); PG8_SCHED; PG8_LDBT(B0, 1, 1); PG8_WAIT_L(0); PG8_SCHED; PG8_MMA(1, 1, At, B0); PG8_BAR; PG8_SCHED;
            } else {
            PG8_LDB(B0, 0, 0); PG8_LDB(B1, 0, 1); PG8_SCHED; PG8_LDA(At, 0, 0); PG8_STAGE_A(PG8_SA(1, 1), voC[1], kb1);
            PG8_WAIT_V(8); PG8_WAIT_L(0); PG8_BAR; PG8_MMA(0, 0, At, B0); PG8_MMA(0, 1, At, B1); PG8_BAR; PG8_SCHED;
            PG8_LDA(At, 0, 1); PG8_STAGE_B(PG8_SB(0, 0), b2); PG8_STAGE_B(PG8_SB(0, 1), b2 + hstepB); PG8_STAGE_A(PG8_SA(0, 0), vo2[0], kb2);
            PG8_WAIT_V(8); PG8_WAIT_L(0); PG8_BAR; PG8_MMA(1, 0, At, B0); PG8_MMA(1, 1, At, B1); PG8_BAR; PG8_SCHED;
            PG8_LDB(B0, 1, 0); PG8_LDB(B1, 1, 1); PG8_SCHED; PG8_LDA(At, 1, 0); PG8_STAGE_A(PG8_SA(0, 1), vo2[1], kb2);
            PG8_WAIT_V(8); PG8_WAIT_L(0); PG8_BAR; PG8_MMA(0, 0, At, B0); PG8_MMA(0, 1, At, B1); PG8_BAR; PG8_SCHED;
            PG8_LDA(At, 1, 1); PG8_STAGE_B(PG8_SB(1, 0), b3); PG8_STAGE_B(PG8_SB(1, 1), b3 + hstepB); PG8_STAGE_A(PG8_SA(1, 0), vo2[0], kb3);
            PG8_WAIT_V(8); PG8_WAIT_L(0); PG8_BAR; PG8_MMA(1, 0, At, B0); PG8_MMA(1, 1, At, B1); PG8_BAR; PG8_SCHED;
            }
        }
        if constexpr (ALIGN_EPI) { if (wr == 0) PG8_BAR; }
        E(acc, cur, wr, wc, fr, fq);
        if (!has_next) break;
#pragma unroll
        for (int a = 0; a < 2; ++a)
#pragma unroll
            for (int b = 0; b < 2; ++b)
#pragma unroll
                for (int m = 0; m < 4; ++m)
#pragma unroll
                    for (int n = 0; n < 2; ++n) acc[a][b][m][n] = (f32x4){0.f, 0.f, 0.f, 0.f};
        cur = nxt; cB = nB; cB1 = nB1; ++ui;
#pragma unroll
        for (int h = 0; h < 2; ++h)
#pragma unroll
            for (int i = 0; i < 2; ++i) voC[h][i] = voN[h][i];
        if constexpr (ALIGN_EPI) { if (wr == 1) PG8_BAR; }
    }
    PG8_WAIT_V(0);
    if constexpr (!ALIGN_EPI) { if (wr == 0) PG8_BAR; }
    PG8_BAR;
#undef PG8_SA
#undef PG8_SB
#undef PG8_STAGE_A
#undef PG8_STAGE_B
#undef PG8_LDA
#undef PG8_LDB
#undef PG8_LDBT
#undef PG8_LDBX
#undef PG8_TR
#undef PG8_BLOAD
#undef PG8_BWRITE
#undef PG8_MMA
#undef PG8_WAIT_V
#undef PG8_WAIT_L
#undef PG8_BAR
#undef PG8_SCHED
#undef PG8_SETVO
}
}


namespace mz {
using pg8::lds_byte; using pg8::stage_rc; using pg8::Unit; using pg8::s16x4_t; using pg8::v4i16g_t;
template <class Epi, class Sched, bool GATHER>
__device__ __forceinline__ void gemm_z(LAS unsigned char* lds, const void* Amat, const unsigned Abytes, const int K, const Sched& S, const Epi& E) {
    const __amdgpu_buffer_rsrc_t rA = __builtin_amdgcn_make_buffer_rsrc((void*)Amat, 0, Abytes, 0x00020000);
    const __amdgpu_buffer_rsrc_t rB0 = __builtin_amdgcn_make_buffer_rsrc((void*)S.Wb0, 0, S.Wbytes, 0x00020000), rB1 = __builtin_amdgcn_make_buffer_rsrc((void*)S.Wb1, 0, S.Wbytes, 0x00020000);
    const int tid = threadIdx.x, wid = __builtin_amdgcn_readfirstlane(tid >> 6), lane = tid & 63, wr = wid >> 2, wc = wid & 3, fr = lane & 15, fq = lane >> 4;
    const int nt = K / 64;
    const unsigned ldwb = (unsigned)S.ldwb, ktb = 64u * ldwb;
    int Rv[2], Cv[2];
#pragma unroll
    for (int i = 0; i < 2; ++i) stage_rc(tid * 16 + i * 8192, Rv[i], Cv[i]);
    const unsigned ldsw = (unsigned)wid * 1024u;
    const int aoff = lds_byte(wr * 64 + fr, fq * 8);
    const int bk0 = tid >> 5, bmm = tid & 31;
    const unsigned bwoff = (256u * bk0 + 16u * ((unsigned)(bmm >> 1) ^ ((((unsigned)bk0 & 3u) << 2) | (((unsigned)bk0 >> 2) & 3u)))) + 8u * (((unsigned)bmm & 1u) ^ (((unsigned)bk0 >> 3) & 1u));
    unsigned bgo[4];
#pragma unroll
    for (int i = 0; i < 4; ++i) bgo[i] = (unsigned)(bk0 + 16 * i) * ldwb + (unsigned)bmm * 16u;
    unsigned trb[2][2];
#pragma unroll
    for (int t = 0; t < 2; ++t)
#pragma unroll
        for (int nf = 0; nf < 2; ++nf) { const unsigned row = 8u * fq + 4u * t + ((unsigned)fr >> 2), ch = 4u * wc + ((unsigned)fr & 3u);
            trb[t][nf] = 256u * row + 16u * (ch ^ (((row & 3u) << 2) | ((row >> 2) & 3u))) + 8u * ((unsigned)nf ^ ((unsigned)fq & 1u)); }
#define MZ_SB(p, h) (((p) * 2 + (h)) * 16384)
#define MZ_SA(q) (65536 + (q) * 16384)
#define MZ_STAGE_A(q, vo, kb) do { _Pragma("unroll") for (int _i = 0; _i < 2; ++_i) \
        __builtin_amdgcn_raw_ptr_buffer_load_lds(rA, (LAS void*)(lds + MZ_SA(q) + ldsw + _i * 8192), 16, (int)(vo)[_i], (int)(kb), 0, 0); } while (0)
#define MZ_BLOAD(X, so0, so1, kt) do { const int _s0 = (int)((so0) + (unsigned)(kt) * ktb), _s1 = (int)((so1) + (unsigned)(kt) * ktb); _Pragma("unroll") for (int _i = 0; _i < 4; ++_i) { \
        X[0][_i] = __builtin_bit_cast(f32x4, __builtin_amdgcn_raw_buffer_load_b128(rB0, (int)bgo[_i], _s0, 0)); X[1][_i] = __builtin_bit_cast(f32x4, __builtin_amdgcn_raw_buffer_load_b128(rB1, (int)bgo[_i], _s1, 0)); } } while (0)
#define MZ_BWRITE(X, p) do { _Pragma("unroll") for (int _h = 0; _h < 2; ++_h) _Pragma("unroll") for (int _i = 0; _i < 4; ++_i) { v2u _w; _w.x = cvt_pk_bf16(X[_h][_i].x, X[_h][_i].y); _w.y = cvt_pk_bf16(X[_h][_i].z, X[_h][_i].w); \
        *(LAS v2u*)(lds + MZ_SB(p, _h) + bwoff + 4096 * _i) = _w; } } while (0)
#define MZ_TR(addr) __builtin_bit_cast(s16x4_t, __builtin_amdgcn_ds_read_tr16_b64_v4i16((LAS v4i16g_t*)(addr)))
#define MZ_LDB(dst, p, h) do { _Pragma("unroll") for (int n = 0; n < 2; ++n) _Pragma("unroll") for (int k = 0; k < 2; ++k) { \
        const s16x4_t _lo = MZ_TR(lds + MZ_SB(p, h) + trb[0][n] + 8192 * k), _hi = MZ_TR(lds + MZ_SB(p, h) + trb[1][n] + 8192 * k); \
        dst[n][k] = (bf16x8){_lo[0], _lo[1], _lo[2], _lo[3], _hi[0], _hi[1], _hi[2], _hi[3]}; } } while (0)
#define MZ_LDA(q) do { _Pragma("unroll") for (int m = 0; m < 4; ++m) _Pragma("unroll") for (int k = 0; k < 2; ++k) At[m][k] = *(const LAS bf16x8*)(lds + MZ_SA(q) + aoff + m * 2048 + k * 1024); } while (0)
#define MZ_MMA() do { __builtin_amdgcn_s_setprio(1); _Pragma("unroll") for (int m = 0; m < 4; ++m) _Pragma("unroll") for (int n = 0; n < 2; ++n) _Pragma("unroll") for (int k = 0; k < 2; ++k) { \
        acc[0][m][n] = __builtin_amdgcn_mfma_f32_16x16x32_bf16(B0[n][k], At[m][k], acc[0][m][n], 0, 0, 0); acc[1][m][n] = __builtin_amdgcn_mfma_f32_16x16x32_bf16(B1[n][k], At[m][k], acc[1][m][n], 0, 0, 0); } \
        __builtin_amdgcn_s_setprio(0); } while (0)
#define MZ_WAIT_V(n) asm volatile("s_waitcnt vmcnt(" #n ")" ::: "memory")
#define MZ_WAIT_L(n) asm volatile("s_waitcnt lgkmcnt(" #n ")" ::: "memory")
#define MZ_BAR __builtin_amdgcn_s_barrier()
#define MZ_SCHED __builtin_amdgcn_sched_barrier(0)
#define MZ_SETVO(vo, u) do { _Pragma("unroll") for (int _i = 0; _i < 2; ++_i) { const int _row = GATHER ? S.arow(u, Rv[_i]) : (u).arow0 + Rv[_i]; (vo)[_i] = (unsigned)(_row * K + Cv[_i]) * 2u; } } while (0)
#define MZ_SP(q, p, X, avo, akb, b0, b1, bkt) do { \
        MZ_LDA(q); MZ_LDB(B0, p, 0); MZ_LDB(B1, p, 1); MZ_SCHED; MZ_BWRITE(X, (p) ^ 1); MZ_STAGE_A(((q) + 2) & 3, avo, akb); MZ_BLOAD(X, b0, b1, bkt); \
        MZ_WAIT_V(18); MZ_WAIT_L(0); MZ_BAR; MZ_MMA(); MZ_BAR; MZ_SCHED; } while (0)
    Unit cur, nxt; int ui = 0;
    if (!S.next(0, cur)) return;
    unsigned voC[2], voN[2];
    MZ_SETVO(voC, cur);
    f32x4 acc[2][4][2];
#pragma unroll
    for (int b = 0; b < 2; ++b)
#pragma unroll
        for (int m = 0; m < 4; ++m)
#pragma unroll
            for (int n = 0; n < 2; ++n) acc[b][m][n] = (f32x4){0.f, 0.f, 0.f, 0.f};
    bf16x8 At[4][2], B0[2][2], B1[2][2];
    f32x4 P[2][4], Q[2][4];
    MZ_STAGE_A(0, voC, 0); MZ_STAGE_A(1, voC, 128);
    MZ_BLOAD(P, cur.B, cur.B1, 0); MZ_BWRITE(P, 0);
    MZ_WAIT_V(0); MZ_WAIT_L(0);
    if (wr == 1) MZ_BAR;
    MZ_BAR;
    MZ_BLOAD(P, cur.B, cur.B1, 1); MZ_BLOAD(Q, cur.B, cur.B1, 2);
    for (;;) {
        const bool has_next = S.next(ui + 1, nxt);
        const unsigned nB = has_next ? nxt.B : cur.B, nB1 = has_next ? nxt.B1 : cur.B1;
        if (has_next) { MZ_SETVO(voN, nxt); } else { voN[0] = voC[0]; voN[1] = voC[1]; }
        for (int t = 0; t < nt; t += 4) {
            const bool last = (t == nt - 4);
            MZ_SP(0, 0, P, voC, (unsigned)(t + 2) * 128u, cur.B, cur.B1, t + 3);
            { const unsigned b0 = last ? nB : cur.B, b1 = last ? nB1 : cur.B1; const int bkt = last ? 0 : t + 4;
              MZ_SP(1, 1, Q, voC, (unsigned)(t + 3) * 128u, b0, b1, bkt); }
            { const unsigned b0 = last ? nB : cur.B, b1 = last ? nB1 : cur.B1; const int bkt = last ? 1 : t + 5;
              unsigned av[2]; av[0] = last ? voN[0] : voC[0]; av[1] = last ? voN[1] : voC[1]; const unsigned akb = last ? 0u : (unsigned)(t + 4) * 128u;
              MZ_SP(2, 0, P, av, akb, b0, b1, bkt); }
            { const unsigned b0 = last ? nB : cur.B, b1 = last ? nB1 : cur.B1; const int bkt = last ? 2 : t + 6;
              unsigned av[2]; av[0] = last ? voN[0] : voC[0]; av[1] = last ? voN[1] : voC[1]; const unsigned akb = last ? 128u : (unsigned)(t + 5) * 128u;
              MZ_SP(3, 1, Q, av, akb, b0, b1, bkt); }
        }
        if (wr == 0) MZ_BAR;
        E(acc, cur, wr, wc, fr, fq);
        if (!has_next) break;
#pragma unroll
        for (int b = 0; b < 2; ++b)
#pragma unroll
            for (int m = 0; m < 4; ++m)
#pragma unroll
                for (int n = 0; n < 2; ++n) acc[b][m][n] = (f32x4){0.f, 0.f, 0.f, 0.f};
        cur = nxt; ++ui; voC[0] = voN[0]; voC[1] = voN[1];
        if (wr == 1) MZ_BAR;
    }
    MZ_WAIT_V(0);
    MZ_BAR;
#undef MZ_SB
#undef MZ_SA
#undef MZ_STAGE_A
#undef MZ_BLOAD
#undef MZ_BWRITE
#undef MZ_TR
#undef MZ_LDB
#undef MZ_LDA
#undef MZ_MMA
#undef MZ_WAIT_V
#undef MZ_WAIT_L
#undef MZ_BAR
#undef MZ_SCHED
#undef MZ_SETVO
#undef MZ_SP
}
}


namespace mw {
using pg8::lds_byte; using pg8::stage_rc; using pg8::Unit; using pg8::s16x4_t; using pg8::v4i16g_t;
template <class Epi, class Sched, bool GATHER>
__device__ __forceinline__ void gemm_w(LAS unsigned char* lds, const void* Amat, const unsigned Abytes, const int K, const Sched& S, const Epi& E) {
    const __amdgpu_buffer_rsrc_t rA = __builtin_amdgcn_make_buffer_rsrc((void*)Amat, 0, Abytes, 0x00020000);
    const __amdgpu_buffer_rsrc_t rB0 = __builtin_amdgcn_make_buffer_rsrc((void*)S.Wb0, 0, S.Wbytes, 0x00020000), rB1 = __builtin_amdgcn_make_buffer_rsrc((void*)S.Wb1, 0, S.Wbytes, 0x00020000);
    const int wid = S.wave, lane = lane_now(), tid = wid * 64 + lane, wr = wid >> 2, wc = wid & 3, fr = lane & 15, fq = lane >> 4;
    const int nt = K / 64;
    const unsigned ldwb = (unsigned)S.ldwb, ktb = 64u * ldwb, pstep = 16u * ldwb, hA = (unsigned)(128 * K * 2);
    int Rv[2], Cv[2]; unsigned al[2];
#pragma unroll
    for (int i = 0; i < 2; ++i) { stage_rc(tid * 16 + i * 8192, Rv[i], Cv[i]); al[i] = (unsigned)(Rv[i] * K + Cv[i]) * 2u; }
    const unsigned ldsw = (unsigned)wid * 1024u;
    const int aoff = lds_byte(wr * 64 + fr, fq * 8);
    const int bk0 = tid >> 5, bmm = tid & 31;
    const unsigned bwoff = (256u * bk0 + 16u * ((unsigned)(bmm >> 1) ^ ((((unsigned)bk0 & 3u) << 2) | (((unsigned)bk0 >> 2) & 3u)))) + 8u * (((unsigned)bmm & 1u) ^ (((unsigned)bk0 >> 3) & 1u));
    const unsigned bgoff = (unsigned)bk0 * ldwb + (unsigned)bmm * 16u;
    unsigned trb[2];
#pragma unroll
    for (int t = 0; t < 2; ++t) { const unsigned row = 8u * fq + 4u * t + ((unsigned)fr >> 2), ch = 4u * wc + ((unsigned)fr & 3u);
        trb[t] = 256u * row + 16u * (ch ^ (((row & 3u) << 2) | ((row >> 2) & 3u))) + 8u * ((unsigned)fq & 1u); }
    unsigned tra[2][2];
#pragma unroll
    for (int t = 0; t < 2; ++t)
#pragma unroll
        for (int n = 0; n < 2; ++n) tra[t][n] = (unsigned)(__SIZE_TYPE__)lds + (trb[t] ^ (8u * n));
#define MW_SB(b, h) (((b) * 2 + (h)) * 16384)
#define MW_SA(b, h) ((4 + (b) * 2 + (h)) * 16384)
#define MW_TRA(dst, a, off) asm volatile("ds_read_b64_tr_b16 %0, %1 offset:%2" : "=v"(dst) : "v"(a), "n"(off))
#define MW_LDB_A1(dst, b, h, n, k) do { v2u _lo, _hi; MW_TRA(_lo, tra[0][n], MW_SB(b, h) + 8192 * (k)); MW_TRA(_hi, tra[1][n], MW_SB(b, h) + 8192 * (k)); \
        dst[n][k] = __builtin_bit_cast(bf16x8, (v4u){_lo.x, _lo.y, _hi.x, _hi.y}); } while (0)
#define MW_LDB_A(dst, b, h) do { MW_LDB_A1(dst, b, h, 0, 0); MW_LDB_A1(dst, b, h, 0, 1); MW_LDB_A1(dst, b, h, 1, 0); MW_LDB_A1(dst, b, h, 1, 1); } while (0)
    const unsigned aad = (unsigned)(__SIZE_TYPE__)lds + 65536u + (unsigned)aoff;
#define MW_LDA_A1(b, h, m, k) asm volatile("ds_read_b128 %0, %1 offset:%2" : "=v"(At[m][k]) : "v"(aad), "n"(((b) * 2 + (h)) * 16384 + (m) * 2048 + (k) * 1024))
#define MW_LDA_A(b, h) do { MW_LDA_A1(b, h, 0, 0); MW_LDA_A1(b, h, 0, 1); MW_LDA_A1(b, h, 1, 0); MW_LDA_A1(b, h, 1, 1); MW_LDA_A1(b, h, 2, 0); MW_LDA_A1(b, h, 2, 1); MW_LDA_A1(b, h, 3, 0); MW_LDA_A1(b, h, 3, 1); } while (0)
#define MW_VO_voC(h, i) voC[h][i]
#define MW_VO_voN(h, i) voNt[(2 * (h) + (i)) * 512]
#define MW_STAGE_A(b, h, vo, uo, kb) do { _Pragma("unroll") for (int _i = 0; _i < 2; ++_i) { \
        if constexpr (GATHER) __builtin_amdgcn_raw_ptr_buffer_load_lds(rA, (LAS void*)(lds + MW_SA(b, h) + ldsw + _i * 8192), 16, (int)MW_VO_##vo(h, _i), (int)(kb), 0, 0); \
        else __builtin_amdgcn_raw_ptr_buffer_load_lds(rA, (LAS void*)(lds + MW_SA(b, h) + ldsw + _i * 8192), 16, (int)al[_i], (int)((uo) + (h) * hA + (kb)), 0, 0); } } while (0)
#define MW_BLOAD(X, h, so, kt) do { const unsigned _s = (so) + (unsigned)(kt) * ktb; _Pragma("unroll") for (int _i = 0; _i < 4; ++_i) \
        X[_i] = __builtin_bit_cast(f32x4, __builtin_amdgcn_raw_buffer_load_b128((h) ? rB1 : rB0, (int)bgoff, (int)(_s + (unsigned)_i * pstep), 0)); } while (0)
#define MW_BWRITE(X, b, h) do { _Pragma("unroll") for (int _i = 0; _i < 4; ++_i) { v2u _w; _w.x = cvt_pk_bf16(X[_i].x, X[_i].y); _w.y = cvt_pk_bf16(X[_i].z, X[_i].w); *(LAS v2u*)(lds + MW_SB(b, h) + bwoff + 4096 * _i) = _w; } } while (0)
#define MW_TR(addr) __builtin_bit_cast(s16x4_t, __builtin_amdgcn_ds_read_tr16_b64_v4i16((LAS v4i16g_t*)(addr)))
#define MW_LDB(b, h) do { _Pragma("unroll") for (int n = 0; n < 2; ++n) _Pragma("unroll") for (int k = 0; k < 2; ++k) { \
        const s16x4_t _lo = MW_TR(lds + MW_SB(b, h) + (trb[0] ^ (8u * n)) + 8192 * k), _hi = MW_TR(lds + MW_SB(b, h) + (trb[1] ^ (8u * n)) + 8192 * k); \
        B0[n][k] = (bf16x8){_lo[0], _lo[1], _lo[2], _lo[3], _hi[0], _hi[1], _hi[2], _hi[3]}; } } while (0)
#define MW_LDA(b, h) do { _Pragma("unroll") for (int m = 0; m < 4; ++m) _Pragma("unroll") for (int k = 0; k < 2; ++k) At[m][k] = *(const LAS bf16x8*)(lds + MW_SA(b, h) + aoff + m * 2048 + k * 1024); } while (0)
#define MW_MMA(ai, bj, Bf) do { __builtin_amdgcn_s_setprio(1); _Pragma("unroll") for (int k = 0; k < 2; ++k) _Pragma("unroll") for (int m = 0; m < 4; ++m) _Pragma("unroll") for (int n = 0; n < 2; ++n)   \
        asm volatile("v_mfma_f32_16x16x32_bf16 %0, %1, %2, %0" : "+v"(acc[ai][bj][m][n]) : "v"(Bf[n][k]), "v"(At[m][k]));   \
        __builtin_amdgcn_s_setprio(0); } while (0)
#define MW_WAIT_V(n) asm volatile("s_waitcnt vmcnt(" #n ")" ::: "memory")
#define MW_WAIT_L(n) asm volatile("s_waitcnt lgkmcnt(" #n ")" ::: "memory")
#define MW_BAR __builtin_amdgcn_s_barrier()
#define MW_SCHED __builtin_amdgcn_sched_barrier(0)
#define MW_SETVO(vo, u) do { if constexpr (GATHER) { const int _t = wid * 64 + lane_now();   \
        _Pragma("unroll") for (int _i = 0; _i < 2; ++_i) { int _R, _C; stage_rc(_t * 16 + _i * 8192, _R, _C); _Pragma("unroll") for (int _h = 0; _h < 2; ++_h) { \
        const int _row = S.arow(u, _h * 128 + _R); MW_VO_##vo(_h, _i) = (unsigned)(_row * K + _C) * 2u; } } } } while (0)
#define MW_SP(rb, ai, X, wb, wh, sb, sh, svo, suo, skb, lh, lso, lkt) do { \
        MW_LDB_A(B0, rb, 0); MW_LDB_A(B1, rb, 1); MW_SCHED; MW_LDA_A(rb, ai); MW_BWRITE(X, wb, wh); MW_STAGE_A(sb, sh, svo, suo, skb); \
        MW_WAIT_L(0); MW_BAR; MW_MMA(ai, 0, B0); MW_MMA(ai, 1, B1); MW_SCHED; MW_BLOAD(X, lh, lso, lkt); MW_SCHED; MW_BAR; MW_SCHED; } while (0)
#define MW_SPP(rb, ai, X, wb, wh, sb, sh, svo, suo, skb, lh, lso, lkt, ps, pb) do { \
        MW_LDB_A(B0, rb, 0); MW_LDB_A(B1, rb, 1); MW_SCHED; MW_LDA_A(rb, ai); MW_BWRITE(X, wb, wh); if (ps) { MW_STAGE_A(sb, sh, svo, suo, skb); } \
        MW_WAIT_L(0); MW_BAR; MW_MMA(ai, 0, B0); MW_MMA(ai, 1, B1); MW_SCHED; if (pb) { MW_BLOAD(X, lh, lso, lkt); } MW_SCHED; MW_BAR; MW_SCHED; } while (0)
    Unit cur, nxt; int ui = 0;
    if (!S.next(0, cur)) return;
    unsigned voC[2][2];
    LAS unsigned* const voNt = (LAS unsigned*)(lds + 131072 + 2048) + tid;
    MW_SETVO(voC, cur);
    if (wid == 0) E.prefetch(cur, lds + 131072 + 10240);
    f32x4 acc[2][2][4][2];
#pragma unroll
    for (int a = 0; a < 2; ++a)
#pragma unroll
        for (int b = 0; b < 2; ++b)
#pragma unroll
            for (int m = 0; m < 4; ++m)
#pragma unroll
                for (int n = 0; n < 2; ++n) acc[a][b][m][n] = (f32x4){0.f, 0.f, 0.f, 0.f};
    bf16x8 At[4][2], B0[2][2], B1[2][2];
    f32x4 X[4], Y[4];
    unsigned cU = (unsigned)cur.arow0 * (unsigned)(K * 2);
    MW_STAGE_A(0, 0, voC, cU, 0u); MW_STAGE_A(0, 1, voC, cU, 0u);
    MW_BLOAD(X, 0, cur.B, 0); MW_BWRITE(X, 0, 0); MW_BLOAD(Y, 1, cur.B1, 0); MW_BWRITE(Y, 0, 1);
    MW_WAIT_V(0); MW_WAIT_L(0);
    if (wr == 1) MW_BAR;
    MW_BAR;
    MW_STAGE_A(1, 0, voC, cU, 128u); MW_BLOAD(X, 0, cur.B, 1); MW_BLOAD(Y, 1, cur.B1, 1);
    MW_BAR;
    for (;;) {
        const bool has_next = S.next(ui + 1, nxt);
        const unsigned nB = has_next ? nxt.B : cur.B, nB1 = has_next ? nxt.B1 : cur.B1, nU = has_next ? (unsigned)nxt.arow0 * (unsigned)(K * 2) : cU;
        if constexpr (GATHER) { if (has_next) { MW_SETVO(voN, nxt); } else {
#pragma unroll
            for (int h = 0; h < 2; ++h)
#pragma unroll
                for (int i = 0; i < 2; ++i) MW_VO_voN(h, i) = voC[h][i]; } }
        for (int t = 0; t < nt - 2; t += 2) {
            MW_SP(0, 0, X, 1, 0, 1, 1, voC, cU, (unsigned)(t + 1) * 128u, 0, cur.B, t + 2);
            MW_SP(0, 1, Y, 1, 1, 0, 0, voC, cU, (unsigned)(t + 2) * 128u, 1, cur.B1, t + 2);
            MW_SP(1, 0, X, 0, 0, 0, 1, voC, cU, (unsigned)(t + 2) * 128u, 0, cur.B, t + 3);
            MW_SP(1, 1, Y, 0, 1, 1, 0, voC, cU, (unsigned)(t + 3) * 128u, 1, cur.B1, t + 3);
        }
        {
            const int t = nt - 2;
            const bool la = GATHER || has_next;
            MW_SPP(0, 0, X, 1, 0, 1, 1, voC, cU, (unsigned)(t + 1) * 128u, 0, nB, 0, true, la);
            MW_SPP(0, 1, Y, 1, 1, 0, 0, voN, nU, 0u, 1, nB1, 0, la, la);
            MW_SPP(1, 0, X, 0, 0, 0, 1, voN, nU, 0u, 0, nB, 1, la, la);
            MW_SPP(1, 1, Y, 0, 1, 1, 0, voN, nU, 128u, 1, nB1, 1, la, la);
        }
        asm volatile("s_nop 15\n\ts_nop 7" ::: "memory");
        if (wr == 0) MW_BAR;
        E(acc, cur, wr, wc, fr, fq, lds + 131072 + 10240 + 2048 * (ui & 1));
        if (!has_next) break;
        if (wid == 0) E.prefetch(nxt, lds + 131072 + 10240 + 2048 * ((ui + 1) & 1));
#pragma unroll
        for (int a = 0; a < 2; ++a)
#pragma unroll
            for (int b = 0; b < 2; ++b)
#pragma unroll
                for (int m = 0; m < 4; ++m)
#pragma unroll
                    for (int n = 0; n < 2; ++n) acc[a][b][m][n] = (f32x4){0.f, 0.f, 0.f, 0.f};
        cur = nxt; cU = nU; ++ui;
        if constexpr (GATHER) {
#pragma unroll
            for (int h = 0; h < 2; ++h)
#pragma unroll
                for (int i = 0; i < 2; ++i) voC[h][i] = MW_VO_voN(h, i); }
        if (wr == 1) MW_BAR;
    }
    MW_WAIT_V(0);
    MW_BAR;
#undef MW_SB
#undef MW_SA
#undef MW_STAGE_A
#undef MW_BLOAD
#undef MW_BWRITE
#undef MW_TR
#undef MW_TRA
#undef MW_LDB_A1
#undef MW_LDB_A
#undef MW_LDA_A1
#undef MW_LDA_A
#undef MW_LDB
#undef MW_LDA
#undef MW_MMA
#undef MW_WAIT_V
#undef MW_WAIT_L
#undef MW_BAR
#undef MW_SCHED
#undef MW_SETVO
#undef MW_VO_voC
#undef MW_VO_voN
#undef MW_SP
#undef MW_SPP
}
}

#define XB_TMO      128
#define XB_XCNT(j)  (256  + 64 * (j))
#define XB_XSUB(j)  (1280 + 64 * (j))
#define XB_XGEN(j)  (2304 + 64 * (j))
#define XB_TOP      3328
#define XB_TOPGEN   3392
#define XCD_BAR_WORDS 3456
#define XB_SPIN_CAP (1u << 18)
__device__ __forceinline__ unsigned xb_ld(unsigned* p)              { return __hip_atomic_load(p, __ATOMIC_RELAXED, __HIP_MEMORY_SCOPE_AGENT); }
__device__ __forceinline__ unsigned xb_add(unsigned* p, unsigned v) { return __hip_atomic_fetch_add(p, v, __ATOMIC_RELAXED, __HIP_MEMORY_SCOPE_AGENT); }
__device__ __forceinline__ unsigned xb_xcc_id() { return (unsigned)__builtin_amdgcn_s_getreg((3 << 11) | 20) & 0xFu; }
#define XB_SPIN(cond, bar) do { unsigned _sp = 0; while (cond) { __builtin_amdgcn_s_sleep(1); \
    if ((++_sp & 255u) == 0u) { if (xb_ld(&(bar)[XB_TMO])) break; if (_sp > XB_SPIN_CAP) { atomicAdd(&(bar)[XB_TMO], 1u); break; } } } } while (0)
struct XcdBarrier { unsigned* bar; unsigned x; volatile LAS unsigned* st; };
__device__ __forceinline__ XcdBarrier xcd_barrier_post(unsigned* bar, volatile LAS unsigned* st) {
    XcdBarrier b; b.bar = bar; b.x = xb_xcc_id(); b.st = st;
    if (threadIdx.x == 0) (void)xb_add(&bar[XB_XCNT(b.x)], 1u);
    return b;
}
__device__ __forceinline__ void xcd_barrier_complete(unsigned* bar, unsigned x, unsigned& nloc, unsigned& nx) {
    const unsigned G = gridDim.x * gridDim.y * gridDim.z;
    unsigned sum, cnt, mine, sp = 0u;
    for (;;) {
        sum = 0u; cnt = 0u; mine = 0u;
#pragma unroll
        for (unsigned j = 0; j < 16; ++j) { const unsigned c = xb_ld(&bar[XB_XCNT(j)]); sum += c; cnt += (c > 0u) ? 1u : 0u; mine = (j == x) ? c : mine; }
        if (sum == G) break;
        __builtin_amdgcn_s_sleep(1);
        if ((++sp & 255u) == 0u) { if (xb_ld(&bar[XB_TMO])) break; if (sp > XB_SPIN_CAP) { atomicAdd(&bar[XB_TMO], 1u); break; } }
    }
    nloc = mine > 0u ? mine : 1u; nx = cnt > 0u ? cnt : 1u;
}
__device__ __forceinline__ void xcd_barrier(const XcdBarrier& b) {
    asm volatile("s_waitcnt vmcnt(0)" ::: "memory");
    __syncthreads();
    if (threadIdx.x == 0) {
        unsigned* bar = b.bar;
        __builtin_amdgcn_s_waitcnt(0);
        unsigned nloc = b.st[0], nx = b.st[1];
        if (nloc == 0u) { xcd_barrier_complete(bar, b.x, nloc, nx); b.st[0] = nloc; b.st[1] = nx; }
        const unsigned old = xb_add(&bar[XB_XSUB(b.x)], 1u);
        const unsigned gen = old / nloc;
        if (old + 1u == (gen + 1u) * nloc) {
            __builtin_amdgcn_fence(__ATOMIC_RELEASE, "agent");
            asm volatile("s_waitcnt vmcnt(0)" ::: "memory");
            const unsigned og = xb_add(&bar[XB_TOP], 1u);
            const unsigned tg = og / nx;
            if (og + 1u != (tg + 1u) * nx) XB_SPIN(xb_ld(&bar[XB_TOP]) < (tg + 1u) * nx, bar);
            __builtin_amdgcn_fence(__ATOMIC_ACQUIRE, "agent");
            xb_add(&bar[XB_XGEN(b.x)], 1u);
            asm volatile("s_waitcnt vmcnt(0)" ::: "memory");
        } else {
            XB_SPIN(xb_ld(&bar[XB_XGEN(b.x)]) == gen, bar);
            __builtin_amdgcn_fence(__ATOMIC_ACQUIRE, "agent");
            asm volatile("s_waitcnt vmcnt(0)" ::: "memory");
        }
    }
    __syncthreads();
}

__device__ __forceinline__ void wave_arrive(volatile LAS unsigned* wcnt, unsigned* xcnt, unsigned nloc, unsigned* top) {
    asm volatile("s_waitcnt vmcnt(0)" ::: "memory");
    if (lane_now() == 0) {
        const unsigned o = __hip_atomic_fetch_add((LAS unsigned*)wcnt, 1u, __ATOMIC_RELAXED, __HIP_MEMORY_SCOPE_WORKGROUP);
        if (o == (unsigned)NWAVES - 1u) {
            *wcnt = 0u;
            const unsigned old = xb_add(xcnt, 1u);
            if (old + 1u == nloc) {
                __builtin_amdgcn_fence(__ATOMIC_RELEASE, "agent");
                asm volatile("s_waitcnt vmcnt(0)" ::: "memory");
                (void)xb_add(top, nloc);
            }
        }
    }
}
__device__ __forceinline__ void wg_wait_count(unsigned* ctr, unsigned target, unsigned* bar) {
    if (threadIdx.x == 0) {
        XB_SPIN(xb_ld(ctr) < target, bar);
        __builtin_amdgcn_fence(__ATOMIC_ACQUIRE, "agent");
        asm volatile("s_waitcnt vmcnt(0)" ::: "memory");
    }
    __syncthreads();
}

struct Frame {
    LAS unsigned char* lds; volatile LAS unsigned* MISC; gu32* ctl;
    int tid, lane, wave, vcu, G;
    const float *x, *norm1_w, *w_in, *gn_w, *conv_w, *w_o, *norm2_w, *rg_w, *rg_b, *re_w, *re_b, *w_gate, *w_up, *w_down, *fin_w;
    float* out; unsigned char* ws;
};
__device__ __forceinline__ float wave_sum(float v) {
#pragma unroll
    for (int o = 1; o < 64; o <<= 1) v += __shfl_xor(v, o);
    return v;
}

__device__ __forceinline__ int win_srccol(int c) {
    const int tile = c >> 8, bj = (c >> 7) & 1, p = c & 127;
    if (tile < 4) { const int head = (tile & 1) * 2 + bj; const int orig = 4 * (p >> 3) + (p & 3) + 64 * ((p >> 2) & 1); return (tile >> 1) * RW + head * HD + orig; }
    if (tile < 10) return 1024 + (c - 1024);
    const int t = tile - 10; return (bj ? 3072 : 2560) + 128 * t + p;
}
__device__ __forceinline__ void p0_transpose_item(const float* W, int ldw, int srccol, bf16* WT0, int Kd, int k0, const float* scale, LAS float* scr, int lane) {
    const int dn = 4 * (lane & 7), kr = lane >> 3;
    f32x4 v[8];
#pragma unroll
    for (int i = 0; i < 8; ++i) v[i] = *(const GAS f32x4*)(W + (size_t)(k0 + 8 * i + kr) * ldw + srccol);
#pragma unroll
    for (int i = 0; i < 8; ++i) { LAS float* s = scr + (8 * i + kr) * 33 + dn; s[0] = v[i].x; s[1] = v[i].y; s[2] = v[i].z; s[3] = v[i].w; }
    LDS_WAIT(); asm volatile("" ::: "memory");
    const int c = lane & 7;
    f32x4 s0 = (f32x4){1.f, 1.f, 1.f, 1.f}, s1 = s0;
    if (scale) { s0 = *(const GAS f32x4*)(scale + k0 + 8 * c); s1 = *(const GAS f32x4*)(scale + k0 + 8 * c + 4); }
#pragma unroll
    for (int j = 0; j < 4; ++j) { const int n = (lane >> 3) + 8 * j; const LAS float* s = scr + (8 * c) * 33 + n;
        v4u o; o.x = pk2(s[0 * 33] * s0.x, s[1 * 33] * s0.y); o.y = pk2(s[2 * 33] * s0.z, s[3 * 33] * s0.w); o.z = pk2(s[4 * 33] * s1.x, s[5 * 33] * s1.y); o.w = pk2(s[6 * 33] * s1.z, s[7 * 33] * s1.w);
        *(GAS v4u*)(WT0 + (size_t)n * Kd + k0 + 8 * c) = o; }
    LDS_WAIT(); asm volatile("" ::: "memory");
}
__device__ __forceinline__ void p0_item_load(f32x4 (&v)[8], const float* W, int ldw, int srccol, int k0, int lane) {
    const int kr = lane >> 3;
#pragma unroll
    for (int i = 0; i < 8; ++i) v[i] = *(const GAS f32x4*)(W + (size_t)(k0 + 8 * i + kr) * ldw + srccol);
}
__device__ __forceinline__ void p0_item_finish(const f32x4 (&v)[8], bf16* WT0, int Kd, int k0, LAS float* scr, int lane) {
    const int dn = 4 * (lane & 7), kr = lane >> 3;
#pragma unroll
    for (int i = 0; i < 8; ++i) { LAS float* sp = scr + (8 * i + kr) * 33 + dn; sp[0] = v[i].x; sp[1] = v[i].y; sp[2] = v[i].z; sp[3] = v[i].w; }
    LDS_WAIT(); asm volatile("" ::: "memory");
    const int c = lane & 7;
#pragma unroll
    for (int j = 0; j < 4; ++j) { const int n = (lane >> 3) + 8 * j; const LAS float* sp = scr + (8 * c) * 33 + n;
        v4u o; o.x = pk2(sp[0 * 33], sp[1 * 33]); o.y = pk2(sp[2 * 33], sp[3 * 33]); o.z = pk2(sp[4 * 33], sp[5 * 33]); o.w = pk2(sp[6 * 33], sp[7 * 33]);
        *(GAS v4u*)(WT0 + (size_t)n * Kd + k0 + 8 * c) = o; }
    LDS_WAIT(); asm volatile("" ::: "memory");
}
__device__ __forceinline__ void rms_row_to_bf16(const float* xrow, const float* w, bf16* orow, int lane) {
    const GAS f32x4* xr = (const GAS f32x4*)xrow + lane;
    f32x4 v[4]; float s = 0.f;
#pragma unroll
    for (int j = 0; j < 4; ++j) { v[j] = xr[64 * j]; s += (v[j].x * v[j].x + v[j].y * v[j].y) + (v[j].z * v[j].z + v[j].w * v[j].w); }
    const float rs = 1.f / sqrtf(wave_sum(s) * (1.f / D) + EPS);
    GAS unsigned long long* o8 = (GAS unsigned long long*)orow + lane;
#pragma unroll
    for (int j = 0; j < 4; ++j) { const f32x4 ww = ((const GAS f32x4*)w)[lane + 64 * j];
        o8[64 * j] = (unsigned long long)pk2(v[j].x * rs * ww.x, v[j].y * rs * ww.y) | ((unsigned long long)pk2(v[j].z * rs * ww.z, v[j].w * rs * ww.w) << 32); }
}
__device__ __forceinline__ void rms_row2_to_bf16(const float* x0, const float* x1, const float* w, bf16* o0, bf16* o1, int lane) {
    const GAS f32x4* xr0 = (const GAS f32x4*)x0 + lane; const GAS f32x4* xr1 = (const GAS f32x4*)x1 + lane;
    f32x4 v0[4], v1[4]; float s0 = 0.f, s1 = 0.f;
#pragma unroll
    for (int j = 0; j < 4; ++j) v0[j] = xr0[64 * j];
#pragma unroll
    for (int j = 0; j < 4; ++j) v1[j] = xr1[64 * j];
#pragma unroll
    for (int j = 0; j < 4; ++j) { s0 += (v0[j].x * v0[j].x + v0[j].y * v0[j].y) + (v0[j].z * v0[j].z + v0[j].w * v0[j].w); s1 += (v1[j].x * v1[j].x + v1[j].y * v1[j].y) + (v1[j].z * v1[j].z + v1[j].w * v1[j].w); }
    const float r0 = 1.f / sqrtf(wave_sum(s0) * (1.f / D) + EPS), r1 = 1.f / sqrtf(wave_sum(s1) * (1.f / D) + EPS);
    GAS unsigned long long* p0 = (GAS unsigned long long*)o0 + lane; GAS unsigned long long* p1 = (GAS unsigned long long*)o1 + lane;
#pragma unroll
    for (int j = 0; j < 4; ++j) { const f32x4 ww = ((const GAS f32x4*)w)[lane + 64 * j];
        p0[64 * j] = (unsigned long long)pk2(v0[j].x * r0 * ww.x, v0[j].y * r0 * ww.y) | ((unsigned long long)pk2(v0[j].z * r0 * ww.z, v0[j].w * r0 * ww.w) << 32);
        p1[64 * j] = (unsigned long long)pk2(v1[j].x * r1 * ww.x, v1[j].y * r1 * ww.y) | ((unsigned long long)pk2(v1[j].z * r1 * ww.z, v1[j].w * r1 * ww.w) << 32); }
}
__device__ __forceinline__ void p0_prologue(Frame& F) {
    LAS float* scr = (LAS float*)(F.lds + RING_OFF + F.wave * 16384);
    const int gw = F.vcu * NWAVES + F.wave, NGW = F.G * NWAVES, lane = F.lane;
    bf16* WinT = (bf16*)(F.ws + WS_WINT); bf16* WoT = (bf16*)(F.ws + WS_WOT);
    constexpr int I_IN = (D / 64) * (INC / 32), I_O = (D / 64) * (D / 32);
    constexpr int NITEMS = I_IN + I_O;
    static_assert(NITEMS <= 2 * 2048, "at most two transpose items per wave at 256 workgroups");
    for (int it0 = gw; it0 < NITEMS; it0 += 2 * NGW) {
        f32x4 va[8], vb[8];
        const int it1 = it0 + NGW; const bool h1 = it1 < NITEMS;
        const float* Wa; int lda, sca, ka; bf16* Ta; const float* Wb; int ldb, scb, kb2; bf16* Tb;
        { const int r = it0; if (r < I_IN) { const int nb = r % (INC / 32), kb = r / (INC / 32), n0 = 32 * nb; Wa = F.w_in; lda = INC; sca = win_srccol(n0 + 4 * (lane & 7)); Ta = WinT + (size_t)n0 * D; ka = 64 * kb; }
          else { const int q = r - I_IN, nb = q % (D / 32), kb = q / (D / 32), n0 = 32 * nb; Wa = F.w_o; lda = D; sca = n0 + 4 * (lane & 7); Ta = WoT + (size_t)n0 * D; ka = 64 * kb; } }
        { const int r = h1 ? it1 : it0; if (r < I_IN) { const int nb = r % (INC / 32), kb = r / (INC / 32), n0 = 32 * nb; Wb = F.w_in; ldb = INC; scb = win_srccol(n0 + 4 * (lane & 7)); Tb = WinT + (size_t)n0 * D; kb2 = 64 * kb; }
          else { const int q = r - I_IN, nb = q % (D / 32), kb = q / (D / 32), n0 = 32 * nb; Wb = F.w_o; ldb = D; scb = n0 + 4 * (lane & 7); Tb = WoT + (size_t)n0 * D; kb2 = 64 * kb; } }
        p0_item_load(va, Wa, lda, sca, ka, lane);
        if (h1) p0_item_load(vb, Wb, ldb, scb, kb2, lane);
        p0_item_finish(va, Ta, D, ka, scr, lane);
        if (h1) p0_item_finish(vb, Tb, D, kb2, scr, lane);
    }
    { bf16* WrT = (bf16*)(F.ws + WS_WRT);
      for (int idx = F.vcu * 512 + F.tid; idx < 128 * D; idx += F.G * 512) {
          const int n = idx >> 10, k = idx & 1023; float v = 0.f;
          if (n < 8) v = F.rg_w[k * NG + n];
          else if (n < 72) { const int gg = (n - 8) >> 3, ee = (n - 8) & 7; v = F.re_w[((size_t)gg * D + k) * EPG + ee]; }
          WrT[idx] = (bf16)f2bf(v); } }
    bf16* XN = (bf16*)(F.ws + WS_XN);
    static_assert(M % 2 == 0, "row pairs");
    for (int m = gw; m < M / 2; m += NGW) rms_row2_to_bf16(F.x + (size_t)m * D, F.x + (size_t)(m + M / 2) * D, F.norm1_w, XN + (size_t)m * D, XN + (size_t)(m + M / 2) * D, lane);
    float* rc = (float*)(F.ws + WS_ROPE); float* rsn = rc + SEQ * 64;
    for (int idx = F.vcu * 512 + F.tid; idx < SEQ * 64; idx += F.G * 512) {
        const int i = idx & 63, pos = idx >> 6;
        const float inv = (float)exp2(-(double)i * (13.287712379549449 / 64.0));
        const float ang = (float)pos * inv;
        const double rev = (double)ang * 0.15915494309189535;
        const float fr = (float)(rev - floor(rev));
        rc[idx] = __builtin_amdgcn_cosf(fr); rsn[idx] = __builtin_amdgcn_sinf(fr);
    }
}

struct InProjSched {
    int c, G; const void* Wb0; const void* Wb1; unsigned Wbytes; int r0, r1;
    __device__ __forceinline__ bool next(int ii, pg8::Unit& u) const {
        constexpr int nM = M / 256, nN = INC / 256, nwg = nM * nN;
        const int i = r0 + ii; if (i >= r1) return false;
        const int L = i * G + c; if (L >= nwg) return false;
        int wgid = L; { const int q = nwg / 8, r = nwg % 8, xcd = wgid % 8, off = wgid / 8; wgid = (xcd < r ? xcd * (q + 1) : r * (q + 1) + (xcd - r) * q) + off; }
        const int nig = 8 * nN, gid = wgid / nig, fm = gid * 8;
        u.pm = fm + ((wgid % nig) % 8); u.pn = (wgid % nig) / 8; u.arow0 = u.pm * 256; u.e = i; u.rb = 0; u.nvalid = 256;
        u.B = (unsigned)u.pn * (256u * D * 2u); u.B1 = u.B; return true;
    }
    __device__ __forceinline__ int arow(const pg8::Unit&, int) const { return 0; }
};
struct EpiInProj {
    static constexpr bool PERM = true;
    bf16* base; const float *rc, *rs; unsigned *xc1, *top1; volatile LAS unsigned* misc;
    __device__ __forceinline__ void operator()(const f32x4 (&acc)[2][2][4][2], const pg8::Unit& u, int wr, int wc, int fr, int fq) const {
        const int row0 = u.pm * 256 + wr * 64 + fr; const int pn = u.pn;
        if (pn < 4) {
            bf16* dst = base + (size_t)(pn >> 1) * (8u << 20); const float sc = (pn < 2) ? 0.08838834764831845f : 1.0f;
            const int i0 = 4 * (4 * wc + fq);
#pragma unroll
            for (int ai = 0; ai < 2; ++ai)
#pragma unroll
                for (int m = 0; m < 4; ++m) { const int r = row0 + ai * 128 + m * 16; const int pos = r & (SEQ - 1);
                    const f32x4 cs = *(const f32x4*)(rc + pos * 64 + i0), sn = *(const f32x4*)(rs + pos * 64 + i0);
#pragma unroll
                    for (int bj = 0; bj < 2; ++bj) { const f32x4 x1 = acc[ai][bj][m][0], x2 = acc[ai][bj][m][1];
                        const f32x4 o1 = (x1 * cs - x2 * sn) * sc, o2 = (x2 * cs + x1 * sn) * sc;
                        v4u w; w.x = cvt_pk_bf16(o1[0], o1[1]); w.y = cvt_pk_bf16(o1[2], o1[3]); w.z = cvt_pk_bf16(o2[0], o2[1]); w.w = cvt_pk_bf16(o2[2], o2[3]);
                        *(v4u*)(dst + (size_t)r * RW + ((pn & 1) * 2 + bj) * HD + wc * 32 + 8 * fq) = w; } }
        } else if (pn < 10) {
            bf16* dst = base + (size_t)(pn >> 1) * (8u << 20);
#pragma unroll
            for (int ai = 0; ai < 2; ++ai)
#pragma unroll
                for (int m = 0; m < 4; ++m) { const int r = row0 + ai * 128 + m * 16;
#pragma unroll
                    for (int bj = 0; bj < 2; ++bj) { const f32x4 v0 = acc[ai][bj][m][0], v1 = acc[ai][bj][m][1];
                        v4u w; w.x = cvt_pk_bf16(v0[0], v0[1]); w.y = cvt_pk_bf16(v0[2], v0[3]); w.z = cvt_pk_bf16(v1[0], v1[1]); w.w = cvt_pk_bf16(v1[2], v1[3]);
                        *(v4u*)(dst + (size_t)r * RW + (pn & 1) * 256 + bj * 128 + wc * 32 + 8 * fq) = w; } }
        } else {
            const int t = pn - 10; bf16* cub = base + (size_t)5 * (8u << 20);
#pragma unroll
            for (int ai = 0; ai < 2; ++ai)
#pragma unroll
                for (int m = 0; m < 4; ++m) { const int r = row0 + ai * 128 + m * 16;
                    const f32x4 v0 = acc[ai][0][m][0] * acc[ai][1][m][0], v1 = acc[ai][0][m][1] * acc[ai][1][m][1];
                    v4u w; w.x = cvt_pk_bf16(v0[0], v0[1]); w.y = cvt_pk_bf16(v0[2], v0[3]); w.z = cvt_pk_bf16(v1[0], v1[1]); w.w = cvt_pk_bf16(v1[2], v1[3]);
                    *(v4u*)(cub + (size_t)r * RW + t * 128 + wc * 32 + 8 * fq) = w; }
        }
        if (u.e == 1) wave_arrive(misc + 12, xc1, misc[8], top1);
    }
};


typedef short s16x4 __attribute__((ext_vector_type(4)));
typedef short v4i16_t __attribute__((ext_vector_type(4)));
__device__ __forceinline__ unsigned offb(unsigned row, unsigned ch) { return 256u * row + 16u * (ch ^ (((row & 3u) << 2) | ((row >> 2) & 3u))); }
__device__ __forceinline__ bf16x8 tr_frag(const LAS unsigned char* img, int lane, int c, int ks) {
    const unsigned g = lane >> 4, q = (lane & 15) >> 2, p = lane & 3;
    const unsigned a0 = offb(32 * ks + 8 * g + q, 2 * c + (p >> 1)) + 8 * (p & 1), a1 = offb(32 * ks + 8 * g + 4 + q, 2 * c + (p >> 1)) + 8 * (p & 1);
    const s16x4 lo = __builtin_bit_cast(s16x4, __builtin_amdgcn_ds_read_tr16_b64_v4i16((LAS v4i16_t*)(img + a0)));
    const s16x4 hi = __builtin_bit_cast(s16x4, __builtin_amdgcn_ds_read_tr16_b64_v4i16((LAS v4i16_t*)(img + a1)));
    return (bf16x8){lo[0], lo[1], lo[2], lo[3], hi[0], hi[1], hi[2], hi[3]};
}
__device__ __forceinline__ bf16x8 row_frag(const LAS unsigned char* img, int lane, int rb, int s) { return *(const LAS bf16x8*)(img + offb((lane & 15) + 16 * rb, 4 * s + (lane >> 4))); }
__device__ __forceinline__ float lg2_gamma(int h) { return log2f(1.0f - exp2f(-5.0f - (float)h)); }
__device__ __forceinline__ float silu_f(float g) { return g * __builtin_amdgcn_rcpf(1.0f + __expf(-g)); }

__device__ __forceinline__ void tile_load(v4u (&r)[4], const bf16* base, size_t row_stride, int tid) {
#pragma unroll
    for (int i = 0; i < 4; ++i) { const int id = tid + 512 * i, row = id >> 4, ch = id & 15; r[i] = *(const GAS v4u*)(base + (size_t)row * row_stride + 8 * ch); }
}
template <bool KSCALE>
__device__ __forceinline__ void tile_write(const v4u (&r)[4], LAS unsigned char* img, int tid, float lg2) {
#pragma unroll
    for (int i = 0; i < 4; ++i) { const int id = tid + 512 * i, row = id >> 4, ch = id & 15; v4u kv = r[i];
        if (KSCALE) { const float kd = exp2f((float)(CH - 1 - row) * lg2);
            kv.x = cvt_pk_bf16(bflo(kv.x) * kd, bfhi(kv.x) * kd); kv.y = cvt_pk_bf16(bflo(kv.y) * kd, bfhi(kv.y) * kd); kv.z = cvt_pk_bf16(bflo(kv.z) * kd, bfhi(kv.z) * kd); kv.w = cvt_pk_bf16(bflo(kv.w) * kd, bfhi(kv.w) * kd); }
        *(LAS v4u*)(img + offb(row, ch)) = kv; }
}
__device__ __forceinline__ void p2_kv_phase(Frame& F, const int u0, const int ustride) {
    bf16* KVT = (bf16*)(F.ws + WS_KVT);
    const bf16* kb = (const bf16*)(F.ws + WS_KB); const bf16* vb = (const bf16*)(F.ws + WS_VB);
    LAS unsigned char* Kimg = F.lds; LAS unsigned char* Vimg = F.lds + 32768;
    const int lane = F.lane, w = F.wave, g = lane >> 4, fr = lane & 15, tid = F.tid;
    LAS unsigned char* stg = F.lds + 65536 + 4608 * w;
    v4u rk[4], rv[4];
    int u = u0;
    if (u < NB * NCH * NH) { const int h = u & 3, n = (u >> 2) & 31, b = u >> 7; const size_t row0 = (size_t)b * SEQ + (size_t)n * CH;
        tile_load(rk, kb + row0 * RW + h * HD, RW, tid); tile_load(rv, vb + row0 * RW + h * HD, RW, tid); }
    for (; u < NB * NCH * NH; u += ustride) {
        const int h = u & 3;
        tile_write<true>(rk, Kimg, tid, lg2_gamma(h)); tile_write<false>(rv, Vimg, tid, 0.f);
        __syncthreads();
        { const int u2 = u + ustride; if (u2 < NB * NCH * NH) { const int h2 = u2 & 3, n2 = (u2 >> 2) & 31, b2 = u2 >> 7; const size_t r2 = (size_t)b2 * SEQ + (size_t)n2 * CH;
            tile_load(rk, kb + r2 * RW + h2 * HD, RW, tid); tile_load(rv, vb + r2 * RW + h2 * HD, RW, tid); } }
        bf16x8 af[4];
#pragma unroll
        for (int ks = 0; ks < 4; ++ks) af[ks] = tr_frag(Vimg, lane, w, ks);
#pragma unroll
        for (int cd0 = 0; cd0 < 8; cd0 += 4) {
            f32x4 acc[4];
#pragma unroll
            for (int q = 0; q < 4; ++q) acc[q] = (f32x4){0.f, 0.f, 0.f, 0.f};
#pragma unroll
            for (int ks = 0; ks < 4; ++ks)
#pragma unroll
                for (int q = 0; q < 4; ++q) acc[q] = __builtin_amdgcn_mfma_f32_16x16x32_bf16(tr_frag(Kimg, lane, cd0 + q, ks), af[ks], acc[q], 0, 0, 0);
#pragma unroll
            for (int q = 0; q < 4; ++q) { v2u pw; pw.x = pk2(acc[q][0], acc[q][1]); pw.y = pk2(acc[q][2], acc[q][3]);
                *(LAS v2u*)(stg + fr * 272 + (16 * (cd0 + q) + 4 * g) * 2) = pw; }
        }
        LDS_WAIT();
#pragma unroll
        for (int k = 0; k < 4; ++k) { const int id = lane + 64 * k, row = id >> 4, ch = id & 15;
            *(GAS v4u*)(KVT + (size_t)u * (HD * HD) + (size_t)(16 * w + row) * HD + 8 * ch) = *(const LAS v4u*)(stg + row * 272 + ch * 16); }
        __syncthreads();
    }
}
__device__ __forceinline__ void p3_scan_phase(Frame& F, const int u0, const int ustride) {
    const bf16* KVT = (const bf16*)(F.ws + WS_KVT); bf16* prevT = (bf16*)(F.ws + WS_PREVT);
    for (int idx = u0 * 512 + F.tid; idx < NB * NH * HD * HD / 4; idx += ustride * 512) {
        const int de4 = idx & 4095, h = (idx >> 12) & 3, b = idx >> 14;
        const float cd = exp2f((float)CH * lg2_gamma(h));
        float s0 = 0.f, s1 = 0.f, s2 = 0.f, s3 = 0.f;
        v2u kvv[NCH];
#pragma unroll
        for (int n = 0; n < NCH; ++n) kvv[n] = *(const GAS v2u*)(KVT + (size_t)((b * NCH + n) * NH + h) * (HD * HD) + 4 * de4);
#pragma unroll
        for (int n = 0; n < NCH; ++n) {
            const size_t o = (size_t)((b * NCH + n) * NH + h) * (HD * HD) + 4 * de4;
            v2u pw; pw.x = pk2(s0, s1); pw.y = pk2(s2, s3);
            *(GAS v2u*)(prevT + o) = pw;
            s0 = cd * s0 + bflo(kvv[n].x); s1 = cd * s1 + bfhi(kvv[n].x); s2 = cd * s2 + bflo(kvv[n].y); s3 = cd * s3 + bfhi(kvv[n].y);
        }
    }
}
__device__ __forceinline__ void p4_retout_phase(Frame& F) {
    const bf16* qb = (const bf16*)(F.ws + WS_QB); const bf16* gbuf = (const bf16*)(F.ws + WS_GB); const bf16* prevT = (const bf16*)(F.ws + WS_PREVT);
    const bf16* kb = (const bf16*)(F.ws + WS_KB); const bf16* vb = (const bf16*)(F.ws + WS_VB);
    bf16* mixb = (bf16*)(F.ws + WS_MIXB);
    LAS unsigned char* Kimg = F.lds; LAS unsigned char* Vimg = F.lds + 32768; LAS unsigned char* Simg = F.lds + 65536;
    const int lane = F.lane, w = F.wave, g = lane >> 4, fr = lane & 15, tid = F.tid;
    LAS unsigned char* Pimg = F.lds + 98304 + 4096 * w;
    v4u rk[4], rv[4], rp[4], gvr[4];
    bf16x8 qf[4], qn[4];
    int u = blockIdx.x;
    if (u < NB * NCH * NH) { const int h = u & 3, n = (u >> 2) & 31, b = u >> 7; const size_t row0 = (size_t)b * SEQ + (size_t)n * CH;
        tile_load(rk, kb + row0 * RW + h * HD, RW, tid); tile_load(rv, vb + row0 * RW + h * HD, RW, tid); tile_load(rp, prevT + (size_t)u * (HD * HD), HD, tid);
#pragma unroll
        for (int s = 0; s < 4; ++s) qf[s] = *(const GAS bf16x8*)(qb + (row0 + 16 * w + fr) * RW + h * HD + 32 * s + 8 * g); }
    for (; u < NB * NCH * NH; u += F.G) {
        const int h = u & 3, n = (u >> 2) & 31, b = u >> 7; const size_t row0 = (size_t)b * SEQ + (size_t)n * CH;
        const float lg2 = lg2_gamma(h);
        tile_write<false>(rk, Kimg, tid, 0.f); tile_write<false>(rv, Vimg, tid, 0.f); tile_write<false>(rp, Simg, tid, 0.f);
        const int i0 = 16 * w;
        __syncthreads();
#pragma unroll
        for (int k = 0; k < 4; ++k) { const int id = lane + 64 * k, row = id >> 4, ch = id & 15; gvr[k] = *(const GAS v4u*)(gbuf + (row0 + i0 + row) * RW + h * HD + 8 * ch); }
        { const int u2 = u + F.G; if (u2 < NB * NCH * NH) { const int h2 = u2 & 3, n2 = (u2 >> 2) & 31, b2 = u2 >> 7; const size_t r2 = (size_t)b2 * SEQ + (size_t)n2 * CH;
            tile_load(rk, kb + r2 * RW + h2 * HD, RW, tid); tile_load(rv, vb + r2 * RW + h2 * HD, RW, tid); tile_load(rp, prevT + (size_t)u2 * (HD * HD), HD, tid);
#pragma unroll
            for (int s = 0; s < 4; ++s) qn[s] = *(const GAS bf16x8*)(qb + (r2 + i0 + fr) * RW + h2 * HD + 32 * s + 8 * g); } }
        const int njt = (w | 1) + 1;
        for (int jt0 = 0; jt0 < njt; jt0 += 2) {
            f32x4 accj[2] = {(f32x4){0.f, 0.f, 0.f, 0.f}, (f32x4){0.f, 0.f, 0.f, 0.f}};
#pragma unroll
            for (int s = 0; s < 4; ++s) {
#pragma unroll
                for (int q = 0; q < 2; ++q) accj[q] = __builtin_amdgcn_mfma_f32_16x16x32_bf16(row_frag(Kimg, lane, jt0 + q, s), qf[s], accj[q], 0, 0, 0); }
#pragma unroll
            for (int q = 0; q < 2; ++q) { const int jt = jt0 + q;
                const int i = i0 + fr, jb = 16 * jt + 4 * g;
                float pv[4];
#pragma unroll
                for (int r = 0; r < 4; ++r) { const int j = jb + r; const float v = accj[q][r] * exp2f((float)(i - j) * lg2); pv[r] = (i >= j) ? v : 0.f; }
                v2u w2; w2.x = pk2(pv[0], pv[1]); w2.y = pk2(pv[2], pv[3]);
                *(LAS v2u*)(Pimg + offb(fr, 2 * jt + (g >> 1)) + 8 * (g & 1)) = w2; }
        }
        LDS_WAIT();
        float qd[4];
#pragma unroll
        for (int r = 0; r < 4; ++r) qd[r] = exp2f((float)(i0 + 4 * g + r + 1) * lg2);
        const int ksmax = w >> 1;
        f32x4 o[8];
#pragma unroll
        for (int et = 0; et < 8; ++et) o[et] = (f32x4){0.f, 0.f, 0.f, 0.f};
#pragma unroll
        for (int s = 0; s < 4; ++s) {
#pragma unroll
            for (int et = 0; et < 8; ++et) o[et] = __builtin_amdgcn_mfma_f32_16x16x32_bf16(qf[s], row_frag(Simg, lane, et, s), o[et], 0, 0, 0); }
#pragma unroll
        for (int et = 0; et < 8; ++et)
#pragma unroll
            for (int r = 0; r < 4; ++r) o[et][r] *= qd[r];
        for (int ks = 0; ks <= ksmax; ++ks) { const bf16x8 pf = row_frag(Pimg, lane, 0, ks);
#pragma unroll
            for (int et = 0; et < 8; ++et) o[et] = __builtin_amdgcn_mfma_f32_16x16x32_bf16(pf, tr_frag(Vimg, lane, et, ks), o[et], 0, 0, 0); }
        float mu[4], rstd[4];
#pragma unroll
        for (int r = 0; r < 4; ++r) { float sm = 0.f;
#pragma unroll
            for (int et = 0; et < 8; ++et) sm += o[et][r];
            sm += __shfl_xor(sm, 1); sm += __shfl_xor(sm, 2); sm += __shfl_xor(sm, 4); sm += __shfl_xor(sm, 8);
            mu[r] = sm * (1.0f / HD); float q2 = 0.f;
#pragma unroll
            for (int et = 0; et < 8; ++et) { const float d = o[et][r] - mu[r]; q2 += d * d; }
            q2 += __shfl_xor(q2, 1); q2 += __shfl_xor(q2, 2); q2 += __shfl_xor(q2, 4); q2 += __shfl_xor(q2, 8);
            rstd[r] = 1.0f / sqrtf(q2 * (1.0f / HD) + EPS); }
        LDS_WAIT();
        LAS bf16* stg = (LAS bf16*)Pimg;
#pragma unroll
        for (int et = 0; et < 8; ++et) { const float gw = F.gn_w[h * HD + 16 * et + fr];
#pragma unroll
            for (int r = 0; r < 4; ++r) stg[(4 * g + r) * HD + 16 * et + fr] = (bf16)f2bf((o[et][r] - mu[r]) * rstd[r] * gw); }
        LDS_WAIT();
#pragma unroll
        for (int k = 0; k < 4; ++k) {
            const int id = lane + 64 * k, row = id >> 4, ch = id & 15;
            const v4u yv = *(const LAS v4u*)(Pimg + row * 256 + ch * 16);
            const size_t grow = row0 + i0 + row;
            const v4u gv = gvr[k];
            v4u ov;
            ov.x = pk2(silu_f(bflo(gv.x)) * bflo(yv.x), silu_f(bfhi(gv.x)) * bfhi(yv.x)); ov.y = pk2(silu_f(bflo(gv.y)) * bflo(yv.y), silu_f(bfhi(gv.y)) * bfhi(yv.y));
            ov.z = pk2(silu_f(bflo(gv.z)) * bflo(yv.z), silu_f(bfhi(gv.z)) * bfhi(yv.z)); ov.w = pk2(silu_f(bflo(gv.w)) * bflo(yv.w), silu_f(bfhi(gv.w)) * bfhi(yv.w));
            *(GAS v4u*)(mixb + grow * D + h * HD + 8 * ch) = ov;
        }
#pragma unroll
        for (int s = 0; s < 4; ++s) qf[s] = qn[s];
        __syncthreads();
    }
    const bf16* gbb = (const bf16*)(F.ws + WS_GBB); const bf16* cub = (const bf16*)(F.ws + WS_CUB);
    for (int id = blockIdx.x * 512 + F.tid; id < M * 64; id += F.G * 512) {
        const int row = id >> 6, ch = id & 63, t = row & (SEQ - 1);
        const v4u c2 = *(const GAS v4u*)(cub + (size_t)row * CW + 8 * ch);
        v4u c1 = (v4u){0u, 0u, 0u, 0u}, c0 = c1;
        if (t >= 1) c1 = *(const GAS v4u*)(cub + (size_t)(row - 1) * CW + 8 * ch);
        if (t >= 2) c0 = *(const GAS v4u*)(cub + (size_t)(row - 2) * CW + 8 * ch);
        const v4u gv = *(const GAS v4u*)(gbb + (size_t)row * CW + 8 * ch);
        float wk[3][8];
#pragma unroll
        for (int k = 0; k < 3; ++k) { const f32x4 a = *(const GAS f32x4*)(F.conv_w + k * CW + 8 * ch), bq = *(const GAS f32x4*)(F.conv_w + k * CW + 8 * ch + 4);
            wk[k][0] = a.x; wk[k][1] = a.y; wk[k][2] = a.z; wk[k][3] = a.w; wk[k][4] = bq.x; wk[k][5] = bq.y; wk[k][6] = bq.z; wk[k][7] = bq.w; }
        const unsigned c0a[4] = {c0.x, c0.y, c0.z, c0.w}, c1a[4] = {c1.x, c1.y, c1.z, c1.w}, c2a[4] = {c2.x, c2.y, c2.z, c2.w}, ga[4] = {gv.x, gv.y, gv.z, gv.w};
        unsigned oa[4];
#pragma unroll
        for (int x = 0; x < 4; ++x) {
            const float lo = bflo(ga[x]) * (wk[0][2 * x] * bflo(c0a[x]) + wk[1][2 * x] * bflo(c1a[x]) + wk[2][2 * x] * bflo(c2a[x]));
            const float hi = bfhi(ga[x]) * (wk[0][2 * x + 1] * bfhi(c0a[x]) + wk[1][2 * x + 1] * bfhi(c1a[x]) + wk[2][2 * x + 1] * bfhi(c2a[x]));
            oa[x] = pk2(lo, hi); }
        *(GAS v4u*)(mixb + (size_t)row * D + RW + 8 * ch) = (v4u){oa[0], oa[1], oa[2], oa[3]};
    }
}

struct OutProjSched {
    int c, G; const void* Wb0; const void* Wb1; unsigned Wbytes;
    __device__ __forceinline__ bool next(int i, pg8::Unit& u) const {
        constexpr int nN = D / 256, nwg = (M / 256) * nN;
        const int L = i * G + c; if (L >= nwg) return false;
        const int wgid = (L % 8) * (nwg / 8) + L / 8;
        const int nig = 8 * nN, gid = wgid / nig, fm = gid * 8;
        u.pm = fm + ((wgid % nig) % 8); u.pn = (wgid % nig) / 8; u.arow0 = u.pm * 256; u.e = 0; u.rb = 0; u.nvalid = 256;
        u.B = (unsigned)u.pn * (256u * D * 2u); u.B1 = u.B; return true;
    }
    __device__ __forceinline__ int arow(const pg8::Unit&, int) const { return 0; }
};
struct EpiOutProj {
    static constexpr bool PERM = true;
    const float* x; const float* nw2; bf16* xn2; float* ssq;
    __device__ __forceinline__ void operator()(const f32x4 (&acc)[2][2][4][2], const pg8::Unit& u, int wr, int wc, int fr, int fq) const {
        const int row0 = u.pm * 256 + wr * 64 + fr, col0 = u.pn * 256 + wc * 32 + 8 * fq;
        f32x4 nwv[2][2];
#pragma unroll
        for (int bj = 0; bj < 2; ++bj) { nwv[bj][0] = *(const f32x4*)(nw2 + col0 + bj * 128); nwv[bj][1] = *(const f32x4*)(nw2 + col0 + bj * 128 + 4); }
#pragma unroll
        for (int ai = 0; ai < 2; ++ai)
#pragma unroll
            for (int m = 0; m < 4; ++m) { const size_t r = (size_t)(row0 + ai * 128 + m * 16); float ss = 0.f;
#pragma unroll
                for (int bj = 0; bj < 2; ++bj) { const size_t o = r * D + col0 + bj * 128;
                    const f32x4 v0 = acc[ai][bj][m][0] + *(const f32x4*)(x + o), v1 = acc[ai][bj][m][1] + *(const f32x4*)(x + o + 4);
                    ss += (v0[0] * v0[0] + v0[1] * v0[1]) + (v0[2] * v0[2] + v0[3] * v0[3]) + (v1[0] * v1[0] + v1[1] * v1[1]) + (v1[2] * v1[2] + v1[3] * v1[3]);
                    const f32x4 s0 = v0 * nwv[bj][0], s1 = v1 * nwv[bj][1];
                    v4u w; w.x = cvt_pk_bf16(s0[0], s0[1]); w.y = cvt_pk_bf16(s0[2], s0[3]); w.z = cvt_pk_bf16(s1[0], s1[1]); w.w = cvt_pk_bf16(s1[2], s1[3]);
                    *(v4u*)(xn2 + o) = w; }
                ss += __shfl_xor(ss, 16); ss += __shfl_xor(ss, 32);
                if (fq == 0) ssq[(size_t)(4 * u.pn + wc) * M + r] = ss; }
    }
};

__device__ __forceinline__ void p6_router_phase(Frame& F) {
    const bf16* xn2 = (const bf16*)(F.ws + WS_XN); const bf16* WrT = (const bf16*)(F.ws + WS_WRT);
    int* cnt = (int*)(F.ws + WS_CTL) + CW_CNT; int* tokl = (int*)(F.ws + WS_TOKL); float* rsl = (float*)(F.ws + WS_RSL); float* gatel = (float*)(F.ws + WS_GATEL);
    const float* ssq = (const float*)(F.ws + WS_SSQ);
    const int lane = F.lane, w = F.wave, g = lane >> 4, fr = lane & 15;
    constexpr int LS = 84;
    LAS float* slab = (LAS float*)F.lds + (w & 3) * (64 * LS);
    if (w == 0) { ((LAS int*)(F.lds + 4 * 64 * LS * 4))[lane] = 0; LDS_WAIT(); }
    for (int cb = (int)blockIdx.x; cb < M / 64; cb += F.G) {
        f32x4 acc[4][5];
#pragma unroll
        for (int rb = 0; rb < 4; ++rb)
#pragma unroll
            for (int t = 0; t < 5; ++t) acc[rb][t] = (f32x4){0.f, 0.f, 0.f, 0.f};
        const bf16* arow = xn2 + (size_t)(64 * cb + fr) * D + 128 * w + 8 * g;
        const bf16* brow = WrT + (size_t)fr * D + 128 * w + 8 * g;
        float ssq_tok = 0.f;
        if (w == 0) {
#pragma unroll
            for (int p = 0; p < 16; ++p) ssq_tok += ssq[(size_t)p * M + 64 * cb + lane]; }
#pragma unroll
        for (int s4 = 0; s4 < 4; ++s4) {
            bf16x8 bfr[5];
#pragma unroll
            for (int t = 0; t < 5; ++t) bfr[t] = *(const GAS bf16x8*)(brow + (size_t)(16 * t) * D + 32 * s4);
#pragma unroll
            for (int rb = 0; rb < 4; ++rb) { const bf16x8 a = *(const GAS bf16x8*)(arow + (size_t)(16 * rb) * D + 32 * s4);
#pragma unroll
                for (int t = 0; t < 5; ++t) acc[rb][t] = __builtin_amdgcn_mfma_f32_16x16x32_bf16(a, bfr[t], acc[rb][t], 0, 0, 0); }
        }
        if (w < 4) {
#pragma unroll
            for (int rb = 0; rb < 4; ++rb)
#pragma unroll
                for (int t = 0; t < 5; ++t)
#pragma unroll
                    for (int r = 0; r < 4; ++r) slab[(16 * rb + 4 * g + r) * LS + 16 * t + fr] = acc[rb][t][r];
        }
        __syncthreads();
        if (w >= 4) {
#pragma unroll
            for (int rb = 0; rb < 4; ++rb)
#pragma unroll
                for (int t = 0; t < 5; ++t)
#pragma unroll
                    for (int r = 0; r < 4; ++r) { LAS float* p = slab + (16 * rb + 4 * g + r) * LS + 16 * t + fr; *p = *p + acc[rb][t][r]; }
        }
        __syncthreads();
        if (w == 0) {
            const int tok = 64 * cb + lane;
            const LAS float* L0 = (const LAS float*)F.lds + lane * LS;
            const float rs = 1.0f / sqrtf(ssq_tok * (1.0f / D) + EPS);
            float gl[8];
#pragma unroll
            for (int n = 0; n < 8; ++n) gl[n] = (((L0[n] + L0[64 * LS + n]) + L0[2 * 64 * LS + n]) + L0[3 * 64 * LS + n]) * rs + F.rg_b[n];
            int gs = 0; float gm = gl[0];
#pragma unroll
            for (int n = 1; n < 8; ++n) if (gl[n] > gm) { gm = gl[n]; gs = n; }
            float den = 0.f;
#pragma unroll
            for (int n = 0; n < 8; ++n) den += __expf(gl[n] - gm);
            const float pg = 1.0f / den;
            float el[8];
#pragma unroll
            for (int e = 0; e < 8; ++e) { const int n = 8 + gs * 8 + e; el[e] = (((L0[n] + L0[64 * LS + n]) + L0[2 * 64 * LS + n]) + L0[3 * 64 * LS + n]) * rs + F.re_b[gs * EPG + e]; }
            int i1 = 0; float m1 = el[0];
#pragma unroll
            for (int e = 1; e < 8; ++e) if (el[e] > m1) { m1 = el[e]; i1 = e; }
            int i2 = 0; float m2 = -3.0e38f;
#pragma unroll
            for (int e = 0; e < 8; ++e) if (e != i1 && el[e] > m2) { m2 = el[e]; i2 = e; }
            const float rr = __expf(m2 - m1); const float w1 = 1.0f / (1.0f + rr), w2 = rr / (1.0f + rr);
            const int e1 = gs * EPG + i1, e2 = gs * EPG + i2;
            LAS int* hist = (LAS int*)(F.lds + 4 * 64 * LS * 4);
            const int l1 = __hip_atomic_fetch_add(hist + e1, 1, __ATOMIC_RELAXED, __HIP_MEMORY_SCOPE_WORKGROUP), l2 = __hip_atomic_fetch_add(hist + e2, 1, __ATOMIC_RELAXED, __HIP_MEMORY_SCOPE_WORKGROUP);
            LDS_WAIT(); asm volatile("" ::: "memory");
            { const int c = hist[lane]; int base = 0; if (c > 0) base = atomicAdd(cnt + lane * CNT_STRIDE, c); hist[64 + lane] = base; hist[lane] = 0; }
            LDS_WAIT(); asm volatile("" ::: "memory");
            const int r1 = hist[64 + e1] + l1, r2 = hist[64 + e2] + l2;
            tokl[e1 * M + r1] = tok * 2;     rsl[e1 * M + r1] = rs; gatel[e1 * M + r1] = pg * w1;
            tokl[e2 * M + r2] = tok * 2 + 1; rsl[e2 * M + r2] = rs; gatel[e2 * M + r2] = pg * w2;
        }
        __syncthreads();
    }
}

__device__ __forceinline__ const char* uniform_ptr(const char* p) {
    const unsigned long long v = (unsigned long long)p;
    const unsigned lo = __builtin_amdgcn_readfirstlane((unsigned)v), hi = __builtin_amdgcn_readfirstlane((unsigned)(v >> 32));
    return (const char*)(((unsigned long long)hi << 32) | lo);
}
struct MoeSched {
    int half;
    int wave; int c, G; int total, limit; const LAS int* tab;
    const void* Wb0; const void* Wb1; unsigned Wbytes; unsigned off1; unsigned estride; int colstep; int ldwb; const int* tokl;
    __device__ __forceinline__ void init(const int* cnt, int lane, LAS int* table, bool wtail) {
        const int my_cnt = __hip_atomic_load(cnt + lane * CNT_STRIDE, __ATOMIC_RELAXED, __HIP_MEMORY_SCOPE_AGENT), my_nb = (my_cnt + 255) >> 8;
        int v = my_nb;
#pragma unroll
        for (int o = 1; o < 64; o <<= 1) { const int t = __shfl_up(v, o); if (lane >= o) v += t; }
        table[lane] = 4 * (v - my_nb); table[64 + lane] = my_nb; table[128 + lane] = my_cnt; total = 4 * __builtin_amdgcn_readlane(v, 63); limit = (total / G) * G; tab = table;
        if (wtail && 2 * (total - limit) > G) limit = total;
    }
    __device__ __forceinline__ bool next(int i, pg8::Unit& u) const {
        const int j = i * G + c; int L, hf = 0;
        if (half) {
            if ((G & 15) == 0) {
                const int ell = (c & 7) + 8 * ((c >> 4) + (G >> 4) * i); hf = (c >> 3) & 1;
                if (ell >= total - limit) return false; L = limit + ell;
            } else { if (j >= 2 * (total - limit)) return false; L = limit + (j >> 1); hf = j & 1; }
        } else { if (j >= limit) return false; L = j; }
        int wgid = L; { const int q = total / 8, r = total % 8, xcd = wgid % 8, off = wgid / 8; wgid = (xcd < r ? xcd * (q + 1) : r * (q + 1) + (xcd - r) * q) + off; }
        const int ln = (int)__builtin_amdgcn_mbcnt_hi(~0u, __builtin_amdgcn_mbcnt_lo(~0u, 0u));
        const int my_b4 = tab[ln], my_nb = tab[64 + ln];
        const bool hit = (wgid >= my_b4) && (wgid < my_b4 + 4 * my_nb);
        const unsigned long long mk = __ballot(hit);
        const int e = __builtin_amdgcn_readfirstlane((int)__builtin_ctzll(mk));
        const int b4 = __builtin_amdgcn_readfirstlane(tab[e]), nb = __builtin_amdgcn_readfirstlane(tab[64 + e]), ce = __builtin_amdgcn_readfirstlane(tab[128 + e]);
        const int within = wgid - b4; u.pn = __builtin_amdgcn_readfirstlane(within / nb); const int blk = within - u.pn * nb;
        const int rows = half ? 128 : 256;
        u.e = e; u.rb = (blk << 8) + 128 * hf; u.pm = (b4 >> 2) + blk; u.arow0 = (u.pm << 8) + 128 * hf;
        int nv = ce - u.rb; nv = nv < 0 ? 0 : nv; u.nvalid = nv < rows ? nv : rows;
        u.B = (unsigned)e * estride + (unsigned)u.pn * (unsigned)colstep; u.B1 = u.B + off1; return true;
    }
    __device__ __forceinline__ int arow(const pg8::Unit& u, int rl) const { return rl < u.nvalid ? (tokl[u.e * M + u.rb + rl] >> 1) : 0; }
};
struct EpiMoe1 {
    bf16* hb; const float* rsl;
    __device__ __forceinline__ void operator()(const f32x4 (&acc)[2][4][2], const pg8::Unit& u, int wr, int wc, int fr, int fq) const {
#pragma unroll
        for (int m = 0; m < 4; ++m) { const int rl = wr * 64 + m * 16 + fr;
            const float rs = rsl[u.e * M + u.rb + rl];
            f32x4 v0, v1;
#pragma unroll
            for (int j = 0; j < 4; ++j) { v0[j] = silu_f(acc[0][m][0][j] * rs) * (acc[1][m][0][j] * rs); v1[j] = silu_f(acc[0][m][1][j] * rs) * (acc[1][m][1][j] * rs); }
            v4u w; w.x = cvt_pk_bf16(v0[0], v0[1]); w.y = cvt_pk_bf16(v0[2], v0[3]); w.z = cvt_pk_bf16(v1[0], v1[1]); w.w = cvt_pk_bf16(v1[2], v1[3]);
            *(v4u*)(hb + (size_t)(u.arow0 + rl) * FF + u.pn * 128 + wc * 32 + 8 * fq) = w; }
    }
};
struct EpiMoe2 {
    bf16* yb; const int* tokl; const float* gatel;
    __device__ __forceinline__ void operator()(const f32x4 (&acc)[2][4][2], const pg8::Unit& u, int wr, int wc, int fr, int fq) const {
#pragma unroll
        for (int m = 0; m < 4; ++m) { const int rl = wr * 64 + m * 16 + fr;
            if (rl < u.nvalid) {
                const int dst = tokl[u.e * M + u.rb + rl]; const float gt = gatel[u.e * M + u.rb + rl];
#pragma unroll
                for (int bj = 0; bj < 2; ++bj) { const f32x4 v0 = acc[bj][m][0] * gt, v1 = acc[bj][m][1] * gt;
                    v4u w; w.x = cvt_pk_bf16(v0[0], v0[1]); w.y = cvt_pk_bf16(v0[2], v0[3]); w.z = cvt_pk_bf16(v1[0], v1[1]); w.w = cvt_pk_bf16(v1[2], v1[3]);
                    *(v4u*)(yb + (size_t)dst * D + u.pn * 256 + bj * 128 + wc * 32 + 8 * fq) = w; } } }
    }
};

struct EpiMoe1W {
    bf16* hb; const float* rsl;
    __device__ __forceinline__ void prefetch(const pg8::Unit& u, LAS unsigned char* rec) const {
        const __amdgpu_buffer_rsrc_t r = __builtin_amdgcn_make_buffer_rsrc((void*)rsl, 0, (unsigned)(NE * M * 4), 0x00020000);
        const int lo = lane_now() * 4, so = (u.e * M + u.rb) * 4;
#pragma unroll
        for (int j = 0; j < 4; ++j) __builtin_amdgcn_raw_ptr_buffer_load_lds(r, (LAS void*)(rec + 256 * j), 4, lo, so + 256 * j, 0, 0);
    }
    __device__ __forceinline__ void operator()(const f32x4 (&acc)[2][2][4][2], const pg8::Unit& u, int wr, int wc, int fr, int fq, const LAS unsigned char* rec) const {
#pragma unroll
        for (int ai = 0; ai < 2; ++ai)
#pragma unroll
            for (int m = 0; m < 4; ++m) { const int rl = ai * 128 + wr * 64 + m * 16 + fr;
                const float rs = *(const LAS float*)(rec + 4 * rl);
                f32x4 v0, v1;
#pragma unroll
                for (int j = 0; j < 4; ++j) { v0[j] = silu_f(acc[ai][0][m][0][j] * rs) * (acc[ai][1][m][0][j] * rs); v1[j] = silu_f(acc[ai][0][m][1][j] * rs) * (acc[ai][1][m][1][j] * rs); }
                v4u w; w.x = cvt_pk_bf16(v0[0], v0[1]); w.y = cvt_pk_bf16(v0[2], v0[3]); w.z = cvt_pk_bf16(v1[0], v1[1]); w.w = cvt_pk_bf16(v1[2], v1[3]);
                *(v4u*)(hb + (size_t)(u.arow0 + rl) * FF + u.pn * 128 + wc * 32 + 8 * fq) = w; }
    }
};
struct EpiMoe2W {
    bf16* yb; const int* tokl; const float* gatel;
    __device__ __forceinline__ void prefetch(const pg8::Unit& u, LAS unsigned char* rec) const {
        const __amdgpu_buffer_rsrc_t rt = __builtin_amdgcn_make_buffer_rsrc((void*)tokl, 0, (unsigned)(NE * M * 4), 0x00020000), rg = __builtin_amdgcn_make_buffer_rsrc((void*)gatel, 0, (unsigned)(NE * M * 4), 0x00020000);
        const int lo = lane_now() * 4, so = (u.e * M + u.rb) * 4;
#pragma unroll
        for (int j = 0; j < 4; ++j) { __builtin_amdgcn_raw_ptr_buffer_load_lds(rt, (LAS void*)(rec + 256 * j), 4, lo, so + 256 * j, 0, 0); __builtin_amdgcn_raw_ptr_buffer_load_lds(rg, (LAS void*)(rec + 1024 + 256 * j), 4, lo, so + 256 * j, 0, 0); }
    }
    __device__ __forceinline__ void operator()(const f32x4 (&acc)[2][2][4][2], const pg8::Unit& u, int wr, int wc, int fr, int fq, const LAS unsigned char* rec) const {
#pragma unroll
        for (int ai = 0; ai < 2; ++ai)
#pragma unroll
            for (int m = 0; m < 4; ++m) { const int rl = ai * 128 + wr * 64 + m * 16 + fr;
                if (rl < u.nvalid) {
                    const int dst = *(const LAS int*)(rec + 4 * rl); const float gt = *(const LAS float*)(rec + 1024 + 4 * rl);
#pragma unroll
                    for (int bj = 0; bj < 2; ++bj) { const f32x4 v0 = acc[ai][bj][m][0] * gt, v1 = acc[ai][bj][m][1] * gt;
                        v4u w; w.x = cvt_pk_bf16(v0[0], v0[1]); w.y = cvt_pk_bf16(v0[2], v0[3]); w.z = cvt_pk_bf16(v1[0], v1[1]); w.w = cvt_pk_bf16(v1[2], v1[3]);
                        *(v4u*)(yb + (size_t)dst * D + u.pn * 256 + bj * 128 + wc * 32 + 8 * fq) = w; } } }
    }
};

__device__ __forceinline__ void p9_final_phase(Frame& F) {
    const bf16* xb2 = (const bf16*)(F.ws + WS_XN); const bf16* yb = (const bf16*)(F.ws + WS_YB);
    const int gw = F.vcu * NWAVES + F.wave, NGW = F.G * NWAVES, lane = lane_now();
    for (int row = gw; row < M; row += NGW) {
        float v[16]; float ss = 0.f;
#pragma unroll
        for (int c = 0; c < 2; ++c) {
            const int ch = lane + 64 * c;
            const v4u a = *(const GAS v4u*)(xb2 + (size_t)row * D + 8 * ch), b1 = *(const GAS v4u*)(yb + (size_t)(2 * row) * D + 8 * ch), b2 = *(const GAS v4u*)(yb + (size_t)(2 * row + 1) * D + 8 * ch);
            const unsigned aa[4] = {a.x, a.y, a.z, a.w}, bb[4] = {b1.x, b1.y, b1.z, b1.w}, cc[4] = {b2.x, b2.y, b2.z, b2.w};
            const f32x4 n0 = *(const GAS f32x4*)(F.norm2_w + 8 * ch), n1 = *(const GAS f32x4*)(F.norm2_w + 8 * ch + 4);
            const float inw[8] = {1.0f / n0[0], 1.0f / n0[1], 1.0f / n0[2], 1.0f / n0[3], 1.0f / n1[0], 1.0f / n1[1], 1.0f / n1[2], 1.0f / n1[3]};
#pragma unroll
            for (int x = 0; x < 4; ++x) { const float lo = bflo(aa[x]) * inw[2 * x] + (bflo(bb[x]) + bflo(cc[x])), hi = bfhi(aa[x]) * inw[2 * x + 1] + (bfhi(bb[x]) + bfhi(cc[x])); v[8 * c + 2 * x] = lo; v[8 * c + 2 * x + 1] = hi; ss += lo * lo + hi * hi; }
        }
        const float rs = 1.0f / sqrtf(wave_sum(ss) * (1.0f / D) + EPS);
#pragma unroll
        for (int c = 0; c < 2; ++c) {
            const int ch = lane + 64 * c;
            const f32x4 w0 = *(const GAS f32x4*)(F.fin_w + 8 * ch), w1 = *(const GAS f32x4*)(F.fin_w + 8 * ch + 4);
            f32x4 o0, o1;
#pragma unroll
            for (int x = 0; x < 4; ++x) { o0[x] = v[8 * c + x] * rs * w0[x]; o1[x] = v[8 * c + 4 + x] * rs * w1[x]; }
            *(GAS f32x4*)(F.out + (size_t)row * D + 8 * ch) = o0; *(GAS f32x4*)(F.out + (size_t)row * D + 8 * ch + 4) = o1;
        }
    }
}

struct Args { const float* in[15]; float* out; unsigned char* ws; int ph_lo, ph_hi, li, pad; };
__global__ void __launch_bounds__(NWAVES * 64, 2) mega_fwd(Args args) {
    extern __shared__ __attribute__((aligned(16))) unsigned char lds[];
    Frame F;
    F.lds = (LAS unsigned char*)lds; F.MISC = (volatile LAS unsigned*)(F.lds + MISC_OFF);
    F.tid = threadIdx.x; F.lane = F.tid & 63; F.wave = __builtin_amdgcn_readfirstlane(F.tid >> 6);
    F.G = gridDim.x; { const int bx = blockIdx.x; F.vcu = (F.G % 8 == 0) ? (bx % 8) * (F.G / 8) + bx / 8 : bx; }
    F.ws = args.ws; F.ctl = (gu32*)(args.ws + WS_CTL); F.out = args.out;
    F.x = args.in[0]; F.norm1_w = args.in[1]; F.w_in = args.in[2]; F.gn_w = args.in[3]; F.conv_w = args.in[4]; F.w_o = args.in[5]; F.norm2_w = args.in[6];
    F.rg_w = args.in[7]; F.rg_b = args.in[8]; F.re_w = args.in[9]; F.re_b = args.in[10]; F.w_gate = args.in[11]; F.w_up = args.in[12]; F.w_down = args.in[13]; F.fin_w = args.in[14];
    for (int u = F.tid; u < (LDS_BYTES - LDSCTL_OFF) / 4; u += NWAVES * 64) ((LAS unsigned*)(F.lds + LDSCTL_OFF))[u] = 0u;
    __syncthreads();
    XcdBarrier bar = xcd_barrier_post((unsigned*)(F.ctl + CW_BAR) + args.li * XCD_BAR_WORDS, F.MISC + 8);
    const int lo = args.ph_lo, hi = args.ph_hi;
    const bool early = (F.G == 256);
    if (early && blockIdx.x >= 128 && threadIdx.x == 0) (void)xb_add((unsigned*)(F.ctl + CW_ECNT) + 64 * bar.x, 1u);
#define IN(k) (lo <= (k) && (k) < hi)
#define BOTH(k) (IN(k) && IN((k) + 1))
    if (IN(0)) { p0_prologue(F); if (BOTH(0)) xcd_barrier(bar); }
    if (IN(1)) {
        const int bx = (int)blockIdx.x; const bool mine = !early || bx >= 128; const int pi = early ? bx - 128 : bx, pstr = early ? 128 : F.G;
        static_assert(WS_KB - WS_QB == 16 * MiB && WS_VB - WS_KB == 16 * MiB && WS_GB - WS_VB == 16 * MiB && WS_GBB - WS_GB == 16 * MiB && WS_CUB - WS_GBB == 16 * MiB, "EpiInProj strides");
        EpiInProj E{(bf16*)(F.ws + WS_QB), (const float*)(F.ws + WS_ROPE), (const float*)(F.ws + WS_ROPE) + SEQ * 64, (unsigned*)(F.ctl + CW_X1) + 64 * bar.x, (unsigned*)(F.ctl + CW_E1), F.MISC};
        const bool split = early && bx >= 128;
        { InProjSched S{bx, F.G, (const void*)(F.ws + WS_WINT), (const void*)(F.ws + WS_WINT), (unsigned)(INC * D * 2), 0, split ? 2 : 1000};
          pg8::gemm_phase<EpiInProj, InProjSched, false, true>(F.lds + RING_OFF, (const void*)(F.ws + WS_XN), (unsigned)(M * D * 2), D, S, E); }
        if (split) {
            wg_wait_count((unsigned*)(F.ctl + CW_E1), 256u, bar.bar);
            p2_kv_phase(F, pi, pstr);
            wave_arrive(F.MISC + 12, (unsigned*)(F.ctl + CW_X2) + 64 * bar.x, xb_ld((unsigned*)(F.ctl + CW_ECNT) + 64 * bar.x), (unsigned*)(F.ctl + CW_E2));
            __syncthreads();
            InProjSched S{bx, F.G, (const void*)(F.ws + WS_WINT), (const void*)(F.ws + WS_WINT), (unsigned)(INC * D * 2), 2, 1000};
            pg8::gemm_phase<EpiInProj, InProjSched, false, true>(F.lds + RING_OFF, (const void*)(F.ws + WS_XN), (unsigned)(M * D * 2), D, S, E);
        }
        if (!early) { xcd_barrier(bar); p2_kv_phase(F, pi, pstr); xcd_barrier(bar); }
        if (mine) { if (early) wg_wait_count((unsigned*)(F.ctl + CW_E2), 128u, bar.bar); p3_scan_phase(F, pi, pstr); }
        xcd_barrier(bar);
    }
    if (IN(4)) { p4_retout_phase(F); if (BOTH(4)) xcd_barrier(bar); }
    if (IN(5)) {
        OutProjSched S{(int)blockIdx.x, F.G, (const void*)(F.ws + WS_WOT), (const void*)(F.ws + WS_WOT), (unsigned)(D * D * 2)};
        EpiOutProj E{F.x, F.norm2_w, (bf16*)(F.ws + WS_XN), (float*)(F.ws + WS_SSQ)};
        pg8::gemm_phase<EpiOutProj, OutProjSched, false, true>(F.lds + RING_OFF, (const void*)(F.ws + WS_MIXB), (unsigned)(M * D * 2), D, S, E);
        if (BOTH(5)) xcd_barrier(bar);
    }
    if (IN(6)) { p6_router_phase(F); if (BOTH(6)) xcd_barrier(bar); }
    int moe_total = -1;
    if (IN(7)) {
        MoeSched S; S.half = 0; S.wave = F.wave; S.c = (int)blockIdx.x; S.G = F.G; S.Wb0 = (const void*)F.w_gate; S.Wb1 = (const void*)F.w_up; S.Wbytes = (unsigned)(NE * D * FF * 4); S.off1 = 0; S.estride = (unsigned)(D * FF * 4); S.colstep = 128 * 4; S.ldwb = FF * 4; S.tokl = (const int*)(F.ws + WS_TOKL);
        S.init((const int*)(F.ws + WS_CTL) + CW_CNT, lane_now(), (LAS int*)(F.lds + LDSCTL_OFF + 1024), true); __syncthreads();
        moe_total = S.total;
        { EpiMoe1W E{(bf16*)(F.ws + WS_HB), (const float*)(F.ws + WS_RSL)};
          mw::gemm_w<EpiMoe1W, MoeSched, true>(F.lds + RING_OFF, (const void*)(F.ws + WS_XN), (unsigned)(M * D * 2), D, S, E); }
        S.half = 1;
        { EpiMoe1 E{(bf16*)(F.ws + WS_HB), (const float*)(F.ws + WS_RSL)};
          mz::gemm_z<EpiMoe1, MoeSched, true>(F.lds + RING_OFF, (const void*)(F.ws + WS_XN), (unsigned)(M * D * 2), D, S, E); }
        if (BOTH(7)) xcd_barrier(bar);
    }
    if (IN(8)) {
        MoeSched S; S.half = 0; S.wave = F.wave; S.c = (int)blockIdx.x; S.G = F.G; S.Wb0 = (const void*)F.w_down; S.Wb1 = (const void*)F.w_down; S.Wbytes = (unsigned)(NE * FF * D * 4); S.off1 = 128 * 4; S.estride = (unsigned)(FF * D * 4); S.colstep = 256 * 4; S.ldwb = D * 4; S.tokl = (const int*)(F.ws + WS_TOKL);
        if (moe_total >= 0) { S.total = moe_total; S.limit = (moe_total / S.G) * S.G; S.tab = (const LAS int*)(F.lds + LDSCTL_OFF + 1024); }
        else { S.init((const int*)(F.ws + WS_CTL) + CW_CNT, lane_now(), (LAS int*)(F.lds + LDSCTL_OFF + 1024), false); __syncthreads(); }
        { EpiMoe2W E{(bf16*)(F.ws + WS_YB), (const int*)(F.ws + WS_TOKL), (const float*)(F.ws + WS_GATEL)};
          mw::gemm_w<EpiMoe2W, MoeSched, false>(F.lds + RING_OFF, (const void*)(F.ws + WS_HB), (unsigned)(49152u * FF * 2u), FF, S, E); }
        S.half = 1;
        { EpiMoe2 E{(bf16*)(F.ws + WS_YB), (const int*)(F.ws + WS_TOKL), (const float*)(F.ws + WS_GATEL)};
          mz::gemm_z<EpiMoe2, MoeSched, false>(F.lds + RING_OFF, (const void*)(F.ws + WS_HB), (unsigned)(49152u * FF * 2u), FF, S, E); }
        if (BOTH(8)) xcd_barrier(bar);
    }
    if (IN(9)) { p9_final_phase(F); }
#undef IN
#undef BOTH
}

extern "C" void kernel_launch(void* const* d_in, const int* in_sizes, int n_in, void* d_out, int out_size, void* d_ws, size_t ws_size, hipStream_t stream) {
    static int grid = 0;
    if (grid == 0) {
        int dev = 0, cus = 0, per_cu = 0;
        if (hipGetDevice(&dev) != hipSuccess || hipDeviceGetAttribute(&cus, hipDeviceAttributeMultiprocessorCount, dev) != hipSuccess) { fprintf(stderr, "kernel_launch: device query failed\n"); grid = -1; return; }
        if (hipFuncSetAttribute((const void*)mega_fwd, hipFuncAttributeMaxDynamicSharedMemorySize, LDS_BYTES) != hipSuccess) { fprintf(stderr, "kernel_launch: hipFuncSetAttribute failed\n"); grid = -1; return; }
        if (hipOccupancyMaxActiveBlocksPerMultiprocessor(&per_cu, (const void*)mega_fwd, NWAVES * 64, LDS_BYTES) != hipSuccess || per_cu < 1) fprintf(stderr, "kernel_launch: occupancy query reports %d blocks per CU\n", per_cu);
        (void)hipGetLastError();
        grid = cus;
    }
    if (grid < 0) return;
    char* ws = (char*)d_ws; float* out = (float*)d_out;
    (void)hipMemsetAsync(ws + WS_CTL, 0, CTL_ZERO_BYTES, stream);
    Args a{};
    for (int i = 0; i < 15; ++i) a.in[i] = (const float*)d_in[i];
    a.out = out; a.ws = (unsigned char*)d_ws;
    a.ph_lo = 0; a.ph_hi = 10; a.li = 0; hipLaunchKernelGGL(mega_fwd, dim3(grid), dim3(NWAVES * 64), LDS_BYTES, stream, a);
}
```
